# Optimizing an MI355X kernel written in HIP

```python
import jax, jax.numpy as jnp
from jax import lax
import numpy as np

D_MODEL = 1024
BATCH = 4
SEQ = 4096
DEPTH = 2

EPS = 1e-6
CHUNK = 128
GMLP_GROUPS = 4
GMLP_HEAD = 64
GMLP_WIDTH = GMLP_GROUPS * GMLP_HEAD
FOX_HEADS = 12
HEAD_DIM = 64
FOX_WIDTH = FOX_HEADS * HEAD_DIM
Q_BLOCK = 128
EVEN_SPLITS = (GMLP_WIDTH, 2 * GMLP_WIDTH, 2 * GMLP_WIDTH + FOX_WIDTH,
               2 * GMLP_WIDTH + 2 * FOX_WIDTH, 2 * GMLP_WIDTH + 3 * FOX_WIDTH)
EVEN_PROJ = 2 * GMLP_WIDTH + 3 * FOX_WIDTH + FOX_HEADS
EVEN_MIX = GMLP_WIDTH + FOX_WIDTH
CONV_WIDTH = 512
CONV_K = 3
POOL_WINDOWS = (2, 4, 8, 16)
POOL_GROUPS = 4
POOL_GROUP = 128
POOL_WIDTH = POOL_GROUPS * POOL_GROUP
ODD_SPLITS = (CONV_WIDTH, 2 * CONV_WIDTH, 3 * CONV_WIDTH)
ODD_PROJ = 3 * CONV_WIDTH + POOL_WIDTH
ODD_MIX = CONV_WIDTH + POOL_WIDTH
N_GROUPS = 4
EXPERTS_PER_GROUP = 4
N_EXPERTS = N_GROUPS * EXPERTS_PER_GROUP
EXPERT_HIDDEN = 256
TOP_K_INNER = 2

kernel_name = "hybrid_gmlp_fox_conv_pool_hmoe"


def rms_norm(x, g):
    xf = x.astype(jnp.float32)
    y = xf * lax.rsqrt(jnp.mean(xf * xf, axis=-1, keepdims=True) + EPS)
    return (y * g.astype(jnp.float32)).astype(x.dtype)


def gmlp_mixer(u, v, w_s, b_s, g_v):
    bsz, s_len, _ = u.shape
    n_chunks = s_len // CHUNK
    u = jax.nn.gelu(u)
    v = rms_norm(jax.nn.gelu(v).reshape(bsz, s_len, GMLP_GROUPS, GMLP_HEAD), g_v)
    v = v.reshape(bsz, n_chunks, CHUNK, GMLP_GROUPS, GMLP_HEAD)
    w = w_s * jnp.tril(jnp.ones((CHUNK, CHUNK), dtype=w_s.dtype))
    s = jnp.einsum('gts,bcsgd->bctgd', w, v) + b_s.T[None, None, :, :, None]
    return u * s.reshape(bsz, s_len, GMLP_WIDTH)


def fox_attention(q, k, v, f_logit, g_q, g_k):
    bsz, s_len = q.shape[0], q.shape[1]
    q = rms_norm(q, g_q).transpose(0, 2, 1, 3)
    k = rms_norm(k, g_k).transpose(0, 2, 1, 3)
    v = v.transpose(0, 2, 1, 3)
    log_f = jax.nn.log_sigmoid(f_logit.astype(jnp.float32))
    cum_f = jnp.cumsum(log_f, axis=1).transpose(0, 2, 1)
    scale = HEAD_DIM ** -0.5
    outs = []
    for blk in range(s_len // Q_BLOCK):
        q0 = blk * Q_BLOCK
        q1 = q0 + Q_BLOCK
        logits = jnp.einsum('bhqd,bhkd->bhqk', q[:, :, q0:q1], k[:, :, :q1]).astype(jnp.float32) * scale
        logits = logits + cum_f[:, :, q0:q1, None] - cum_f[:, :, None, :q1]
        causal = jnp.arange(q1)[None, :] <= jnp.arange(q0, q1)[:, None]
        logits = jnp.where(causal, logits, -jnp.inf)
        p = jax.nn.softmax(logits, axis=-1).astype(v.dtype)
        outs.append(jnp.einsum('bhqk,bhkd->bhqd', p, v[:, :, :q1]))
    o = jnp.concatenate(outs, axis=2)
    return o.transpose(0, 2, 1, 3).reshape(bsz, s_len, FOX_WIDTH)


def even_mixer(xn, w_in, b_forget, w_s, b_s, g_v, g_q, g_k, w_out):
    bsz, s_len, _ = xn.shape
    h = xn @ w_in
    u, v, q, k, val, f = jnp.split(h, EVEN_SPLITS, axis=-1)
    a = gmlp_mixer(u, v, w_s, b_s, g_v)
    hs = (bsz, s_len, FOX_HEADS, HEAD_DIM)
    b = fox_attention(q.reshape(hs), k.reshape(hs), val.reshape(hs), f + b_forget, g_q, g_k)
    return jnp.concatenate([a, b], axis=-1) @ w_out


def short_conv(bg, cg, hc, conv_w):
    s_len = hc.shape[1]
    z = cg * hc
    zp = jnp.pad(z, ((0, 0), (CONV_K - 1, 0), (0, 0)))
    y = conv_w[0] * zp[:, 0:s_len]
    for tap in range(1, CONV_K):
        y = y + conv_w[tap] * zp[:, tap:tap + s_len]
    return bg * y


def pool_mixer(p, w_pool, pool_scale):
    bsz, s_len, _ = p.shape
    pf = p.astype(jnp.float32).reshape(bsz, s_len, POOL_GROUPS, POOL_GROUP)
    cs = jnp.concatenate([jnp.zeros_like(pf[:, :1]), jnp.cumsum(pf, axis=1)], axis=1)
    hi = jnp.arange(1, s_len + 1)
    groups = []
    for gi, win in enumerate(POOL_WINDOWS):
        lo = jnp.maximum(hi - win, 0)
        cnt = (hi - lo).astype(jnp.float32)
        mean = (cs[:, hi, gi] - cs[:, lo, gi]) / cnt[None, :, None]
        groups.append(mean - pf[:, :, gi])
    pooled = jnp.stack(groups, axis=2).astype(p.dtype)
    y = jnp.einsum('bsgc,gcd->bsgd', pooled, w_pool).reshape(bsz, s_len, POOL_WIDTH)
    return y * pool_scale


def odd_mixer(xn, w_in, conv_w, w_pool, pool_scale, w_out):
    h = xn @ w_in
    bg, cg, hc, p = jnp.split(h, ODD_SPLITS, axis=-1)
    c = short_conv(bg, cg, hc, conv_w)
    d = pool_mixer(p, w_pool, pool_scale)
    return jnp.concatenate([c, d], axis=-1) @ w_out


def hier_moe(xn, w_group, b_group, w_router, b_router, w_gate, w_up, w_down):
    bsz, s_len, d = xn.shape
    xt = xn.reshape(bsz * s_len, d)
    g_prob = jax.nn.softmax((xt @ w_group).astype(jnp.float32) + b_group.astype(jnp.float32), axis=-1)
    g_top_p, g_idx = lax.top_k(g_prob, 1)
    e_logits_all = jnp.einsum('td,dge->tge', xt, w_router).astype(jnp.float32) + b_router.astype(jnp.float32)
    g_sel = jax.nn.one_hot(g_idx[:, 0], N_GROUPS, dtype=jnp.float32)
    e_logits = jnp.einsum('tge,tg->te', e_logits_all, g_sel)
    e_prob = jax.nn.softmax(e_logits, axis=-1)
    e_top_p, e_idx = lax.top_k(e_prob, TOP_K_INNER)
    e_top_p = e_top_p / jnp.sum(e_top_p, axis=-1, keepdims=True)
    weights = g_top_p * e_top_p
    expert_id = g_idx * EXPERTS_PER_GROUP + e_idx
    combine = jnp.einsum('tk,tke->te', weights, jax.nn.one_hot(expert_id, N_EXPERTS, dtype=jnp.float32))
    hid = jax.nn.silu(jnp.einsum('td,edh->teh', xt, w_gate)) * jnp.einsum('td,edh->teh', xt, w_up)
    hid = hid * combine[:, :, None].astype(hid.dtype)
    y = jnp.einsum('teh,ehd->td', hid, w_down)
    return y.reshape(bsz, s_len, d)


def setup_inputs(seed: int = 0) -> dict:
    key = jax.random.key(seed)
    ks = iter(jax.random.split(key, 32))
    n_even = (DEPTH + 1) // 2
    n_odd = DEPTH // 2
    f32 = jnp.float32

    def nrm(shape, scale):
        return jax.random.normal(next(ks), shape, f32) * scale

    def gain(shape):
        return 1.0 + 0.05 * jax.random.normal(next(ks), shape, f32)

    return {
        "x": jax.random.normal(next(ks), (BATCH, SEQ, D_MODEL), f32),
        "ev_norm": gain((n_even, D_MODEL)),
        "ev_w_in": nrm((n_even, D_MODEL, EVEN_PROJ), D_MODEL ** -0.5),
        "ev_b_forget": jax.random.uniform(next(ks), (n_even, FOX_HEADS), f32, 1.0, 5.0),
        "ev_w_s": nrm((n_even, GMLP_GROUPS, CHUNK, CHUNK), CHUNK ** -0.5),
        "ev_b_s": gain((n_even, GMLP_GROUPS, CHUNK)),
        "ev_g_v": gain((n_even, GMLP_GROUPS, GMLP_HEAD)),
        "ev_g_q": gain((n_even, HEAD_DIM)),
        "ev_g_k": gain((n_even, HEAD_DIM)),
        "ev_w_out": nrm((n_even, EVEN_MIX, D_MODEL), EVEN_MIX ** -0.5),
        "od_norm": gain((n_odd, D_MODEL)),
        "od_w_in": nrm((n_odd, D_MODEL, ODD_PROJ), D_MODEL ** -0.5),
        "od_conv_w": nrm((n_odd, CONV_K, CONV_WIDTH), CONV_K ** -0.5),
        "od_w_pool": nrm((n_odd, POOL_GROUPS, POOL_GROUP, POOL_GROUP), POOL_GROUP ** -0.5),
        "od_pool_scale": gain((n_odd, POOL_WIDTH)),
        "od_w_out": nrm((n_odd, ODD_MIX, D_MODEL), ODD_MIX ** -0.5),
        "moe_norm": gain((DEPTH, D_MODEL)),
        "moe_w_group": nrm((DEPTH, D_MODEL, N_GROUPS), D_MODEL ** -0.5),
        "moe_b_group": nrm((DEPTH, N_GROUPS), 0.01),
        "moe_w_router": nrm((DEPTH, D_MODEL, N_GROUPS, EXPERTS_PER_GROUP), D_MODEL ** -0.5),
        "moe_b_router": nrm((DEPTH, N_GROUPS, EXPERTS_PER_GROUP), 0.01),
        "moe_w_gate": nrm((DEPTH, N_EXPERTS, D_MODEL, EXPERT_HIDDEN), D_MODEL ** -0.5),
        "moe_w_up": nrm((DEPTH, N_EXPERTS, D_MODEL, EXPERT_HIDDEN), D_MODEL ** -0.5),
        "moe_w_down": nrm((DEPTH, N_EXPERTS, EXPERT_HIDDEN, D_MODEL), EXPERT_HIDDEN ** -0.5),
    }


def reference(x, ev_norm, ev_w_in, ev_b_forget, ev_w_s, ev_b_s, ev_g_v, ev_g_q, ev_g_k, ev_w_out,
              od_norm, od_w_in, od_conv_w, od_w_pool, od_pool_scale, od_w_out,
              moe_norm, moe_w_group, moe_b_group, moe_w_router, moe_b_router,
              moe_w_gate, moe_w_up, moe_w_down):
    for layer in range(DEPTH):
        j = layer // 2
        if layer % 2 == 0:
            x = x + even_mixer(rms_norm(x, ev_norm[j]), ev_w_in[j], ev_b_forget[j], ev_w_s[j], ev_b_s[j],
                               ev_g_v[j], ev_g_q[j], ev_g_k[j], ev_w_out[j])
        else:
            x = x + odd_mixer(rms_norm(x, od_norm[j]), od_w_in[j], od_conv_w[j], od_w_pool[j],
                              od_pool_scale[j], od_w_out[j])
        x = x + hier_moe(rms_norm(x, moe_norm[layer]), moe_w_group[layer], moe_b_group[layer],
                         moe_w_router[layer], moe_b_router[layer], moe_w_gate[layer],
                         moe_w_up[layer], moe_w_down[layer])
    return x
```

```cpp
#define MK_N_LAUNCHES 1
#include <hip/hip_runtime.h>
#include <hip/hip_cooperative_groups.h>
#include <hip/hip_bf16.h>
#include <cstdio>
#include <cstdint>
#include <cmath>

#ifndef MK_N_LAUNCHES
#define MK_N_LAUNCHES 15
#endif
#ifndef MK_USE_CG
#define MK_USE_CG 0
#endif
#ifndef MK_NAIVE_ATTN
#define MK_NAIVE_ATTN 0
#endif
#ifndef MK_REPEAT_MASK
#define MK_REPEAT_MASK 0
#endif
namespace pg8 {
#define PG8_LAS __attribute__((address_space(3)))
typedef unsigned short bf16_t;
typedef short bf16x8 __attribute__((ext_vector_type(8)));
typedef float f32x4 __attribute__((ext_vector_type(4)));
typedef unsigned u32x4 __attribute__((ext_vector_type(4)));
constexpr int BM = 256, BK = 64, HALF = 128, HTB = HALF * BK * 2  , STAGE_BYTES = 8 * HTB, NXCD = 8, WGM = 8;

__host__ __device__ __forceinline__ int lds_byte(int r, int c) { const int st = (r >> 4) * 2 + (c >> 5), rr = r & 15, cc = c & 31, ob = rr * 64 + cc * 2; return st * 1024 + (ob ^ (((ob >> 9) & 1) << 5)); }
__host__ __device__ __forceinline__ void stage_rc(int b, int& R, int& C) { const int st = b / 1024, sb = b % 1024, swz = sb ^ (((sb >> 9) & 1) << 5); R = (st >> 1) * 16 + swz / 64; C = (st & 1) * 32 + (swz % 64) / 2; }
__host__ __device__ __forceinline__ int perm32(int rho) { const int n = rho >> 4, i = rho & 15; return 8 * (i >> 2) + 4 * n + (i & 3); }

struct Unit { int pm, pn, e, j, cnt; };

__device__ __forceinline__ unsigned cvt_pk_bf16(float lo, float hi) { unsigned r; asm volatile("v_cvt_pk_bf16_f32 %0, %1, %2" : "=v"(r) : "v"(lo), "v"(hi)); return r; }

struct ProbPlain {
    const char* A; const char* Bt; int K, nM, nN, nwg, G, c;
    __device__ __forceinline__ void init(const void* A_, const void* Bt_, int M, int N, int K_, int G_, int c_) { A = (const char*)A_; Bt = (const char*)Bt_; K = K_; nM = M / BM; nN = N / BM; nwg = nM * nN; G = G_; c = c_; }
    __device__ __forceinline__ bool next(int i, Unit& u) const {
        const long L = (long)i * G + c; if (L >= nwg) return false;
        int wgid = (int)L; { const int q = nwg / NXCD, r = nwg % NXCD, xcd = wgid % NXCD, off = wgid / NXCD; wgid = (xcd < r ? xcd * (q + 1) : r * (q + 1) + (xcd - r) * q) + off; }
        const int nig = WGM * nN, gid = wgid / nig, fm = gid * WGM, gsz = (nM - fm) < WGM ? (nM - fm) : WGM;
        u.pm = fm + ((wgid % nig) % gsz); u.pn = (wgid % nig) / gsz; u.e = 0; u.j = 0; u.cnt = 0; return true;
    }
    __device__ __forceinline__ unsigned a_off(const Unit& u, int row) const { return (unsigned)(u.pm * BM + row) * (unsigned)(K * 2); }
    __device__ __forceinline__ const char* b_base(const Unit& u) const { return Bt + (size_t)u.pn * BM * K * 2; }
};

template <class Epi, class Prob, bool ALIGN_EPI>
__device__ __forceinline__ void gemm_phase(PG8_LAS unsigned char* lds, const Prob& S, const Epi& E) {
    const int tid = threadIdx.x, wid = __builtin_amdgcn_readfirstlane(tid >> 6), lane = tid & 63, wr = wid >> 2, wc = wid & 3, fr = lane & 15, fq = lane >> 4;
    const int K = S.K, nt = K / BK;
    int Rr[2], Cb[2]; unsigned voffB[2];
#pragma unroll
    for (int i = 0; i < 2; ++i) { int R, C; stage_rc(tid * 16 + i * 8192, R, C); const int Rb = Epi::PERM ? ((R & ~31) + perm32(R & 31)) : R;
        Rr[i] = R; Cb[i] = C * 2; voffB[i] = (unsigned)(Rb * K + C) * 2u; }
    const size_t kstep = (size_t)(BK * 2);
    const size_t hstep = (size_t)HALF * K * 2;
    const unsigned ldsw = (unsigned)wid * 1024u;
    const int aoff = lds_byte(wr * 64 + fr, fq * 8), boff = lds_byte(wc * 32 + fr, fq * 8);
#define PG8_SA(b, h) (((b) * 2 + (h)) * HTB)
#define PG8_SB(b, h) ((4 + (b) * 2 + (h)) * HTB)
#define PG8_STAGE(bufoff, gbase, voff) do { _Pragma("unroll") for (int _i = 0; _i < 2; ++_i) \
        __builtin_amdgcn_global_load_lds((const unsigned*)((const char*)(gbase) + (voff)[_i]), (PG8_LAS unsigned*)(lds + (bufoff) + ldsw + _i * 8192), 16, 0, 0); } while (0)
#define PG8_LDA(dst, b, h) do { _Pragma("unroll") for (int m = 0; m < 4; ++m) _Pragma("unroll") for (int k = 0; k < 2; ++k) dst[m][k] = *(const PG8_LAS bf16x8*)(lds + PG8_SA(b, h) + aoff + m * 2048 + k * 1024); } while (0)
#define PG8_LDB(dst, b, h) do { _Pragma("unroll") for (int n = 0; n < 2; ++n) _Pragma("unroll") for (int k = 0; k < 2; ++k) dst[n][k] = *(const PG8_LAS bf16x8*)(lds + PG8_SB(b, h) + boff + n * 2048 + k * 1024); } while (0)
#define PG8_MMA(ai, bj, At, Bt) do { __builtin_amdgcn_s_setprio(1); _Pragma("unroll") for (int m = 0; m < 4; ++m) _Pragma("unroll") for (int n = 0; n < 2; ++n) _Pragma("unroll") for (int k = 0; k < 2; ++k) \
        acc[ai][bj][m][n] = __builtin_amdgcn_mfma_f32_16x16x32_bf16(Bt[n][k], At[m][k], acc[ai][bj][m][n], 0, 0, 0); __builtin_amdgcn_s_setprio(0); } while (0)
#define PG8_WAIT_V(n) asm volatile("s_waitcnt vmcnt(" #n ")" ::: "memory")
#define PG8_WAIT_L(n) asm volatile("s_waitcnt lgkmcnt(" #n ")" ::: "memory")
#define PG8_BAR __builtin_amdgcn_s_barrier()
#define PG8_SCHED __builtin_amdgcn_sched_barrier(0)
    Unit cur, nxt; int ui = 0;
    if (!S.next(0, cur)) return;
    f32x4 acc[2][2][4][2];
#pragma unroll
    for (int a = 0; a < 2; ++a)
#pragma unroll
        for (int b = 0; b < 2; ++b)
#pragma unroll
            for (int m = 0; m < 4; ++m)
#pragma unroll
                for (int n = 0; n < 2; ++n) acc[a][b][m][n] = (f32x4){0.f, 0.f, 0.f, 0.f};
    bf16x8 At[4][2], B0[2][2], B1[2][2];
    const char* const Ab = S.A;
    unsigned cA0[2], cA1[2], nA0[2], nA1[2];
#pragma unroll
    for (int i = 0; i < 2; ++i) { cA0[i] = S.a_off(cur, Rr[i]) + (unsigned)Cb[i]; cA1[i] = S.a_off(cur, Rr[i] + HALF) + (unsigned)Cb[i]; }
    const char* cB = S.b_base(cur);
    PG8_STAGE(PG8_SB(0, 0), cB, voffB); PG8_STAGE(PG8_SB(0, 1), cB + hstep, voffB); PG8_STAGE(PG8_SA(0, 0), Ab, cA0); PG8_STAGE(PG8_SA(0, 1), Ab, cA1);
    if (wr == 1) PG8_BAR;
    PG8_WAIT_V(2); PG8_BAR;
    PG8_STAGE(PG8_SB(1, 0), cB + kstep, voffB); PG8_STAGE(PG8_SA(1, 0), Ab + kstep, cA0); PG8_STAGE(PG8_SB(1, 1), cB + hstep + kstep, voffB);
    PG8_WAIT_V(6); PG8_BAR;
    for (;;) {
        const bool has_next = S.next(ui + 1, nxt);
        const char* nB = cB;
#pragma unroll
        for (int i = 0; i < 2; ++i) { nA0[i] = cA0[i]; nA1[i] = cA1[i]; }
        if (has_next) { nB = S.b_base(nxt);
#pragma unroll
            for (int i = 0; i < 2; ++i) { nA0[i] = S.a_off(nxt, Rr[i]) + (unsigned)Cb[i]; nA1[i] = S.a_off(nxt, Rr[i] + HALF) + (unsigned)Cb[i]; } }
        for (int t = 0; t < nt; t += 2) {
            const bool last = (t == nt - 2);
            const char* a1 = Ab + (size_t)(t + 1) * kstep;
            const char* a2 = last ? Ab : Ab + (size_t)(t + 2) * kstep; const char* b2 = last ? nB : cB + (size_t)(t + 2) * kstep;
            const char* a3 = a2 + kstep; const char* b3 = b2 + kstep;
            unsigned x0[2], x1[2];
#pragma unroll
            for (int i = 0; i < 2; ++i) { x0[i] = last ? nA0[i] : cA0[i]; x1[i] = last ? nA1[i] : cA1[i]; }
            PG8_LDB(B0, 0, 0); PG8_LDB(B1, 0, 1); PG8_SCHED; PG8_LDA(At, 0, 0); PG8_STAGE(PG8_SA(1, 1), a1, cA1);
            PG8_WAIT_V(8); PG8_WAIT_L(0); PG8_BAR; PG8_MMA(0, 0, At, B0); PG8_MMA(0, 1, At, B1); PG8_BAR; PG8_SCHED;
            PG8_LDA(At, 0, 1); PG8_STAGE(PG8_SB(0, 0), b2, voffB); PG8_STAGE(PG8_SB(0, 1), b2 + hstep, voffB); PG8_STAGE(PG8_SA(0, 0), a2, x0);
            PG8_WAIT_V(8); PG8_WAIT_L(0); PG8_BAR; PG8_MMA(1, 0, At, B0); PG8_MMA(1, 1, At, B1); PG8_BAR; PG8_SCHED;
            PG8_LDB(B0, 1, 0); PG8_LDB(B1, 1, 1); PG8_SCHED; PG8_LDA(At, 1, 0); PG8_STAGE(PG8_SA(0, 1), a2, x1);
            PG8_WAIT_V(8); PG8_WAIT_L(0); PG8_BAR; PG8_MMA(0, 0, At, B0); PG8_MMA(0, 1, At, B1); PG8_BAR; PG8_SCHED;
            PG8_LDA(At, 1, 1); PG8_STAGE(PG8_SB(1, 0), b3, voffB); PG8_STAGE(PG8_SB(1, 1), b3 + hstep, voffB); PG8_STAGE(PG8_SA(1, 0), a3, x0);
            PG8_WAIT_V(8); PG8_WAIT_L(0); PG8_BAR; PG8_MMA(1, 0, At, B0); PG8_MMA(1, 1, At, B1); PG8_BAR; PG8_SCHED;
        }
        if constexpr (ALIGN_EPI) { if (wr == 0) PG8_BAR; }
        E(acc, cur, wr, wc, fr, fq);
        if (!has_next) break;
#pragma unroll
        for (int a = 0; a < 2; ++a)
#pragma unroll
            for (int b = 0; b < 2; ++b)
#pragma unroll
                for (int m = 0; m < 4; ++m)
#pragma unroll
                    for (int n = 0; n < 2; ++n) acc[a][b][m][n] = (f32x4){0.f, 0.f, 0.f, 0.f};
        cur = nxt; cB = nB; ++ui;
#pragma unroll
        for (int i = 0; i < 2; ++i) { cA0[i] = nA0[i]; cA1[i] = nA1[i]; }
        if constexpr (ALIGN_EPI) { if (wr == 1) PG8_BAR; }
    }
    PG8_WAIT_V(0);
    if constexpr (!ALIGN_EPI) { if (wr == 0) PG8_BAR; }
    PG8_BAR;
#undef PG8_SA
#undef PG8_SB
#undef PG8_STAGE
#undef PG8_LDA
#undef PG8_LDB
#undef PG8_MMA
#undef PG8_WAIT_V
#undef PG8_WAIT_L
#undef PG8_BAR
#undef PG8_SCHED
}
}
namespace attn_body {
using bf16=__hip_bfloat16;
using bf16x8=__attribute__((ext_vector_type(8)))short;
using s16x4=__attribute__((ext_vector_type(4)))short;
using f32x16=__attribute__((ext_vector_type(16)))float;
using u32x4=__attribute__((ext_vector_type(4)))unsigned;
using f32x4v=__attribute__((ext_vector_type(4)))float;
constexpr int BATCH=4,NHEAD=12,SEQ=4096,D=64;
constexpr int QP=768,KP=768,VP=768,OP=1024;
constexpr int NW=8,QBLK=32,QB=QBLK*NW,KVBLK=64,NQB=SEQ/QB;
constexpr int ATTN_UNIT_ROWS=QB;
__device__ __forceinline__ int crow(int r,int hi){return (r&3)+8*(r>>2)+4*hi;}
#define SBAR() __builtin_amdgcn_sched_barrier(0)
__device__ __forceinline__ void cmask(f32x16&p0,f32x16&p1,int jb,int qrel,int hi){
  const float NEG=-INFINITY; int kb=64*jb+4*hi;
  #pragma unroll
  for(int r=0;r<16;++r){int kv=kb+(r&3)+8*(r>>2); if(kv>qrel)p0[r]=NEG; if(kv+32>qrel)p1[r]=NEG;}
}

constexpr int NSLOT=3, SLOTB=8192;
constexpr int LDS_K=0, LDS_V=NSLOT*SLOTB, LDS_WS=2*NSLOT*SLOTB, LDS_OST=LDS_WS+NW*64*4, LDS_BYTES=LDS_OST+NW*4096, LDS_F=86016, LDS_F_BYTES=16384;
constexpr float C2=0.125f*1.4426950408889634f;
__device__ __forceinline__ void glds16(const void*gsrc,unsigned lds_dst){unsigned keep;
  asm volatile("s_mov_b32 %0, m0\n\ts_mov_b32 m0, %2\n\ts_nop 0\n\tglobal_load_lds_dwordx4 %1, off\n\ts_mov_b32 m0, %0":"=&s"(keep):"v"(gsrc),"s"(lds_dst):"memory");}
__device__ __forceinline__ float max3f(float a,float b,float c){float r;asm("v_max3_f32 %0, %1, %2, %3":"=v"(r):"v"(a),"v"(b),"v"(c));return r;}
__device__ __forceinline__ float max2f(float a,float b){float r;asm("v_max_f32_e32 %0, %1, %2":"=v"(r):"v"(a),"v"(b));return r;}
__device__ __forceinline__ float fadd_s(float a,float b){float r;asm("v_add_f32_e32 %0, %1, %2":"=v"(r):"v"(a),"v"(b));return r;}
__device__ __forceinline__ float fsub_s(float a,float b){float r;asm("v_sub_f32_e32 %0, %1, %2":"=v"(r):"v"(a),"v"(b));return r;}
typedef float f32x2_t __attribute__((ext_vector_type(2))); typedef __bf16 bf16x2_t __attribute__((ext_vector_type(2)));
__device__ __forceinline__ unsigned cvtpk_s(float lo,float hi){f32x2_t v={lo,hi};bf16x2_t b=__builtin_convertvector(v,bf16x2_t);return __builtin_bit_cast(unsigned,b);}
#define WAIT_BAR(N) asm volatile("s_waitcnt vmcnt(" #N ") lgkmcnt(0)\n\ts_barrier":::"memory")

__device__ __forceinline__ void qkt(f32x16&p0,f32x16&p1,const char*Kslot,const bf16x8*qr,int r32,int hi){
  const char*kb=Kslot+hi*1024+r32*16;
  #pragma unroll
  for(int d0=0;d0<4;++d0){
    const bf16x8 b0=*reinterpret_cast<const bf16x8*>(kb+d0*2048);
    const bf16x8 b1=*reinterpret_cast<const bf16x8*>(kb+d0*2048+512);
    p0=__builtin_amdgcn_mfma_f32_32x32x16_bf16(b0,qr[d0],p0,0,0,0);p1=__builtin_amdgcn_mfma_f32_32x32x16_bf16(b1,qr[d0],p1,0,0,0);}
}
typedef __attribute__((address_space(3))) const char* lds_cptr;
typedef short v4i16_t __attribute__((ext_vector_type(4)));
__device__ __forceinline__ void kload8(bf16x8*kf,lds_cptr kp){
  kf[0]=*(const __attribute__((address_space(3))) bf16x8*)(kp);      kf[1]=*(const __attribute__((address_space(3))) bf16x8*)(kp+512);
  kf[2]=*(const __attribute__((address_space(3))) bf16x8*)(kp+2048); kf[3]=*(const __attribute__((address_space(3))) bf16x8*)(kp+2560);
  kf[4]=*(const __attribute__((address_space(3))) bf16x8*)(kp+4096); kf[5]=*(const __attribute__((address_space(3))) bf16x8*)(kp+4608);
  kf[6]=*(const __attribute__((address_space(3))) bf16x8*)(kp+6144); kf[7]=*(const __attribute__((address_space(3))) bf16x8*)(kp+6656);
}
__device__ __forceinline__ void kload2(bf16x8*kf,lds_cptr kp,int j){ kf[2*j]=*(const __attribute__((address_space(3))) bf16x8*)(kp+j*2048); kf[2*j+1]=*(const __attribute__((address_space(3))) bf16x8*)(kp+j*2048+512); }
__device__ __forceinline__ s16x4 vtr(lds_cptr p){ return __builtin_bit_cast(s16x4,__builtin_amdgcn_ds_read_tr16_b64_v4i16((__attribute__((address_space(3))) v4i16_t*)p)); }
__device__ __forceinline__ float rowmax(const f32x16&p0,const f32x16&p1){
  float a=max3f(p0[0],p0[1],p1[0]),b=max3f(p0[2],p0[3],p1[1]);a=max3f(a,p1[2],p1[3]);
  #pragma unroll
  for(int r=4;r<16;r+=4){a=max3f(a,p0[r],p0[r+1]);b=max3f(b,p0[r+2],p0[r+3]);a=max3f(a,p1[r],p1[r+1]);b=max3f(b,p1[r+2],p1[r+3]);}
  const float m=max2f(a,b);
  auto rr=__builtin_amdgcn_permlane32_swap(__float_as_uint(m),__float_as_uint(m),false,false);
  return max2f(__uint_as_float(rr[0]),__uint_as_float(rr[1]));
}
__device__ __forceinline__ void pv(f32x16*o,int vb,bf16x8 pa0,bf16x8 pa1,bf16x8 pa2,bf16x8 pa3){
  #pragma unroll
  for(int d0=0;d0<2;++d0){s16x4 lo[4],hi[4];
    #pragma unroll
    for(int ks=0;ks<4;++ks){
      asm volatile("ds_read_b64_tr_b16 %0,%1 offset:%c2":"=&v"(lo[ks]):"v"(vb),"i"(d0*4096+ks*1024):"memory");
      asm volatile("ds_read_b64_tr_b16 %0,%1 offset:%c2":"=&v"(hi[ks]):"v"(vb),"i"(d0*4096+ks*1024+512):"memory");}
    asm volatile("s_waitcnt lgkmcnt(0)":::"memory");SBAR();
    #define PK(k) (bf16x8){lo[k][0],lo[k][1],lo[k][2],lo[k][3],hi[k][0],hi[k][1],hi[k][2],hi[k][3]}
    o[d0]=__builtin_amdgcn_mfma_f32_32x32x16_bf16(pa0,PK(0),o[d0],0,0,0);
    o[d0]=__builtin_amdgcn_mfma_f32_32x32x16_bf16(pa1,PK(1),o[d0],0,0,0);
    o[d0]=__builtin_amdgcn_mfma_f32_32x32x16_bf16(pa2,PK(2),o[d0],0,0,0);
    o[d0]=__builtin_amdgcn_mfma_f32_32x32x16_bf16(pa3,PK(3),o[d0],0,0,0);
    #undef PK
  }
}

#ifndef ATTN_STORE16
#define ATTN_STORE16(p,v) (*(u32x4*)(p)=(v))
#endif
template<int THRL> __device__ __forceinline__ void attn_unit(int b,int h,int qb,const bf16*Q,const bf16*__restrict__ K,const bf16*__restrict__ V,bf16*O,const float*F2seq,char*shm){
  const int tid=threadIdx.x,lane=tid&63,r32=lane&31,hi=lane>>5; const int wid=__builtin_amdgcn_readfirstlane(tid>>6);
  const long rowbase=(long)b*SEQ; const int q0=qb*QB;
  typedef __attribute__((address_space(3))) float* lds_fptr; typedef __attribute__((address_space(3))) f32x4v* lds_f4ptr;
  const lds_fptr Fl=(lds_fptr)(shm+LDS_F);
  { const f32x4v*Fg=(const f32x4v*)F2seq; const int nF=(q0+QB)>>2; for(int i=tid;i<nF;i+=NW*64)((lds_f4ptr)Fl)[i]=Fg[i]; }
  const float fq2=F2seq[q0+wid*QBLK+r32];
  const bf16*Qw=Q+(rowbase+q0+wid*QBLK)*QP+h*D;
  const bf16*Kh=K+rowbase*KP+h*D,*Vh=V+rowbase*VP+h*D;
  const unsigned lds0=(unsigned)(uintptr_t)shm;
  float*wsf=(float*)(shm+LDS_WS)+wid*64;
  const bf16*ksrc=Kh+(long)lane*KP+wid*8;
  const bf16*vsrc=Vh+(long)(16*(wid&3)+(lane>>2))*VP+(wid>>2)*32+(lane&3)*8;
  const unsigned kdst=lds0+LDS_K+wid*1024, vdst=lds0+LDS_V+wid*1024;
  #define DMA_K(t,slot) glds16(ksrc+(long)(t)*KVBLK*KP,(unsigned)__builtin_amdgcn_readfirstlane(kdst+(slot)))
  #define DMA_V(t,slot) glds16(vsrc+(long)(t)*KVBLK*VP,(unsigned)__builtin_amdgcn_readfirstlane(vdst+(slot)))
  const int vb0=(int)(lds0+LDS_V)+((lane>>4)&1)*32+(lane&3)*8+(4*hi+((lane&15)>>2))*64;
  const char*Kbase=shm+LDS_K; bf16x8 kf[8];
  const lds_cptr shm3=(lds_cptr)shm; const lds_cptr kp0=shm3+LDS_K+hi*1024+r32*16; const lds_cptr vp0=shm3+LDS_V+((lane>>4)&1)*32+(lane&3)*8+(4*hi+((lane&15)>>2))*64;
  const int NT=(q0+QB)/KVBLK;
  DMA_K(0,0);DMA_V(0,0);DMA_K(1,SLOTB);
  bf16x8 qr[4];
  #pragma unroll
  for(int d0=0;d0<4;++d0)qr[d0]=*reinterpret_cast<const bf16x8*>(&Qw[(long)r32*QP+d0*16+hi*8]);
  float mhat=0.f,l_reg=0.f;f32x16 o[2];o[0]=f32x16{};o[1]=f32x16{};
  #define BIAS(C0,C1,t) do{ const float nb_=fq2-mhat; const lds_fptr fk_=Fl+64*(t)+4*hi; \
    _Pragma("unroll") for(int j_=0;j_<4;++j_){ const f32x4v a_=*(const lds_f4ptr)(fk_+8*j_); const f32x4v c_=*(const lds_f4ptr)(fk_+32+8*j_); \
      C0[4*j_]=nb_-a_.x; C0[4*j_+1]=nb_-a_.y; C0[4*j_+2]=nb_-a_.z; C0[4*j_+3]=nb_-a_.w; C1[4*j_]=nb_-c_.x; C1[4*j_+1]=nb_-c_.y; C1[4*j_+2]=nb_-c_.z; C1[4*j_+3]=nb_-c_.w; } }while(0)
  const int qrel=wid*QBLK+r32;
  #define CMASK(P0,P1,t) do{int jb_=(t)-(NT-4); if(jb_>=0)cmask(P0,P1,jb_,qrel,hi);}while(0)
  bool resc=false;
  #define START(P0,P1) do{ const float rm=rowmax(P0,P1); resc=false; \
    { const float dl=rm; mhat=fadd_s(mhat,dl); \
      _Pragma("unroll") for(int r=0;r<16;++r){P0[r]=fsub_s(P0[r],dl);P1[r]=fsub_s(P1[r],dl);} } \
    _Pragma("unroll") for(int r=0;r<16;++r)P0[r]=__builtin_amdgcn_exp2f(P0[r]); }while(0)
  #define RESC() do{ if(resc){ asm volatile("s_waitcnt lgkmcnt(0)":::"memory"); \
      _Pragma("unroll") for(int d_=0;d_<2;++d_) _Pragma("unroll") for(int r=0;r<16;++r)o[d_][r]*=wsf[crow(r,hi)]; } }while(0)
  f32x16 pA0,pA1,pB0,pB1;
  int sl_prev=0,sl_cur=0,sl_next=SLOTB;
  #define ROT() do{sl_prev=sl_cur;sl_cur=sl_next;sl_next=(sl_next==(NSLOT-1)*SLOTB)?0:sl_next+SLOTB;}while(0)
  DMA_K(2,2*SLOTB);
  WAIT_BAR(3);
  BIAS(pA0,pA1,0); qkt(pA0,pA1,Kbase,qr,r32,hi);asm volatile("s_nop 15\n\ts_nop 7":"+v"(pA0),"+v"(pA1));CMASK(pA0,pA1,0);
  START(pA0,pA1);
  _Pragma("unroll") for(int r=0;r<16;++r)pA1[r]=__builtin_amdgcn_exp2f(pA1[r]);
  WAIT_BAR(0);
  DMA_K(3,0);DMA_V(1,SLOTB);
  ROT();
  kload8(kf,kp0+sl_cur);
  WAIT_BAR(2);
  s16x4 vlo[8],vhi[8]; u32x4 pw0,pw1,pw2,pw3;
  #define PKW(P,B) cvtpk_s(P[B],P[B+1])
  #define PAF(k) __builtin_bit_cast(bf16x8,pw##k)
  #define VFR(i) (bf16x8){vlo[i][0],vlo[i][1],vlo[i][2],vlo[i][3],vhi[i][0],vhi[i][1],vhi[i][2],vhi[i][3]}
  #define PIN(x) asm volatile("":"+v"(x))
  #define MX3(a,b,c) __builtin_fmaxf(__builtin_fmaxf((a),(b)),(c))
  #define GAPA(MF,A0,A1,A2,A3,W0,W1,PW) do{ MF; sacc+=A0; sacc+=A1; sacc+=A2; sacc+=A3; PIN(sacc); W0; W1; PIN(PW); SBAR(); }while(0)
  #define EX(v) __builtin_amdgcn_exp2f(v)
  #define GAPB(MF,X,B) do{ MF; X[B]=EX(X[B]); X[B+1]=EX(X[B+1]); X[B+2]=EX(X[B+2]); X[B+3]=EX(X[B+3]); PIN(X); SBAR(); }while(0)
  #define VRD(i) do{ vlo[i]=vtr(vp_+(((i)>>2)*4096+((i)&3)*1024)); vhi[i]=vtr(vp_+(((i)>>2)*4096+((i)&3)*1024+512)); }while(0)
  #define KRD(G,j) do{ if(G){ kload2(kf,kp0+sl_next,j); SBAR(); } }while(0)
  #define STEP(C0,C1,P0,P1,t,GK,GV,GL) do{ BIAS(C0,C1,t); SBAR(); \
    const lds_cptr vp_=vp0+sl_prev; \
    VRD(0); SBAR(); float sacc=(P0[0]+P0[1]); \
    GAPA(C0=__builtin_amdgcn_mfma_f32_32x32x16_bf16(kf[0],qr[0],C0,0,0,0), P0[2],P0[3],P0[4],P0[5],     pw0[0]=PKW(P0,0), pw0[1]=PKW(P0,2), pw0); \
    VRD(4); SBAR(); GAPA(C1=__builtin_amdgcn_mfma_f32_32x32x16_bf16(kf[1],qr[0],C1,0,0,0), P0[6],P0[7],P0[8],P0[9],     pw0[2]=PKW(P0,4), pw0[3]=PKW(P0,6), pw0); \
    VRD(1); SBAR(); GAPA(C0=__builtin_amdgcn_mfma_f32_32x32x16_bf16(kf[2],qr[1],C0,0,0,0),   P0[10],P0[11],P0[12],P0[13], pw1[0]=PKW(P0,8), pw1[1]=PKW(P0,10), pw1); \
    VRD(5); SBAR(); GAPA(C1=__builtin_amdgcn_mfma_f32_32x32x16_bf16(kf[3],qr[1],C1,0,0,0),   P0[14],P0[15],P1[0],P1[1],   pw1[2]=PKW(P0,12),pw1[3]=PKW(P0,14), pw1); \
    VRD(2); SBAR(); GAPA(C0=__builtin_amdgcn_mfma_f32_32x32x16_bf16(kf[4],qr[2],C0,0,0,0),   P1[2],P1[3],P1[4],P1[5],     pw2[0]=PKW(P1,0), pw2[1]=PKW(P1,2), pw2); \
    VRD(6); SBAR(); GAPA(C1=__builtin_amdgcn_mfma_f32_32x32x16_bf16(kf[5],qr[2],C1,0,0,0),   P1[6],P1[7],P1[8],P1[9],     pw2[2]=PKW(P1,4), pw2[3]=PKW(P1,6), pw2); \
    VRD(3); SBAR(); GAPA(C0=__builtin_amdgcn_mfma_f32_32x32x16_bf16(kf[6],qr[3],C0,0,0,0),   P1[10],P1[11],P1[12],P1[13], pw3[0]=PKW(P1,8), pw3[1]=PKW(P1,10), pw3); \
    VRD(7); SBAR(); GAPA(C1=__builtin_amdgcn_mfma_f32_32x32x16_bf16(kf[7],qr[3],C1,0,0,0),   P1[14],P1[15],0.f,0.f,       pw3[2]=PKW(P1,12),pw3[3]=PKW(P1,14), pw3); \
    l_reg+=sacc; \
    if(GK){DMA_K((t)+3,sl_cur);} if(GV){DMA_V((t)+1,sl_next);} \
    CMASK(C0,C1,t); \
    { float a=MX3(C0[0],C0[1],C1[0]),b=MX3(C0[2],C0[3],C1[1]); a=MX3(a,C1[2],C1[3]); \
      _Pragma("unroll") for(int r=4;r<16;r+=4){a=MX3(a,C0[r],C0[r+1]);b=MX3(b,C0[r+2],C0[r+3]);a=MX3(a,C1[r],C1[r+1]);b=MX3(b,C1[r+2],C1[r+3]);} \
      float rm=__builtin_fmaxf(a,b); { auto rr=__builtin_amdgcn_permlane32_swap(__float_as_uint(rm),__float_as_uint(rm),false,false); rm=__builtin_fmaxf(__uint_as_float(rr[0]),__uint_as_float(rr[1])); } \
      resc=false; \
      if(__builtin_expect(__any(rm>(float)THRL),0)){ const float dl=__builtin_fmaxf(rm,0.f); mhat+=dl; \
        _Pragma("unroll") for(int r=0;r<16;++r){C0[r]-=dl;C1[r]-=dl;} \
        const float f=__builtin_amdgcn_exp2f(-dl); l_reg*=f; if(hi==0)wsf[r32]=f; resc=true; } } \
    SBAR(); \
    GAPB(o[0]=__builtin_amdgcn_mfma_f32_32x32x16_bf16(PAF(0),VFR(0),o[0],0,0,0), C0,0); \
    GAPB(o[1]=__builtin_amdgcn_mfma_f32_32x32x16_bf16(PAF(0),VFR(4),o[1],0,0,0), C0,4); \
    KRD(GL,0); GAPB(o[0]=__builtin_amdgcn_mfma_f32_32x32x16_bf16(PAF(1),VFR(1),o[0],0,0,0), C0,8); \
    KRD(GL,1); GAPB(o[1]=__builtin_amdgcn_mfma_f32_32x32x16_bf16(PAF(1),VFR(5),o[1],0,0,0), C0,12); \
    KRD(GL,2); GAPB(o[0]=__builtin_amdgcn_mfma_f32_32x32x16_bf16(PAF(2),VFR(2),o[0],0,0,0), C1,0); \
    KRD(GL,3); GAPB(o[1]=__builtin_amdgcn_mfma_f32_32x32x16_bf16(PAF(2),VFR(6),o[1],0,0,0), C1,4); \
    GAPB(o[0]=__builtin_amdgcn_mfma_f32_32x32x16_bf16(PAF(3),VFR(3),o[0],0,0,0), C1,8); \
    GAPB(o[1]=__builtin_amdgcn_mfma_f32_32x32x16_bf16(PAF(3),VFR(7),o[1],0,0,0), C1,12); \
    }while(0)
  int t=1;
  #undef CMASK
  #define CMASK(P0,P1,t) do{}while(0)
  for(;t+5<NT;t+=2){
    STEP(pB0,pB1,pA0,pA1,t,true,true,true);     WAIT_BAR(2); RESC(); ROT();
    STEP(pA0,pA1,pB0,pB1,t+1,true,true,true);   WAIT_BAR(2); RESC(); ROT();
  }
  #undef CMASK
  #define CMASK(P0,P1,t) do{int jb_=(t)-(NT-4); if(jb_>=0)cmask(P0,P1,jb_,qrel,hi);}while(0)
  #define ENDW(tt) do{ if((tt)+3<NT){WAIT_BAR(2);} else if((tt)+2<NT){WAIT_BAR(1);} else {WAIT_BAR(0);} }while(0)
  for(;t+1<NT;t+=2){
    STEP(pB0,pB1,pA0,pA1,t,(t+3<NT),(t+1<NT),(t+1<NT));       ENDW(t);   RESC(); ROT();
    STEP(pA0,pA1,pB0,pB1,t+1,(t+4<NT),(t+2<NT),(t+2<NT));     ENDW(t+1); RESC(); ROT();
  }
  STEP(pB0,pB1,pA0,pA1,NT-1,false,false,false); RESC();
  { float sacc=pB0[0]+pB0[1]; _Pragma("unroll") for(int r=2;r<16;++r)sacc+=pB0[r]; _Pragma("unroll") for(int r=0;r<16;++r)sacc+=pB1[r]; l_reg+=sacc;
    pw0=(u32x4){PKW(pB0,0),PKW(pB0,2),PKW(pB0,4),PKW(pB0,6)};pw1=(u32x4){PKW(pB0,8),PKW(pB0,10),PKW(pB0,12),PKW(pB0,14)};pw2=(u32x4){PKW(pB1,0),PKW(pB1,2),PKW(pB1,4),PKW(pB1,6)};pw3=(u32x4){PKW(pB1,8),PKW(pB1,10),PKW(pB1,12),PKW(pB1,14)};
    SBAR(); pv(o,vb0+sl_cur,PAF(0),PAF(1),PAF(2),PAF(3)); }
  #undef PKW
  #undef PAF
  #undef VFR
  #undef PIN
  #undef MX3
  #undef GAPA
  #undef GAPB
  #undef EX
  #undef VRD
  #undef KRD
  #undef STEP
  #undef ENDW
  {auto rr=__builtin_amdgcn_permlane32_swap(__float_as_uint(l_reg),__float_as_uint(l_reg),false,false);l_reg=__uint_as_float(rr[0])+__uint_as_float(rr[1]);}
  if(hi==0)wsf[32+r32]=l_reg;asm volatile("s_waitcnt lgkmcnt(0)":::"memory");
  float rli[16];
  #pragma unroll
  for(int r=0;r<16;++r)rli[r]=__builtin_amdgcn_rcpf(wsf[32+crow(r,hi)]);
  bf16*Ow=O+(rowbase+q0+wid*QBLK)*OP+h*D;
  { bf16*stg=(bf16*)(shm+LDS_OST)+wid*2048;
    #pragma unroll
    for(int r=0;r<16;++r){const int orow=crow(r,hi);
      #pragma unroll
      for(int d0=0;d0<2;++d0)stg[orow*64+d0*32+r32]=__float2bfloat16(o[d0][r]*rli[r]);}
    asm volatile("s_waitcnt lgkmcnt(0)":::"memory");
    #pragma unroll
    for(int i=0;i<4;++i){const int row=i*8+(lane>>3),ch=lane&7; const u32x4 v=*(const u32x4*)(stg+row*64+ch*8); ATTN_STORE16(Ow+(long)row*OP+ch*8,v);} }
  asm volatile("s_waitcnt lgkmcnt(0)\n\ts_barrier":::"memory");
  #undef DMA_K
  #undef DMA_V
  #undef CMASK
  #undef START
  #undef RESC
  #undef BIAS
  #undef ROT
}
constexpr int ATTN_LDS_BYTES=LDS_F+LDS_F_BYTES;
#undef SBAR
#undef WAIT_BAR
}
#define GAS __attribute__((address_space(1)))
#define LAS __attribute__((address_space(3)))
typedef unsigned short bf16;
typedef unsigned v4u __attribute__((ext_vector_type(4)));
typedef float f32x4 __attribute__((ext_vector_type(4)));
typedef short bf16x8 __attribute__((ext_vector_type(8)));
typedef GAS unsigned gu32;
typedef GAS unsigned long long gu64;
#define RLX_AGENT __ATOMIC_RELAXED, __HIP_MEMORY_SCOPE_AGENT
#define LDS_WAIT() asm volatile("s_waitcnt lgkmcnt(0)" ::: "memory")
#define VM_WAIT() asm volatile("s_waitcnt vmcnt(0)" ::: "memory")
__device__ __forceinline__ unsigned long long rt() { return __builtin_amdgcn_s_memrealtime(); }
__device__ __forceinline__ unsigned f2bf(float f) { unsigned u = __builtin_bit_cast(unsigned, f); return (u + 0x7fffu + ((u >> 16) & 1u)) >> 16; }
__device__ __forceinline__ unsigned pk2(float lo, float hi) { return f2bf(lo) | (f2bf(hi) << 16); }

#define XB_TMO      128
#define XB_XCNT(j)  (256  + 64 * (j))
#define XB_XSUB(j)  (1280 + 64 * (j))
#define XB_XGEN(j)  (2304 + 64 * (j))
#define XB_TOP      3328
#define XB_TOPGEN   3392
#define XCD_BAR_WORDS 3456
#define XB_SPIN_CAP (1u << 18)

__device__ __forceinline__ unsigned xb_ld(unsigned* p)              { return __hip_atomic_load(p, __ATOMIC_RELAXED, __HIP_MEMORY_SCOPE_AGENT); }
__device__ __forceinline__ unsigned xb_add(unsigned* p, unsigned v) { return __hip_atomic_fetch_add(p, v, __ATOMIC_RELAXED, __HIP_MEMORY_SCOPE_AGENT); }
__device__ __forceinline__ unsigned xb_xcc_id() { return (unsigned)__builtin_amdgcn_s_getreg((3 << 11) | 20) & 0xFu; }
#define XB_SPIN(cond, bar) do { unsigned _sp = 0; while (cond) { __builtin_amdgcn_s_sleep(1); \
    if ((++_sp & 255u) == 0u) { if (xb_ld(&(bar)[XB_TMO])) break; if (_sp > XB_SPIN_CAP) { atomicAdd(&(bar)[XB_TMO], 1u); break; } } } } while (0)

struct XcdBarrier {
    unsigned* bar; unsigned x;
    volatile LAS unsigned* st;
};

__device__ __forceinline__ XcdBarrier xcd_barrier_post(unsigned* bar, volatile LAS unsigned* st) {
    XcdBarrier b; b.bar = bar; b.x = xb_xcc_id(); b.st = st;
    if (threadIdx.x == 0) (void)xb_add(&bar[XB_XCNT(b.x)], 1u);
    return b;
}
__device__ __forceinline__ void xcd_barrier_complete(unsigned* bar, unsigned x, unsigned& nloc, unsigned& nx) {
    const unsigned G = gridDim.x * gridDim.y * gridDim.z;
    unsigned sum, cnt, mine, sp = 0u;
    for (;;) {
        sum = 0u; cnt = 0u; mine = 0u;
#pragma unroll
        for (unsigned j = 0; j < 16; ++j) { const unsigned c = xb_ld(&bar[XB_XCNT(j)]); sum += c; cnt += (c > 0u) ? 1u : 0u; mine = (j == x) ? c : mine; }
        if (sum == G) break;
        __builtin_amdgcn_s_sleep(1);
        if ((++sp & 255u) == 0u) { if (xb_ld(&bar[XB_TMO])) break; if (sp > XB_SPIN_CAP) { atomicAdd(&bar[XB_TMO], 1u); break; } }
    }
    nloc = mine > 0u ? mine : 1u; nx = cnt > 0u ? cnt : 1u;
}

__device__ __forceinline__ void xcd_barrier(const XcdBarrier& b) {
    asm volatile("s_waitcnt vmcnt(0)" ::: "memory");
    __syncthreads();
    if (threadIdx.x == 0) {
        unsigned* bar = b.bar;
        __builtin_amdgcn_s_waitcnt(0);
        unsigned nloc = b.st[0], nx = b.st[1];
        if (nloc == 0u) { xcd_barrier_complete(bar, b.x, nloc, nx); b.st[0] = nloc; b.st[1] = nx; }
        const unsigned old = xb_add(&bar[XB_XSUB(b.x)], 1u);
        const unsigned gen = old / nloc;
        if (old + 1u == (gen + 1u) * nloc) {
            __builtin_amdgcn_fence(__ATOMIC_RELEASE, "agent");
            asm volatile("s_waitcnt vmcnt(0)" ::: "memory");
            const unsigned og = xb_add(&bar[XB_TOP], 1u);
            const unsigned tg = og / nx;
            if (og + 1u == (tg + 1u) * nx) xb_add(&bar[XB_TOPGEN], 1u);
            else XB_SPIN(xb_ld(&bar[XB_TOPGEN]) == tg, bar);
            __builtin_amdgcn_fence(__ATOMIC_ACQUIRE, "agent");
            xb_add(&bar[XB_XGEN(b.x)], 1u);
            asm volatile("s_waitcnt vmcnt(0)" ::: "memory");
        } else {
            XB_SPIN(xb_ld(&bar[XB_XGEN(b.x)]) == gen, bar);
            __builtin_amdgcn_fence(__ATOMIC_ACQUIRE, "agent");
            asm volatile("s_waitcnt vmcnt(0)" ::: "memory");
        }
    }
    __syncthreads();
}
constexpr int NWAVES = 8, NTHR = NWAVES * 64;
constexpr int T_ = 16384, DM_ = 1024, SEQ_ = 4096, NBH = 48, NHEADS = 12;
constexpr int EV_LD = 2828, EV_N = 2816;
constexpr int NEXP = 16, EHID = 256, SLOTS = 36864;
constexpr float EPS_ = 1e-6f, LOG2E = 1.4426950408889634f;
constexpr int NPH = 15;
constexpr size_t MiB = 1u << 20;
constexpr size_t WS_CTL = 0, CTL_ZERO_BYTES = 1 * MiB;
constexpr size_t WS_WIN0 = 1 * MiB, WS_WOUT0 = 7 * MiB, WS_WIN1 = 9 * MiB, WS_WOUT1 = 13 * MiB, WS_WST = 15 * MiB, WS_WGU = 16 * MiB, WS_WD = 48 * MiB;
constexpr size_t WS_XN = 64 * MiB;
constexpr size_t WS_A = 96 * MiB;
constexpr size_t WS_U = WS_A, WS_V = WS_A + 8 * MiB, WS_Q = WS_A + 16 * MiB, WS_K = WS_A + 40 * MiB, WS_VAL = WS_A + 64 * MiB;
constexpr size_t WS_Y = WS_A, WS_H1 = WS_A;
constexpr size_t WS_MIX = 184 * MiB;
constexpr size_t WS_HID = 216 * MiB;
constexpr size_t WS_F2 = 234 * MiB, WS_LIST = 235 * MiB, WS_LISTW = 236 * MiB, WS_TOKE = 237 * MiB, WS_TOKP = 237 * MiB + 512 * 1024, WS_END = 240 * MiB;
static_assert(WS_Y + (size_t)SLOTS * 1024 * 2 <= WS_MIX && WS_HID + (size_t)SLOTS * 256 * 2 <= WS_F2 && WS_VAL + (size_t)T_ * 768 * 2 <= WS_MIX, "ws map");
constexpr int CW_TMO = 0, CW_BAR = 4096, CW_Q = 8192, CW_CNT0 = 8256, CW_CNT1 = 8320;
constexpr int RING_BYTES = 131072, LDSCTL_OFF = RING_BYTES, MISC_OFF = LDSCTL_OFF + 320, LDS_BYTES = 147456;

__device__ __forceinline__ float wave_sum(float v) {
#pragma unroll
    for (int o = 1; o < 64; o <<= 1) v += __shfl_xor(v, o);
    return v;
}
__device__ __forceinline__ float fast_sigmoid(float z) { return __builtin_amdgcn_rcpf(1.f + __builtin_amdgcn_exp2f(-z * LOG2E)); }
__device__ __forceinline__ float gelu_tanh(float x) { const float z = 1.5957691216057308f * x * (1.f + 0.044715f * x * x); return x * fast_sigmoid(z); }
__device__ __forceinline__ float bf2f(unsigned short h) { return __builtin_bit_cast(float, (unsigned)h << 16); }

__device__ __forceinline__ void tr_item(const float* W, int ldw, bf16* WT, int Kp, LAS float* scr, int k0, int n0, int drow0, int lane) {
#pragma unroll 8
    for (int i = 0; i < 32; ++i) { const int kk = 2 * i + (lane >> 5); scr[kk * 33 + (lane & 31)] = W[(size_t)(k0 + kk) * ldw + n0 + (lane & 31)]; }
    LDS_WAIT(); asm volatile("" ::: "memory");
    const int c = lane & 7;
#pragma unroll
    for (int j = 0; j < 4; ++j) { const int n = (lane >> 3) + 8 * j; const LAS float* s = scr + (8 * c) * 33 + n;
        v4u o; o.x = pk2(s[0 * 33], s[1 * 33]); o.y = pk2(s[2 * 33], s[3 * 33]); o.z = pk2(s[4 * 33], s[5 * 33]); o.w = pk2(s[6 * 33], s[7 * 33]);
        *(GAS v4u*)(WT + (size_t)(drow0 + n) * Kp + k0 + 8 * c) = o; }
    LDS_WAIT(); asm volatile("" ::: "memory");
}
struct P0Args { const float* const* in; unsigned char* ws; };
template <class IN_T> __device__ __forceinline__ void p0_prologue(const IN_T in, unsigned char* ws, LAS unsigned char* lds, int G, int vcu) {
    const int tid = threadIdx.x, lane = tid & 63, wave = __builtin_amdgcn_readfirstlane(tid >> 6);
    LAS float* scr = (LAS float*)(lds + wave * 16384);
    const int gw = vcu * NWAVES + wave, NGW = G * NWAVES;
    constexpr int I0 = 16 * 88, I1 = 16 * 32, I2 = 16 * 64, I3 = 8 * 32, I4 = 32 * 128, NITEMS = I0 + I1 + I2 + I3 + 3 * I4;
    { const float* const w_in0 = in[2]; const float* const w_out0 = in[9]; const float* const w_in1 = in[11]; const float* const w_out1 = in[15]; const float* const w_gate = in[21]; const float* const w_up = in[22]; const float* const w_down = in[23];
    for (int it = gw; it < NITEMS; it += NGW) {
        int r = it;
        if (r < I0) { const int kb = r / 88, nb = r % 88, n0 = 32 * nb, c = n0 & 255;
            tr_item(w_in0, EV_LD, (bf16*)(ws + WS_WIN0), 1024, scr, 64 * kb, n0, (n0 & ~255) + 128 * ((c >> 5) & 1) + 32 * (c >> 6), lane); continue; } r -= I0;
        if (r < I1) { const int kb = r / 32, nb = r % 32; tr_item(w_out0, 1024, (bf16*)(ws + WS_WOUT0), 1024, scr, 64 * kb, 32 * nb, 32 * nb, lane); continue; } r -= I1;
        if (r < I2) { const int kb = r / 64, nb = r % 64; tr_item(w_in1, 2048, (bf16*)(ws + WS_WIN1), 1024, scr, 64 * kb, 32 * nb, 32 * nb, lane); continue; } r -= I2;
        if (r < I3) { const int kb = r / 32, nb = r % 32; tr_item(w_out1, 1024, (bf16*)(ws + WS_WOUT1), 1024, scr, 64 * kb, 32 * nb, 32 * nb, lane); continue; } r -= I3;
        if (r < I4) { const int le = r / 128, rr = r % 128, kb = rr / 8, n0 = 32 * (rr % 8);
            tr_item(w_gate + (size_t)le * 1024 * 256, 256, (bf16*)(ws + WS_WGU) + (size_t)le * 512 * 1024, 1024, scr, 64 * kb, n0, (n0 >> 7) * 256 + (n0 & 127), lane); continue; } r -= I4;
        if (r < I4) { const int le = r / 128, rr = r % 128, kb = rr / 8, n0 = 32 * (rr % 8);
            tr_item(w_up + (size_t)le * 1024 * 256, 256, (bf16*)(ws + WS_WGU) + (size_t)le * 512 * 1024, 1024, scr, 64 * kb, n0, (n0 >> 7) * 256 + 128 + (n0 & 127), lane); continue; } r -= I4;
        { const int le = r / 128, rr = r % 128, kb = rr / 32, n0 = 32 * (rr % 32);
            tr_item(w_down + (size_t)le * 256 * 1024, 1024, (bf16*)(ws + WS_WD) + (size_t)le * 1024 * 256, 256, scr, 64 * kb, n0, n0, lane); }
    } }
    const int gt = vcu * NTHR + tid, NGT = G * NTHR;
    { const float* const w_s = in[4]; for (int i = gt; i < 4 * 128 * 128; i += NGT) { const int s = i & 127, t = (i >> 7) & 127; ((GAS bf16*)(ws + WS_WST))[i] = (s <= t) ? (bf16)f2bf(w_s[i]) : (bf16)0; } }
    { const float* const w_pool = in[13]; const float* const p_scale = in[14]; const float* const w_out1 = in[15];
    for (int i = gt; i < 512 * 1024; i += NGT) { const int n = i & 1023, kk = i >> 10, g = kk >> 7;
        const float* wp = w_pool + (size_t)kk * 128; const float* sc = p_scale + g * 128; const float* wo = w_out1 + (size_t)(512 + g * 128) * 1024 + n;
        float a = 0.f;
#pragma unroll 8
        for (int d = 0; d < 128; ++d) a += wp[d] * sc[d] * wo[(size_t)d * 1024];
        ((GAS bf16*)(ws + WS_WOUT1))[(size_t)n * 1024 + 512 + kk] = (bf16)f2bf(a); } }
    __syncthreads();
    LAS float* wf = (LAS float*)lds;
    const float* const x = in[0]; const float* const gn = in[1]; const float* const b_forget = in[3];
    { const float* const w_in0 = in[2]; for (int i = tid; i < 1024 * 12; i += NTHR) { const int k = i / 12, h = i % 12; wf[i] = w_in0[(size_t)k * EV_LD + EV_N + h] * gn[k]; } }
    __syncthreads();
    for (int m = gw; m < T_; m += NGW) {
        const GAS f32x4* xr = (const GAS f32x4*)(x + (size_t)m * DM_) + lane;
        float ss = 0.f; float a[12];
#pragma unroll
        for (int h = 0; h < 12; ++h) a[h] = 0.f;
#pragma unroll 1
        for (int j = 0; j < 4; ++j) { const f32x4 vj = xr[64 * j]; ss += (vj.x * vj.x + vj.y * vj.y) + (vj.z * vj.z + vj.w * vj.w);
#pragma unroll
            for (int e = 0; e < 4; ++e) { const float xv = vj[e]; const LAS f32x4* w4 = (const LAS f32x4*)(wf + (256 * j + 4 * lane + e) * 12);
                const f32x4 w0 = w4[0], w1 = w4[1], w2 = w4[2];
                a[0] += xv * w0.x; a[1] += xv * w0.y; a[2] += xv * w0.z; a[3] += xv * w0.w; a[4] += xv * w1.x; a[5] += xv * w1.y; a[6] += xv * w1.z; a[7] += xv * w1.w;
                a[8] += xv * w2.x; a[9] += xv * w2.y; a[10] += xv * w2.z; a[11] += xv * w2.w; } }
        const float rstd = __builtin_amdgcn_rsqf(wave_sum(ss) * (1.f / DM_) + EPS_);
        float zsel = 0.f;
#pragma unroll
        for (int h = 0; h < 12; ++h) { const float s = wave_sum(a[h]); zsel = (lane == h) ? s : zsel; }
        if (lane < 12) { const float z = zsel * rstd + b_forget[lane];
            const float ls = (z >= 0.f) ? -log1pf(__expf(-z)) : (z - log1pf(__expf(z)));
            ((GAS float*)(ws + WS_F2))[(size_t)((m >> 12) * NHEADS + lane) * SEQ_ + (m & (SEQ_ - 1))] = ls * LOG2E; }
        GAS unsigned long long* o8 = (GAS unsigned long long*)(ws + WS_XN + (size_t)m * DM_ * 2) + lane;
#pragma unroll 1
        for (int j = 0; j < 4; ++j) { const f32x4 vj = xr[64 * j]; const f32x4 g4 = *((const GAS f32x4*)gn + 64 * j + lane);
            o8[64 * j] = (unsigned long long)pk2(vj.x * rstd * g4.x, vj.y * rstd * g4.y) | ((unsigned long long)pk2(vj.z * rstd * g4.z, vj.w * rstd * g4.w) << 32); }
    }
}

__device__ __forceinline__ void scan_seq(float* f, LAS float* tot) {
    const int tid = threadIdx.x, lane = tid & 63, wave = tid >> 6;
    GAS f32x4* p = (GAS f32x4*)f + 2 * tid; f32x4 a = p[0], b = p[1];
    a.y += a.x; a.z += a.y; a.w += a.z; b.x += a.w; b.y += b.x; b.z += b.y; b.w += b.z;
    float run = b.w;
#pragma unroll
    for (int o = 1; o < 64; o <<= 1) { const float t = __shfl_up(run, o); if (lane >= o) run += t; }
    if (lane == 63) tot[wave] = run;
    __syncthreads();
    float base = run - b.w;
    for (int w = 0; w < wave; ++w) base += tot[w];
    a = a + base; b = b + base; p[0] = a; p[1] = b;
    __syncthreads();
}

struct EpiInproj0 {
    static constexpr bool PERM = true;
    bf16 *U, *V, *Q, *Kb, *VAL; const float *g_v, *g_q, *g_k;
    __device__ __forceinline__ void operator()(const pg8::f32x4 (&acc)[2][2][4][2], const pg8::Unit& u, int wr, int wc, int fr, int fq) const {
        const int pn = u.pn; const bool act = pn <= 1, nrm = (pn >= 1 && pn <= 7);
        bf16* dst; int pitch, cb; const float* gp = nullptr; float gs = 1.f;
        if (pn == 0) { dst = U; pitch = 256; cb = 0; }
        else if (pn == 1) { dst = V; pitch = 256; cb = 0; gp = g_v + wc * 64; }
        else if (pn <= 4) { dst = Q; pitch = 768; cb = (pn - 2) * 256; gp = g_q; gs = 0.125f * LOG2E; }
        else if (pn <= 7) { dst = Kb; pitch = 768; cb = (pn - 5) * 256; gp = g_k; }
        else { dst = VAL; pitch = 768; cb = (pn - 8) * 256; }
        f32x4 gn[2][2];
#pragma unroll
        for (int bj = 0; bj < 2; ++bj)
#pragma unroll
            for (int n = 0; n < 2; ++n) { gn[bj][n] = (f32x4){1.f, 1.f, 1.f, 1.f}; if (nrm) gn[bj][n] = *(const f32x4*)(gp + 32 * bj + 8 * fq + 4 * n) * gs; }
        const int row0 = u.pm * 256 + wr * 64 + fr, col0 = cb + 64 * wc + 8 * fq;
#pragma unroll
        for (int ai = 0; ai < 2; ++ai)
#pragma unroll
            for (int m = 0; m < 4; ++m) {
                f32x4 x[2][2]; float ss = 0.f;
#pragma unroll
                for (int bj = 0; bj < 2; ++bj)
#pragma unroll
                    for (int n = 0; n < 2; ++n) { f32x4 t = acc[ai][bj][m][n];
                        if (act) { t.x = gelu_tanh(t.x); t.y = gelu_tanh(t.y); t.z = gelu_tanh(t.z); t.w = gelu_tanh(t.w); }
                        ss += (t.x * t.x + t.y * t.y) + (t.z * t.z + t.w * t.w); x[bj][n] = t; }
                float r = 1.f;
                if (nrm) { ss += __shfl_xor(ss, 16); ss += __shfl_xor(ss, 32); r = __builtin_amdgcn_rsqf(ss * (1.f / 64.f) + EPS_); }
                bf16* rowp = dst + (size_t)(row0 + ai * 128 + m * 16) * pitch + col0;
#pragma unroll
                for (int bj = 0; bj < 2; ++bj) { const f32x4 v0 = x[bj][0] * gn[bj][0] * r, v1 = x[bj][1] * gn[bj][1] * r;
                    v4u w; w.x = pg8::cvt_pk_bf16(v0.x, v0.y); w.y = pg8::cvt_pk_bf16(v0.z, v0.w); w.z = pg8::cvt_pk_bf16(v1.x, v1.y); w.w = pg8::cvt_pk_bf16(v1.z, v1.w);
                    *(v4u*)(rowp + 32 * bj) = w; }
            }
    }
};
struct EpiResF32 {
    static constexpr bool PERM = false;
    const float* base; float* out;
    __device__ __forceinline__ void operator()(const pg8::f32x4 (&acc)[2][2][4][2], const pg8::Unit& u, int wr, int wc, int fr, int fq) const {
        const int row0 = u.pm * 256 + wr * 64 + fr, col0 = u.pn * 256 + wc * 32 + 4 * fq;
#pragma unroll
        for (int ai = 0; ai < 2; ++ai)
#pragma unroll
            for (int m = 0; m < 4; ++m) { const size_t off = (size_t)(row0 + ai * 128 + m * 16) * DM_ + col0;
#pragma unroll
                for (int bj = 0; bj < 2; ++bj)
#pragma unroll
                    for (int n = 0; n < 2; ++n) { const f32x4 b = *(const f32x4*)(base + off + bj * 128 + n * 16); *(f32x4*)(out + off + bj * 128 + n * 16) = b + acc[ai][bj][m][n]; }
                if (m & 1) asm volatile("" ::: "memory"); }
    }
};
struct EpiBf16 {
    static constexpr bool PERM = true;
    bf16* O; int ldc;
    __device__ __forceinline__ void operator()(const pg8::f32x4 (&acc)[2][2][4][2], const pg8::Unit& u, int wr, int wc, int fr, int fq) const {
        const int row0 = u.pm * 256 + wr * 64 + fr, col0 = u.pn * 256 + wc * 32 + 8 * fq;
#pragma unroll
        for (int ai = 0; ai < 2; ++ai)
#pragma unroll
            for (int m = 0; m < 4; ++m) { bf16* rowp = O + (size_t)(row0 + ai * 128 + m * 16) * ldc + col0;
#pragma unroll
                for (int bj = 0; bj < 2; ++bj) { const f32x4 v0 = acc[ai][bj][m][0], v1 = acc[ai][bj][m][1];
                    v4u w; w.x = pg8::cvt_pk_bf16(v0.x, v0.y); w.y = pg8::cvt_pk_bf16(v0.z, v0.w); w.z = pg8::cvt_pk_bf16(v1.x, v1.y); w.w = pg8::cvt_pk_bf16(v1.z, v1.w);
                    *(v4u*)(rowp + bj * 128) = w; } }
    }
};
struct EpiGateUp {
    static constexpr bool PERM = true;
    bf16* HID; const float* listw;
    __device__ __forceinline__ void operator()(const pg8::f32x4 (&acc)[2][2][4][2], const pg8::Unit& u, int wr, int wc, int fr, int fq) const {
        const int col0 = u.pn * 128 + wc * 32 + 8 * fq;
#pragma unroll
        for (int ai = 0; ai < 2; ++ai)
#pragma unroll
            for (int m = 0; m < 4; ++m) { const int rt = ai * 128 + wr * 64 + m * 16 + fr, pos = u.j * 256 + rt;
                const float w = (pos < u.cnt) ? listw[(size_t)u.e * T_ + pos] : 0.f;
                f32x4 h[2];
#pragma unroll
                for (int n = 0; n < 2; ++n) { const f32x4 g = acc[ai][0][m][n], up = acc[ai][1][m][n];
                    h[n].x = g.x * fast_sigmoid(g.x) * up.x * w; h[n].y = g.y * fast_sigmoid(g.y) * up.y * w; h[n].z = g.z * fast_sigmoid(g.z) * up.z * w; h[n].w = g.w * fast_sigmoid(g.w) * up.w * w; }
                v4u o; o.x = pg8::cvt_pk_bf16(h[0].x, h[0].y); o.y = pg8::cvt_pk_bf16(h[0].z, h[0].w); o.z = pg8::cvt_pk_bf16(h[1].x, h[1].y); o.w = pg8::cvt_pk_bf16(h[1].z, h[1].w);
                *(v4u*)(HID + (size_t)(u.pm * 256 + rt) * EHID + col0) = o; }
    }
};
struct ProbMoe {
    const char* A; const char* Bt; int K, nN, G, c; unsigned* cnt; const int* list; bool gather; size_t bstride;
    __device__ __forceinline__ bool next(int i, pg8::Unit& u) const {
        const int L = i * G + c, mt = L / nN; int pre = 0; bool found = false;
#pragma unroll
        for (int e = 0; e < NEXP; ++e) { const int ce = (int)__builtin_amdgcn_readfirstlane(__hip_atomic_load(cnt + e, __ATOMIC_RELAXED, __HIP_MEMORY_SCOPE_AGENT)); const int tl = (ce + 255) >> 8;
            if (mt >= pre && mt < pre + tl) { u.e = e; u.j = mt - pre; u.cnt = ce; found = true; } pre += tl; }
        u.pm = mt; u.pn = L % nN; return found;
    }
    __device__ __forceinline__ unsigned a_off(const pg8::Unit& u, int row) const {
        if (gather) { int pos = u.j * 256 + row; pos = pos < u.cnt ? pos : u.cnt - 1; const int tok = list[(size_t)u.e * T_ + pos]; return (unsigned)tok * (unsigned)(K * 2); }
        return (unsigned)(u.pm * 256 + row) * (unsigned)(K * 2);
    }
    __device__ __forceinline__ const char* b_base(const pg8::Unit& u) const { return Bt + (size_t)u.e * bstride + (size_t)u.pn * 256 * K * 2; }
};

__device__ __forceinline__ void gmlp_unit(int idx, const bf16* U, const bf16* V, const bf16* WST, const float* b_s, bf16* MIX, LAS unsigned char* lds) {
    const int tid = threadIdx.x, lane = tid & 63, wave = __builtin_amdgcn_readfirstlane(tid >> 6), fr = lane & 15, fq = lane >> 4;
    const int c = idx >> 2, g = idx & 3, tok0 = c * 128;
    LAS bf16* Vt = (LAS bf16*)lds;
#pragma unroll
    for (int i = 0; i < 2; ++i) { const int p = tid + NTHR * i, s = p >> 3, dc = p & 7;
        const v4u q = *(const GAS v4u*)(V + (size_t)(tok0 + s) * 256 + g * 64 + dc * 8);
        const unsigned w[4] = {q.x, q.y, q.z, q.w};
#pragma unroll
        for (int e = 0; e < 4; ++e) { Vt[(dc * 8 + 2 * e) * 136 + s] = (bf16)(w[e] & 0xffffu); Vt[(dc * 8 + 2 * e + 1) * 136 + s] = (bf16)(w[e] >> 16); } }
    __syncthreads();
    const int t0 = 16 * wave;
    pg8::f32x4 acc[4];
#pragma unroll
    for (int n = 0; n < 4; ++n) acc[n] = (pg8::f32x4){0.f, 0.f, 0.f, 0.f};
#pragma unroll
    for (int ks = 0; ks < 4; ++ks) {
        const bf16x8 wfrag = *(const GAS bf16x8*)(WST + (size_t)(g * 128 + t0 + fr) * 128 + 32 * ks + 8 * fq);
#pragma unroll
        for (int n = 0; n < 4; ++n) { const bf16x8 vfrag = *(const LAS bf16x8*)(Vt + (16 * n + fr) * 136 + 32 * ks + 8 * fq);
            acc[n] = __builtin_amdgcn_mfma_f32_16x16x32_bf16(vfrag, wfrag, acc[n], 0, 0, 0); }
    }
    const int t = t0 + fr; const float bs = b_s[g * 128 + t];
#pragma unroll
    for (int n = 0; n < 4; ++n) { const size_t ucol = (size_t)(tok0 + t) * 256 + g * 64 + 16 * n + 4 * fq;
        const unsigned long long uu = *(const GAS unsigned long long*)(U + ucol);
        const float u0 = bf2f((unsigned short)(uu & 0xffff)), u1 = bf2f((unsigned short)((uu >> 16) & 0xffff)), u2 = bf2f((unsigned short)((uu >> 32) & 0xffff)), u3 = bf2f((unsigned short)(uu >> 48));
        const unsigned lo = pk2(u0 * (acc[n].x + bs), u1 * (acc[n].y + bs)), hi = pk2(u2 * (acc[n].z + bs), u3 * (acc[n].w + bs));
        *(GAS unsigned long long*)(MIX + (size_t)(tok0 + t) * 1024 + g * 64 + 16 * n + 4 * fq) = (unsigned long long)lo | ((unsigned long long)hi << 32); }
    __syncthreads();
}

#if MK_NAIVE_ATTN
__device__ __forceinline__ void naive_attn(const bf16* Q, const bf16* K, const bf16* V, const float* F2, bf16* MIXo, int gt, int NGT) {
    for (int r = gt; r < NBH * SEQ_; r += NGT) { const int bh = r / SEQ_, t = r % SEQ_, b = bh / NHEADS, h = bh % NHEADS; const size_t row = (size_t)b * SEQ_ + t;
        float q[64], o[64];
#pragma unroll
        for (int d = 0; d < 64; ++d) { q[d] = bf2f(Q[row * 768 + h * 64 + d]); o[d] = 0.f; }
        float m = -INFINITY, l = 0.f; const float ft = F2[(size_t)bh * SEQ_ + t];
        for (int s = 0; s <= t; ++s) { const size_t rs = (size_t)b * SEQ_ + s; float sc = 0.f;
#pragma unroll
            for (int d = 0; d < 64; ++d) sc += q[d] * bf2f(K[rs * 768 + h * 64 + d]);
            sc += ft - F2[(size_t)bh * SEQ_ + s];
            const float mn = fmaxf(m, sc), al = exp2f(m - mn), p = exp2f(sc - mn); l = l * al + p; m = mn;
#pragma unroll
            for (int d = 0; d < 64; ++d) o[d] = o[d] * al + p * bf2f(V[rs * 768 + h * 64 + d]); }
        const float il = 1.f / l;
#pragma unroll
        for (int d = 0; d < 64; ++d) MIXo[row * 1024 + 256 + h * 64 + d] = (bf16)f2bf(o[d] * il); }
}
#endif

template <class IN_T> __device__ __forceinline__ void phase_route(const IN_T in, int layer, const float* X, unsigned char* ws, unsigned* cnt, LAS unsigned char* lds, int G, int vcu) {
    const int tid = threadIdx.x, lane = tid & 63, wave = __builtin_amdgcn_readfirstlane(tid >> 6);
    const int gw = vcu * NWAVES + wave, NGW = G * NWAVES;
    LAS float* wt = (LAS float*)lds;
    const float* wg = in[17] + (size_t)layer * 1024 * 4; const float* wrt = in[19] + (size_t)layer * 1024 * 16; const float* gn = in[16] + (size_t)layer * 1024;
    for (int i = tid; i < 1024 * 20; i += NTHR) { const int k = i / 20, j = i % 20; wt[i] = (j < 4 ? wg[k * 4 + j] : wrt[k * 16 + (j - 4)]) * gn[k]; }
    __syncthreads();
    const float* bg = in[18] + layer * 4; const float* br = in[20] + layer * 16;
    int* list = (int*)(ws + WS_LIST); float* listw = (float*)(ws + WS_LISTW); int* toke = (int*)(ws + WS_TOKE); int* tokp = (int*)(ws + WS_TOKP);
    for (int m = gw; m < T_; m += NGW) {
        const GAS f32x4* xr = (const GAS f32x4*)(X + (size_t)m * DM_) + lane;
        float ss = 0.f; float a[20];
#pragma unroll
        for (int c = 0; c < 20; ++c) a[c] = 0.f;
#pragma unroll 1
        for (int j = 0; j < 4; ++j) { const f32x4 vj = xr[64 * j]; ss += (vj.x * vj.x + vj.y * vj.y) + (vj.z * vj.z + vj.w * vj.w);
#pragma unroll
            for (int e = 0; e < 4; ++e) { const float xv = vj[e]; const LAS f32x4* w4 = (const LAS f32x4*)(wt + (256 * j + 4 * lane + e) * 20);
#pragma unroll
                for (int q = 0; q < 5; ++q) { const f32x4 w = w4[q]; a[4 * q] += xv * w.x; a[4 * q + 1] += xv * w.y; a[4 * q + 2] += xv * w.z; a[4 * q + 3] += xv * w.w; } } }
        const float rstd = __builtin_amdgcn_rsqf(wave_sum(ss) * (1.f / DM_) + EPS_);
#pragma unroll
        for (int c = 0; c < 20; ++c) a[c] = wave_sum(a[c]) * rstd;
        GAS unsigned long long* o8 = (GAS unsigned long long*)(ws + WS_XN + (size_t)m * DM_ * 2) + lane;
#pragma unroll 1
        for (int j = 0; j < 4; ++j) { const f32x4 vj = xr[64 * j]; const f32x4 g4 = *((const GAS f32x4*)gn + 64 * j + lane);
            o8[64 * j] = (unsigned long long)pk2(vj.x * rstd * g4.x, vj.y * rstd * g4.y) | ((unsigned long long)pk2(vj.z * rstd * g4.z, vj.w * rstd * g4.w) << 32); }
        float lg[4]; int gi = 0; float gmax;
#pragma unroll
        for (int j = 0; j < 4; ++j) lg[j] = a[j] + bg[j];
        gmax = lg[0];
#pragma unroll
        for (int j = 1; j < 4; ++j) if (lg[j] > gmax) { gmax = lg[j]; gi = j; }
        float gsum = 0.f;
#pragma unroll
        for (int j = 0; j < 4; ++j) gsum += __expf(lg[j] - gmax);
        const float gtop = 1.f / gsum;
        float le[4];
#pragma unroll
        for (int e = 0; e < 4; ++e) { float s = 0.f;
#pragma unroll
            for (int j = 0; j < 4; ++j) s = (gi == j) ? (a[4 + 4 * j + e] + br[4 * j + e]) : s;
            le[e] = s; }
        int i1 = 0; float m1 = le[0];
#pragma unroll
        for (int e = 1; e < 4; ++e) if (le[e] > m1) { m1 = le[e]; i1 = e; }
        int i2 = -1; float m2 = -INFINITY;
#pragma unroll
        for (int e = 0; e < 4; ++e) if (e != i1 && le[e] > m2) { m2 = le[e]; i2 = e; }
        const float p2 = __expf(m2 - m1), w1 = gtop / (1.f + p2), w2 = gtop * p2 / (1.f + p2);
        if (lane == 0) {
            const int e1 = gi * 4 + i1, e2 = gi * 4 + i2;
            const int p1 = (int)__hip_atomic_fetch_add(cnt + e1, 1u, __ATOMIC_RELAXED, __HIP_MEMORY_SCOPE_AGENT);
            const int q2 = (int)__hip_atomic_fetch_add(cnt + e2, 1u, __ATOMIC_RELAXED, __HIP_MEMORY_SCOPE_AGENT);
            list[(size_t)e1 * T_ + p1] = m; listw[(size_t)e1 * T_ + p1] = w1; list[(size_t)e2 * T_ + q2] = m; listw[(size_t)e2 * T_ + q2] = w2;
            toke[2 * m] = e1; toke[2 * m + 1] = e2; tokp[2 * m] = p1; tokp[2 * m + 1] = q2;
        }
    }
}

template <bool NORM>
__device__ __forceinline__ void phase_combine(float* X, const float* gn, unsigned char* ws, unsigned* cnt, int G, int vcu) {
    const int tid = threadIdx.x, lane = tid & 63, wave = __builtin_amdgcn_readfirstlane(tid >> 6);
    const int gw = vcu * NWAVES + wave, NGW = G * NWAVES;
    int sb[NEXP]; { int pre = 0;
#pragma unroll
        for (int e = 0; e < NEXP; ++e) { sb[e] = pre * 256; pre += ((int)__builtin_amdgcn_readfirstlane(__hip_atomic_load(cnt + e, __ATOMIC_RELAXED, __HIP_MEMORY_SCOPE_AGENT)) + 255) >> 8; } }
    const int* toke = (const int*)(ws + WS_TOKE); const int* tokp = (const int*)(ws + WS_TOKP); const bf16* Y = (const bf16*)(ws + WS_Y);
    for (int m = gw; m < T_; m += NGW) {
        const int e1 = toke[2 * m], e2 = toke[2 * m + 1], p1 = tokp[2 * m], p2 = tokp[2 * m + 1]; int s1 = 0, s2 = 0;
#pragma unroll
        for (int e = 0; e < NEXP; ++e) { s1 = (e == e1) ? sb[e] + p1 : s1; s2 = (e == e2) ? sb[e] + p2 : s2; }
        GAS f32x4* xr = (GAS f32x4*)(X + (size_t)m * DM_) + lane;
        const GAS unsigned long long* y1 = (const GAS unsigned long long*)(Y + (size_t)s1 * 1024) + lane; const GAS unsigned long long* y2 = (const GAS unsigned long long*)(Y + (size_t)s2 * 1024) + lane;
        f32x4 v[4]; float ss = 0.f;
#pragma unroll
        for (int j = 0; j < 4; ++j) { v[j] = xr[64 * j]; const unsigned long long a = y1[64 * j], b = y2[64 * j];
            v[j].x += bf2f((unsigned short)(a & 0xffff)) + bf2f((unsigned short)(b & 0xffff)); v[j].y += bf2f((unsigned short)((a >> 16) & 0xffff)) + bf2f((unsigned short)((b >> 16) & 0xffff));
            v[j].z += bf2f((unsigned short)((a >> 32) & 0xffff)) + bf2f((unsigned short)((b >> 32) & 0xffff)); v[j].w += bf2f((unsigned short)(a >> 48)) + bf2f((unsigned short)(b >> 48));
            xr[64 * j] = v[j]; ss += (v[j].x * v[j].x + v[j].y * v[j].y) + (v[j].z * v[j].z + v[j].w * v[j].w); }
        if (NORM) {
            const float rstd = __builtin_amdgcn_rsqf(wave_sum(ss) * (1.f / DM_) + EPS_);
            GAS unsigned long long* o8 = (GAS unsigned long long*)(ws + WS_XN + (size_t)m * DM_ * 2) + lane;
#pragma unroll
            for (int j = 0; j < 4; ++j) { const f32x4 g4 = *((const GAS f32x4*)gn + 64 * j + lane);
                o8[64 * j] = (unsigned long long)pk2(v[j].x * rstd * g4.x, v[j].y * rstd * g4.y) | ((unsigned long long)pk2(v[j].z * rstd * g4.z, v[j].w * rstd * g4.w) << 32); }
        }
    }
}

__device__ __forceinline__ void unpack8(const v4u q, float (&f)[8]) { f[0] = bf2f((unsigned short)(q.x & 0xffff)); f[1] = bf2f((unsigned short)(q.x >> 16)); f[2] = bf2f((unsigned short)(q.y & 0xffff)); f[3] = bf2f((unsigned short)(q.y >> 16));
    f[4] = bf2f((unsigned short)(q.z & 0xffff)); f[5] = bf2f((unsigned short)(q.z >> 16)); f[6] = bf2f((unsigned short)(q.w & 0xffff)); f[7] = bf2f((unsigned short)(q.w >> 16)); }
__device__ __forceinline__ void phase_mix1(const bf16* H1, const float* conv_w, bf16* MIX, int G, int vcu) {
    const int gt = vcu * NTHR + (int)threadIdx.x, NGT = G * NTHR;
    for (int idx = gt; idx < T_ * 128; idx += NGT) {
        const int cgp = idx & 127, m = idx >> 7, t = m & (SEQ_ - 1); const bf16* hr = H1 + (size_t)m * 2048; float o[8];
        if (cgp < 64) { const int ch = cgp * 8; float bgv[8], y[8];
            unpack8(*(const GAS v4u*)(hr + ch), bgv);
#pragma unroll
            for (int e = 0; e < 8; ++e) y[e] = 0.f;
#pragma unroll
            for (int tap = 0; tap < 3; ++tap) { const int dt = 2 - tap;
                if (t >= dt) { float cgv[8], hcv[8]; unpack8(*(const GAS v4u*)(hr - (size_t)dt * 2048 + 512 + ch), cgv); unpack8(*(const GAS v4u*)(hr - (size_t)dt * 2048 + 1024 + ch), hcv);
                    const f32x4 w0 = *(const GAS f32x4*)(conv_w + tap * 512 + ch), w1 = *(const GAS f32x4*)(conv_w + tap * 512 + ch + 4);
                    const float w[8] = {w0.x, w0.y, w0.z, w0.w, w1.x, w1.y, w1.z, w1.w};
#pragma unroll
                    for (int e = 0; e < 8; ++e) y[e] += w[e] * (cgv[e] * hcv[e]); } }
#pragma unroll
            for (int e = 0; e < 8; ++e) o[e] = bgv[e] * y[e];
            v4u w; w.x = pk2(o[0], o[1]); w.y = pk2(o[2], o[3]); w.z = pk2(o[4], o[5]); w.w = pk2(o[6], o[7]);
            *(GAS v4u*)(MIX + (size_t)m * 1024 + ch) = w;
        } else { const int pc = (cgp - 64) * 8, gi = pc >> 7, win = 2 << gi, n = (t + 1 < win) ? t + 1 : win; float s[8], p0[8];
            unpack8(*(const GAS v4u*)(hr + 1536 + pc), p0);
#pragma unroll
            for (int e = 0; e < 8; ++e) s[e] = p0[e];
            for (int d = 1; d < n; ++d) { float pv[8]; unpack8(*(const GAS v4u*)(hr - (size_t)d * 2048 + 1536 + pc), pv);
#pragma unroll
                for (int e = 0; e < 8; ++e) s[e] += pv[e]; }
            const float inv = 1.f / (float)n;
#pragma unroll
            for (int e = 0; e < 8; ++e) o[e] = s[e] * inv - p0[e];
            v4u w; w.x = pk2(o[0], o[1]); w.y = pk2(o[2], o[3]); w.z = pk2(o[4], o[5]); w.w = pk2(o[6], o[7]);
            *(GAS v4u*)(MIX + (size_t)m * 1024 + 512 + pc) = w; }
    }
}
struct Args { const float* in[24]; float* out; unsigned char* ws; int ph_lo, ph_hi, rep, pad; };
__global__ void __launch_bounds__(NTHR, 2) hybrid_fwd(Args args) {
    extern __shared__ __attribute__((aligned(16))) unsigned char lds_raw[];
    LAS unsigned char* lds = (LAS unsigned char*)lds_raw;
    volatile LAS unsigned* MISC = (volatile LAS unsigned*)(lds + MISC_OFF);
    const int tid = threadIdx.x;
    const int G = gridDim.x; const int bx = blockIdx.x; const int vcu = (G % 8 == 0) ? (bx % 8) * (G / 8) + bx / 8 : bx;
    struct KIn { __device__ __forceinline__ const float* operator[](int k) const { const volatile __attribute__((address_space(4))) unsigned long long* ka = (const volatile __attribute__((address_space(4))) unsigned long long*)__builtin_amdgcn_kernarg_segment_ptr(); return (const float*)(const GAS float*)ka[k]; } };
    const KIn in;
#define out ((float*)in[24])
#define ws ((unsigned char*)in[25])
#define XN ((bf16*)(ws + WS_XN))
#define MIX ((bf16*)(ws + WS_MIX))
#define HID ((bf16*)(ws + WS_HID))
#define Y ((bf16*)(ws + WS_Y))
#define F2 ((float*)(ws + WS_F2))
#define ctl ((gu32*)(ws + WS_CTL))
    for (int u = tid; u < (LDS_BYTES - LDSCTL_OFF) / 4; u += NTHR) ((LAS unsigned*)(lds + LDSCTL_OFF))[u] = 0u;
    __syncthreads();
#if MK_USE_CG
    cooperative_groups::grid_group grid = cooperative_groups::this_grid();
#define GRID_BAR() grid.sync()
#else
    XcdBarrier bar; bar.bar = (unsigned*)(ctl + CW_BAR); bar.x = 0; bar.st = nullptr;
    if (MK_N_LAUNCHES == 1) bar = xcd_barrier_post((unsigned*)(ctl + CW_BAR), MISC + 8);
#define GRID_BAR() xcd_barrier(bar)
#endif
    const int lo = args.ph_lo, hi = args.ph_hi;
#ifndef PH_MASK
#define PH_MASK 0x7fff
#endif
#define IN(k) (((PH_MASK >> (k)) & 1) && lo <= (k) && (k) < hi)
#define SEAM(k) do { if (IN(k) && IN((k) + 1)) GRID_BAR(); } while (0)

    if (IN(0)) { p0_prologue(in, ws, lds, G, vcu); }
    SEAM(0);
    if (IN(1)) {
        if (bx >= G - NBH && G > NBH && args.rep == 0) { scan_seq(F2 + (size_t)(bx - (G - NBH)) * SEQ_, (LAS float*)(lds + MISC_OFF + 64)); }
        pg8::ProbPlain S; S.init(XN, ws + WS_WIN0, T_, EV_N, 1024, G, bx);
        EpiInproj0 E{(bf16*)(ws + WS_U), (bf16*)(ws + WS_V), (bf16*)(ws + WS_Q), (bf16*)(ws + WS_K), (bf16*)(ws + WS_VAL), in[6], in[7], in[8]};
        pg8::gemm_phase<EpiInproj0, pg8::ProbPlain, true>(lds, S, E);
    }
    SEAM(1);
    if (IN(2)) {
#if MK_NAIVE_ATTN
        naive_attn((const bf16*)(ws + WS_Q), (const bf16*)(ws + WS_K), (const bf16*)(ws + WS_VAL), F2, MIX, vcu * NTHR + tid, G * NTHR);
        for (int u = bx; u < 512; u += G) gmlp_unit(u, (const bf16*)(ws + WS_U), (const bf16*)(ws + WS_V), (const bf16*)(ws + WS_WST), in[5], MIX, lds);
#else
        for (;;) {
            if (tid == 0) MISC[0] = __hip_atomic_fetch_add((unsigned*)(ctl + CW_Q + 64 * args.rep), 1u, __ATOMIC_RELAXED, __HIP_MEMORY_SCOPE_AGENT);
            __syncthreads();
            const int u = (int)MISC[0];
            __syncthreads();
            if (u >= 768 + 512) break;
            if (u < 768) { const int qb = 15 - u / NBH, bh = u % NBH;
                attn_body::attn_unit<8>(bh / NHEADS, bh % NHEADS, qb, (const attn_body::bf16*)(ws + WS_Q), (const attn_body::bf16*)(ws + WS_K), (const attn_body::bf16*)(ws + WS_VAL),
                                        (attn_body::bf16*)(ws + WS_MIX) + 256, F2 + (size_t)bh * SEQ_, (char*)lds_raw); }
            else gmlp_unit(u - 768, (const bf16*)(ws + WS_U), (const bf16*)(ws + WS_V), (const bf16*)(ws + WS_WST), in[5], MIX, lds);
        }
#endif
    }
    SEAM(2);
    if (IN(3)) {
        pg8::ProbPlain S; S.init(MIX, ws + WS_WOUT0, T_, 1024, 1024, G, bx);
        EpiResF32 E{in[0], out};
        pg8::gemm_phase<EpiResF32, pg8::ProbPlain, false>(lds, S, E);
    }
    SEAM(3);
#define MOE_LAYER(layer, pb, cntw) do { \
        unsigned* cnt = (unsigned*)(ctl + (cntw)); \
          \
        if (IN(pb)) phase_route(in, layer, out, ws, cnt, lds, G, vcu); \
        SEAM(pb); \
          \
        if (IN((pb) + 1)) { \
            ProbMoe S{(const char*)XN, (const char*)(ws + WS_WGU) + (size_t)(layer) * NEXP * 512 * 1024 * 2, 1024, 2, G, bx, cnt, (const int*)(ws + WS_LIST), true, (size_t)512 * 1024 * 2}; \
            EpiGateUp E{HID, (const float*)(ws + WS_LISTW)}; \
            pg8::gemm_phase<EpiGateUp, ProbMoe, true>(lds, S, E); } \
        SEAM((pb) + 1); \
          \
        if (IN((pb) + 2)) { \
            ProbMoe S{(const char*)HID, (const char*)(ws + WS_WD) + (size_t)(layer) * NEXP * 1024 * 256 * 2, 256, 4, G, bx, cnt, nullptr, false, (size_t)1024 * 256 * 2}; \
            EpiBf16 E{Y, 1024}; \
            pg8::gemm_phase<EpiBf16, ProbMoe, true>(lds, S, E); } \
        SEAM((pb) + 2); \
          \
        if (IN((pb) + 3)) { if ((layer) == 0) phase_combine<true>(out, in[10], ws, cnt, G, vcu); else phase_combine<false>(out, nullptr, ws, cnt, G, vcu); } \
    } while (0)
    MOE_LAYER(0, 4, CW_CNT0);
    SEAM(7);
    if (IN(8)) {
        pg8::ProbPlain S; S.init(XN, ws + WS_WIN1, T_, 2048, 1024, G, bx);
        EpiBf16 E{(bf16*)(ws + WS_H1), 2048};
        pg8::gemm_phase<EpiBf16, pg8::ProbPlain, true>(lds, S, E);
    }
    SEAM(8);
    if (IN(9)) phase_mix1((const bf16*)(ws + WS_H1), in[12], MIX, G, vcu);
    SEAM(9);
    if (IN(10)) {
        pg8::ProbPlain S; S.init(MIX, ws + WS_WOUT1, T_, 1024, 1024, G, bx);
        EpiResF32 E{out, out};
        pg8::gemm_phase<EpiResF32, pg8::ProbPlain, false>(lds, S, E);
    }
    SEAM(10);
    MOE_LAYER(1, 11, CW_CNT1);
#undef MOE_LAYER
#undef XN
#undef MIX
#undef HID
#undef Y
#undef F2
#undef ctl
#undef out
#undef ws
#undef IN
#undef SEAM
#undef GRID_BAR
}

extern "C" void kernel_launch(void* const* d_in, const int* in_sizes, int n_in, void* d_out, int out_size, void* d_ws, size_t ws_size, hipStream_t stream) {
    static int grid = 0;
    if (grid == 0) {
        if (n_in != 24 || in_sizes[0] != T_ * DM_ || out_size != T_ * DM_ || ws_size < WS_END) { fprintf(stderr, "kernel_launch: unexpected shapes (n_in %d, in0 %d, out %d, ws %zu); nothing launched\n", n_in, n_in > 0 ? in_sizes[0] : -1, out_size, ws_size); grid = -1; return; }
        int dev = 0, cus = 0, per_cu = 0;
        if (hipGetDevice(&dev) != hipSuccess || hipDeviceGetAttribute(&cus, hipDeviceAttributeMultiprocessorCount, dev) != hipSuccess) { fprintf(stderr, "kernel_launch: device query failed\n"); grid = -1; return; }
        if (hipFuncSetAttribute((const void*)hybrid_fwd, hipFuncAttributeMaxDynamicSharedMemorySize, LDS_BYTES) != hipSuccess) { fprintf(stderr, "kernel_launch: hipFuncSetAttribute failed\n"); grid = -1; return; }
        if (hipOccupancyMaxActiveBlocksPerMultiprocessor(&per_cu, (const void*)hybrid_fwd, NTHR, LDS_BYTES) != hipSuccess || per_cu < 1) { fprintf(stderr, "kernel_launch: occupancy query reports %d workgroups per CU\n", per_cu); per_cu = 1; }
        (void)hipGetLastError();
        grid = cus;
    }
    if (grid < 0) return;
    if (hipMemsetAsync((char*)d_ws + WS_CTL, 0, CTL_ZERO_BYTES, stream) != hipSuccess) { fprintf(stderr, "kernel_launch: memset failed\n"); return; }
    Args a{};
    for (int i = 0; i < 24; ++i) a.in[i] = (const float*)d_in[i];
    a.out = (float*)d_out; a.ws = (unsigned char*)d_ws;
#if MK_N_LAUNCHES == 1
    a.ph_lo = 0; a.ph_hi = NPH;
#if MK_USE_CG
    void* kargs[] = {&a};
    hipError_t e = hipLaunchCooperativeKernel((const void*)hybrid_fwd, dim3(grid), dim3(NTHR), kargs, LDS_BYTES, stream);
    if (e != hipSuccess) fprintf(stderr, "kernel_launch: cooperative launch failed: %s (grid %d)\n", hipGetErrorString(e), grid);
#else
    hipLaunchKernelGGL(hybrid_fwd, dim3(grid), dim3(NTHR), LDS_BYTES, stream, a);
#endif
#else
    for (int p = 0; p < NPH; ++p) { a.ph_lo = p; a.ph_hi = p + 1; a.rep = 0; hipLaunchKernelGGL(hybrid_fwd, dim3(grid), dim3(NTHR), LDS_BYTES, stream, a);
        if ((MK_REPEAT_MASK >> p) & 1) { a.rep = 1; hipLaunchKernelGGL(hybrid_fwd, dim3(grid), dim3(NTHR), LDS_BYTES, stream, a); } }
#endif
}
```

```cpp
#include <hip/hip_runtime.h>
#include <hip/hip_cooperative_groups.h>
#include <hip/hip_bf16.h>
#include <cstdio>
#include <cstdint>
#include <cmath>

#ifndef MK_N_LAUNCHES
#define MK_N_LAUNCHES 1
#endif
#ifndef MK_USE_CG
#define MK_USE_CG 0
#endif
#ifndef MK_NAIVE_ATTN
#define MK_NAIVE_ATTN 0
#endif
#ifndef MK_REPEAT_MASK
#define MK_REPEAT_MASK 0
#endif
namespace pg8 {
#define PG8_LAS __attribute__((address_space(3)))
typedef unsigned short bf16_t;
typedef short bf16x8 __attribute__((ext_vector_type(8)));
typedef float f32x4 __attribute__((ext_vector_type(4)));
typedef unsigned u32x4 __attribute__((ext_vector_type(4)));
constexpr int BM = 256, BK = 64, HALF = 128, HTB = HALF * BK * 2  , STAGE_BYTES = 8 * HTB, NXCD = 8, WGM = 8;

__host__ __device__ __forceinline__ int lds_byte(int r, int c) { const int st = (r >> 4) * 2 + (c >> 5), rr = r & 15, cc = c & 31, ob = rr * 64 + cc * 2; return st * 1024 + (ob ^ (((ob >> 9) & 1) << 5)); }
__host__ __device__ __forceinline__ void stage_rc(int b, int& R, int& C) { const int st = b / 1024, sb = b % 1024, swz = sb ^ (((sb >> 9) & 1) << 5); R = (st >> 1) * 16 + swz / 64; C = (st & 1) * 32 + (swz % 64) / 2; }
__host__ __device__ __forceinline__ int perm32(int rho) { const int n = rho >> 4, i = rho & 15; return 8 * (i >> 2) + 4 * n + (i & 3); }

struct Unit { int pm, pn, e, j, cnt; };

__device__ __forceinline__ unsigned cvt_pk_bf16(float lo, float hi) { unsigned r; asm volatile("v_cvt_pk_bf16_f32 %0, %1, %2" : "=v"(r) : "v"(lo), "v"(hi)); return r; }

struct ProbPlain {
    const char* A; const char* Bt; int K, nM, nN, nwg, G, c;
    __device__ __forceinline__ void init(const void* A_, const void* Bt_, int M, int N, int K_, int G_, int c_) { A = (const char*)A_; Bt = (const char*)Bt_; K = K_; nM = M / BM; nN = N / BM; nwg = nM * nN; G = G_; c = c_; }
    __device__ __forceinline__ bool next(int i, Unit& u) const {
        const long L = (long)i * G + c; if (L >= nwg) return false;
        int wgid = (int)L; { const int q = nwg / NXCD, r = nwg % NXCD, xcd = wgid % NXCD, off = wgid / NXCD; wgid = (xcd < r ? xcd * (q + 1) : r * (q + 1) + (xcd - r) * q) + off; }
        const int nig = WGM * nN, gid = wgid / nig, fm = gid * WGM, gsz = (nM - fm) < WGM ? (nM - fm) : WGM;
        u.pm = fm + ((wgid % nig) % gsz); u.pn = (wgid % nig) / gsz; u.e = 0; u.j = 0; u.cnt = 0; return true;
    }
    __device__ __forceinline__ unsigned a_off(const Unit& u, int row) const { return (unsigned)(u.pm * BM + row) * (unsigned)(K * 2); }
    __device__ __forceinline__ const char* b_base(const Unit& u) const { return Bt + (size_t)u.pn * BM * K * 2; }
};

template <class Epi, class Prob, bool ALIGN_EPI>
__device__ __forceinline__ void gemm_phase(PG8_LAS unsigned char* lds, const Prob& S, const Epi& E) {
    int tid_ = threadIdx.x; asm volatile("" : "+v"(tid_)); const int tid = tid_, wid = __builtin_amdgcn_readfirstlane(tid >> 6), lane = tid & 63, wr = wid >> 2, wc = wid & 3, fr = lane & 15, fq = lane >> 4;
    const int K = S.K, nt = K / BK;
    int Rr[2], Cb[2]; unsigned voffB[2];
#pragma unroll
    for (int i = 0; i < 2; ++i) { int R, C; stage_rc(tid * 16 + i * 8192, R, C); const int Rb = Epi::PERM ? ((R & ~31) + perm32(R & 31)) : R;
        Rr[i] = R; Cb[i] = C * 2; voffB[i] = (unsigned)(Rb * K + C) * 2u; }
    const size_t kstep = (size_t)(BK * 2);
    const size_t hstep = (size_t)HALF * K * 2;
    const unsigned ldsw = (unsigned)wid * 1024u;
    const int aoff = lds_byte(wr * 64 + fr, fq * 8), boff = lds_byte(wc * 32 + fr, fq * 8);
#define PG8_SA(b, h) (((b) * 2 + (h)) * HTB)
#define PG8_SB(b, h) ((4 + (b) * 2 + (h)) * HTB)
#define PG8_STAGE(bufoff, gbase, voff) do { _Pragma("unroll") for (int _i = 0; _i < 2; ++_i) \
        __builtin_amdgcn_global_load_lds((const unsigned*)((const char*)(gbase) + (voff)[_i]), (PG8_LAS unsigned*)(lds + (bufoff) + ldsw + _i * 8192), 16, 0, 0); } while (0)
#define PG8_LDA(dst, b, h) do { _Pragma("unroll") for (int m = 0; m < 4; ++m) _Pragma("unroll") for (int k = 0; k < 2; ++k) dst[m][k] = *(const PG8_LAS bf16x8*)(lds + PG8_SA(b, h) + aoff + m * 2048 + k * 1024); } while (0)
#define PG8_LDB(dst, b, h) do { _Pragma("unroll") for (int n = 0; n < 2; ++n) _Pragma("unroll") for (int k = 0; k < 2; ++k) dst[n][k] = *(const PG8_LAS bf16x8*)(lds + PG8_SB(b, h) + boff + n * 2048 + k * 1024); } while (0)
#define PG8_MMA(ai, bj, At, Bt) do { __builtin_amdgcn_s_setprio(1); _Pragma("unroll") for (int m = 0; m < 4; ++m) _Pragma("unroll") for (int n = 0; n < 2; ++n) _Pragma("unroll") for (int k = 0; k < 2; ++k) \
        acc[ai][bj][m][n] = __builtin_amdgcn_mfma_f32_16x16x32_bf16(Bt[n][k], At[m][k], acc[ai][bj][m][n], 0, 0, 0); __builtin_amdgcn_s_setprio(0); } while (0)
#define PG8_WAIT_V(n) asm volatile("s_waitcnt vmcnt(" #n ")" ::: "memory")
#define PG8_WAIT_L(n) asm volatile("s_waitcnt lgkmcnt(" #n ")" ::: "memory")
#define PG8_BAR __builtin_amdgcn_s_barrier()
#define PG8_SCHED __builtin_amdgcn_sched_barrier(0)
    Unit cur, nxt; int ui = 0;
    if (!S.next(0, cur)) return;
    f32x4 acc[2][2][4][2];
#pragma unroll
    for (int a = 0; a < 2; ++a)
#pragma unroll
        for (int b = 0; b < 2; ++b)
#pragma unroll
            for (int m = 0; m < 4; ++m)
#pragma unroll
                for (int n = 0; n < 2; ++n) acc[a][b][m][n] = (f32x4){0.f, 0.f, 0.f, 0.f};
    bf16x8 At[4][2], B0[2][2], B1[2][2];
    const char* const Ab = S.A;
    unsigned cA0[2], cA1[2], nA0[2], nA1[2];
#pragma unroll
    for (int i = 0; i < 2; ++i) { cA0[i] = S.a_off(cur, Rr[i]) + (unsigned)Cb[i]; cA1[i] = S.a_off(cur, Rr[i] + HALF) + (unsigned)Cb[i]; }
    const char* cB = S.b_base(cur);
    PG8_STAGE(PG8_SB(0, 0), cB, voffB); PG8_STAGE(PG8_SB(0, 1), cB + hstep, voffB); PG8_STAGE(PG8_SA(0, 0), Ab, cA0); PG8_STAGE(PG8_SA(0, 1), Ab, cA1);
    if (wr == 1) PG8_BAR;
    PG8_WAIT_V(2); PG8_BAR;
    PG8_STAGE(PG8_SB(1, 0), cB + kstep, voffB); PG8_STAGE(PG8_SA(1, 0), Ab + kstep, cA0); PG8_STAGE(PG8_SB(1, 1), cB + hstep + kstep, voffB);
    PG8_WAIT_V(6); PG8_BAR;
    for (;;) {
        const bool has_next = S.next(ui + 1, nxt);
        const char* nB = cB;
#pragma unroll
        for (int i = 0; i < 2; ++i) { nA0[i] = cA0[i]; nA1[i] = cA1[i]; }
        if (has_next) { nB = S.b_base(nxt);
#pragma unroll
            for (int i = 0; i < 2; ++i) { nA0[i] = S.a_off(nxt, Rr[i]) + (unsigned)Cb[i]; nA1[i] = S.a_off(nxt, Rr[i] + HALF) + (unsigned)Cb[i]; } }
        for (int t = 0; t < nt; t += 2) {
            const bool last = (t == nt - 2);
            const char* a1 = Ab + (size_t)(t + 1) * kstep;
            const char* a2 = last ? Ab : Ab + (size_t)(t + 2) * kstep; const char* b2 = last ? nB : cB + (size_t)(t + 2) * kstep;
            const char* a3 = a2 + kstep; const char* b3 = b2 + kstep;
            unsigned x0[2], x1[2];
#pragma unroll
            for (int i = 0; i < 2; ++i) { x0[i] = last ? nA0[i] : cA0[i]; x1[i] = last ? nA1[i] : cA1[i]; }
            PG8_LDB(B0, 0, 0); PG8_LDB(B1, 0, 1); PG8_SCHED; PG8_LDA(At, 0, 0); PG8_STAGE(PG8_SA(1, 1), a1, cA1);
            PG8_WAIT_V(8); PG8_WAIT_L(0); PG8_BAR; PG8_MMA(0, 0, At, B0); PG8_MMA(0, 1, At, B1); PG8_BAR; PG8_SCHED;
            PG8_LDA(At, 0, 1); PG8_STAGE(PG8_SB(0, 0), b2, voffB); PG8_STAGE(PG8_SB(0, 1), b2 + hstep, voffB); PG8_STAGE(PG8_SA(0, 0), a2, x0);
            PG8_WAIT_V(8); PG8_WAIT_L(0); PG8_BAR; PG8_MMA(1, 0, At, B0); PG8_MMA(1, 1, At, B1); PG8_BAR; PG8_SCHED;
            PG8_LDB(B0, 1, 0); PG8_LDB(B1, 1, 1); PG8_SCHED; PG8_LDA(At, 1, 0); PG8_STAGE(PG8_SA(0, 1), a2, x1);
            PG8_WAIT_V(8); PG8_WAIT_L(0); PG8_BAR; PG8_MMA(0, 0, At, B0); PG8_MMA(0, 1, At, B1); PG8_BAR; PG8_SCHED;
            PG8_LDA(At, 1, 1); PG8_STAGE(PG8_SB(1, 0), b3, voffB); PG8_STAGE(PG8_SB(1, 1), b3 + hstep, voffB); PG8_STAGE(PG8_SA(1, 0), a3, x0);
            PG8_WAIT_V(8); PG8_WAIT_L(0); PG8_BAR; PG8_MMA(1, 0, At, B0); PG8_MMA(1, 1, At, B1); PG8_BAR; PG8_SCHED;
        }
        if constexpr (ALIGN_EPI) { if (wr == 0) PG8_BAR; }
        E(acc, cur, wr, wc, fr, fq);
        if (!has_next) break;
#pragma unroll
        for (int a = 0; a < 2; ++a)
#pragma unroll
            for (int b = 0; b < 2; ++b)
#pragma unroll
                for (int m = 0; m < 4; ++m)
#pragma unroll
                    for (int n = 0; n < 2; ++n) acc[a][b][m][n] = (f32x4){0.f, 0.f, 0.f, 0.f};
        cur = nxt; cB = nB; ++ui;
#pragma unroll
        for (int i = 0; i < 2; ++i) { cA0[i] = nA0[i]; cA1[i] = nA1[i]; }
        if constexpr (ALIGN_EPI) { if (wr == 1) PG8_BAR; }
    }
    PG8_WAIT_V(0);
    if constexpr (!ALIGN_EPI) { if (wr == 0) PG8_BAR; }
    PG8_BAR;
#undef PG8_SA
#undef PG8_SB
#undef PG8_STAGE
#undef PG8_LDA
#undef PG8_LDB
#undef PG8_MMA
#undef PG8_WAIT_V
#undef PG8_WAIT_L
#undef PG8_BAR
#undef PG8_SCHED
}
}
namespace attn_body {
using bf16=__hip_bfloat16;
using bf16x8=__attribute__((ext_vector_type(8)))short;
using s16x4=__attribute__((ext_vector_type(4)))short;
using f32x16=__attribute__((ext_vector_type(16)))float;
using u32x4=__attribute__((ext_vector_type(4)))unsigned;
using f32x4v=__attribute__((ext_vector_type(4)))float;
constexpr int BATCH=4,NHEAD=12,SEQ=4096,D=64;
constexpr int QP=768,KP=768,VP=768,OP=1024;
constexpr int NW=8,QBLK=32,QB=QBLK*NW,KVBLK=64,NQB=SEQ/QB;
constexpr int ATTN_UNIT_ROWS=QB;
__device__ __forceinline__ int crow(int r,int hi){return (r&3)+8*(r>>2)+4*hi;}
#define SBAR() __builtin_amdgcn_sched_barrier(0)
__device__ __forceinline__ void cmask(f32x16&p0,f32x16&p1,int jb,int qrel,int hi){
  const float NEG=-INFINITY; int kb=64*jb+4*hi;
  #pragma unroll
  for(int r=0;r<16;++r){int kv=kb+(r&3)+8*(r>>2); if(kv>qrel)p0[r]=NEG; if(kv+32>qrel)p1[r]=NEG;}
}

constexpr int NSLOT=3, SLOTB=8192;
constexpr int LDS_K=0, LDS_V=NSLOT*SLOTB, LDS_WS=2*NSLOT*SLOTB, LDS_OST=LDS_WS+NW*64*4, LDS_BYTES=LDS_OST+NW*4096, LDS_F=86016, LDS_F_BYTES=16384;
constexpr float C2=0.125f*1.4426950408889634f;
__device__ __forceinline__ void glds16(const void*gsrc,unsigned lds_dst){unsigned keep;
  asm volatile("s_mov_b32 %0, m0\n\ts_mov_b32 m0, %2\n\ts_nop 0\n\tglobal_load_lds_dwordx4 %1, off\n\ts_mov_b32 m0, %0":"=&s"(keep):"v"(gsrc),"s"(lds_dst):"memory");}
__device__ __forceinline__ float max3f(float a,float b,float c){float r;asm("v_max3_f32 %0, %1, %2, %3":"=v"(r):"v"(a),"v"(b),"v"(c));return r;}
__device__ __forceinline__ float max2f(float a,float b){float r;asm("v_max_f32_e32 %0, %1, %2":"=v"(r):"v"(a),"v"(b));return r;}
__device__ __forceinline__ float fadd_s(float a,float b){float r;asm("v_add_f32_e32 %0, %1, %2":"=v"(r):"v"(a),"v"(b));return r;}
__device__ __forceinline__ float fsub_s(float a,float b){float r;asm("v_sub_f32_e32 %0, %1, %2":"=v"(r):"v"(a),"v"(b));return r;}
typedef float f32x2_t __attribute__((ext_vector_type(2))); typedef __bf16 bf16x2_t __attribute__((ext_vector_type(2)));
__device__ __forceinline__ unsigned cvtpk_s(float lo,float hi){f32x2_t v={lo,hi};bf16x2_t b=__builtin_convertvector(v,bf16x2_t);return __builtin_bit_cast(unsigned,b);}
#define WAIT_BAR(N) asm volatile("s_waitcnt vmcnt(" #N ") lgkmcnt(0)\n\ts_barrier":::"memory")

__device__ __forceinline__ void qkt(f32x16&p0,f32x16&p1,const char*Kslot,const bf16x8*qr,int r32,int hi){
  const char*kb=Kslot+hi*1024+r32*16;
  #pragma unroll
  for(int d0=0;d0<4;++d0){
    const bf16x8 b0=*reinterpret_cast<const bf16x8*>(kb+d0*2048);
    const bf16x8 b1=*reinterpret_cast<const bf16x8*>(kb+d0*2048+512);
    p0=__builtin_amdgcn_mfma_f32_32x32x16_bf16(b0,qr[d0],p0,0,0,0);p1=__builtin_amdgcn_mfma_f32_32x32x16_bf16(b1,qr[d0],p1,0,0,0);}
}
typedef __attribute__((address_space(3))) const char* lds_cptr;
typedef short v4i16_t __attribute__((ext_vector_type(4)));
__device__ __forceinline__ void kload8(bf16x8*kf,lds_cptr kp){
  kf[0]=*(const __attribute__((address_space(3))) bf16x8*)(kp);      kf[1]=*(const __attribute__((address_space(3))) bf16x8*)(kp+512);
  kf[2]=*(const __attribute__((address_space(3))) bf16x8*)(kp+2048); kf[3]=*(const __attribute__((address_space(3))) bf16x8*)(kp+2560);
  kf[4]=*(const __attribute__((address_space(3))) bf16x8*)(kp+4096); kf[5]=*(const __attribute__((address_space(3))) bf16x8*)(kp+4608);
  kf[6]=*(const __attribute__((address_space(3))) bf16x8*)(kp+6144); kf[7]=*(const __attribute__((address_space(3))) bf16x8*)(kp+6656);
}
__device__ __forceinline__ void kload2(bf16x8*kf,lds_cptr kp,int j){ kf[2*j]=*(const __attribute__((address_space(3))) bf16x8*)(kp+j*2048); kf[2*j+1]=*(const __attribute__((address_space(3))) bf16x8*)(kp+j*2048+512); }
__device__ __forceinline__ s16x4 vtr(lds_cptr p){ return __builtin_bit_cast(s16x4,__builtin_amdgcn_ds_read_tr16_b64_v4i16((__attribute__((address_space(3))) v4i16_t*)p)); }
__device__ __forceinline__ float rowmax(const f32x16&p0,const f32x16&p1){
  float a=max3f(p0[0],p0[1],p1[0]),b=max3f(p0[2],p0[3],p1[1]);a=max3f(a,p1[2],p1[3]);
  #pragma unroll
  for(int r=4;r<16;r+=4){a=max3f(a,p0[r],p0[r+1]);b=max3f(b,p0[r+2],p0[r+3]);a=max3f(a,p1[r],p1[r+1]);b=max3f(b,p1[r+2],p1[r+3]);}
  const float m=max2f(a,b);
  auto rr=__builtin_amdgcn_permlane32_swap(__float_as_uint(m),__float_as_uint(m),false,false);
  return max2f(__uint_as_float(rr[0]),__uint_as_float(rr[1]));
}
__device__ __forceinline__ void pv(f32x16*o,int vb,bf16x8 pa0,bf16x8 pa1,bf16x8 pa2,bf16x8 pa3){
  #pragma unroll
  for(int d0=0;d0<2;++d0){s16x4 lo[4],hi[4];
    #pragma unroll
    for(int ks=0;ks<4;++ks){
      asm volatile("ds_read_b64_tr_b16 %0,%1 offset:%c2":"=&v"(lo[ks]):"v"(vb),"i"(d0*4096+ks*1024):"memory");
      asm volatile("ds_read_b64_tr_b16 %0,%1 offset:%c2":"=&v"(hi[ks]):"v"(vb),"i"(d0*4096+ks*1024+512):"memory");}
    asm volatile("s_waitcnt lgkmcnt(0)":::"memory");SBAR();
    #define PK(k) (bf16x8){lo[k][0],lo[k][1],lo[k][2],lo[k][3],hi[k][0],hi[k][1],hi[k][2],hi[k][3]}
    o[d0]=__builtin_amdgcn_mfma_f32_32x32x16_bf16(pa0,PK(0),o[d0],0,0,0);
    o[d0]=__builtin_amdgcn_mfma_f32_32x32x16_bf16(pa1,PK(1),o[d0],0,0,0);
    o[d0]=__builtin_amdgcn_mfma_f32_32x32x16_bf16(pa2,PK(2),o[d0],0,0,0);
    o[d0]=__builtin_amdgcn_mfma_f32_32x32x16_bf16(pa3,PK(3),o[d0],0,0,0);
    #undef PK
  }
}

#ifndef ATTN_STORE16
#define ATTN_STORE16(p,v) (*(u32x4*)(p)=(v))
#endif
template<int THRL> __device__ __forceinline__ void attn_unit(int b,int h,int qb,const bf16*Q,const bf16*__restrict__ K,const bf16*__restrict__ V,bf16*O,const float*F2seq,char*shm){
  int tid_ = threadIdx.x; asm volatile("" : "+v"(tid_)); const int tid = tid_,lane=tid&63,r32=lane&31,hi=lane>>5; const int wid=__builtin_amdgcn_readfirstlane(tid>>6);
  const long rowbase=(long)b*SEQ; const int q0=qb*QB;
  typedef __attribute__((address_space(3))) float* lds_fptr; typedef __attribute__((address_space(3))) f32x4v* lds_f4ptr;
  const lds_fptr Fl=(lds_fptr)(shm+LDS_F);
  { const f32x4v*Fg=(const f32x4v*)F2seq; const int nF=(q0+QB)>>2; for(int i=tid;i<nF;i+=NW*64)((lds_f4ptr)Fl)[i]=Fg[i]; }
  const float fq2=F2seq[q0+wid*QBLK+r32];
  const bf16*Qw=Q+(rowbase+q0+wid*QBLK)*QP+h*D;
  const bf16*Kh=K+rowbase*KP+h*D,*Vh=V+rowbase*VP+h*D;
  const unsigned lds0=(unsigned)(uintptr_t)shm;
  float*wsf=(float*)(shm+LDS_WS)+wid*64;
  const bf16*ksrc=Kh+(long)lane*KP+wid*8;
  const bf16*vsrc=Vh+(long)(16*(wid&3)+(lane>>2))*VP+(wid>>2)*32+(lane&3)*8;
  const unsigned kdst=lds0+LDS_K+wid*1024, vdst=lds0+LDS_V+wid*1024;
  #define DMA_K(t,slot) glds16(ksrc+(long)(t)*KVBLK*KP,(unsigned)__builtin_amdgcn_readfirstlane(kdst+(slot)))
  #define DMA_V(t,slot) glds16(vsrc+(long)(t)*KVBLK*VP,(unsigned)__builtin_amdgcn_readfirstlane(vdst+(slot)))
  const int vb0=(int)(lds0+LDS_V)+((lane>>4)&1)*32+(lane&3)*8+(4*hi+((lane&15)>>2))*64;
  const char*Kbase=shm+LDS_K; bf16x8 kf[8];
  const lds_cptr shm3=(lds_cptr)shm; const lds_cptr kp0=shm3+LDS_K+hi*1024+r32*16; const lds_cptr vp0=shm3+LDS_V+((lane>>4)&1)*32+(lane&3)*8+(4*hi+((lane&15)>>2))*64;
  const int NT=(q0+QB)/KVBLK;
  DMA_K(0,0);DMA_V(0,0);DMA_K(1,SLOTB);
  bf16x8 qr[4];
  #pragma unroll
  for(int d0=0;d0<4;++d0)qr[d0]=*reinterpret_cast<const bf16x8*>(&Qw[(long)r32*QP+d0*16+hi*8]);
  float mhat=0.f,l_reg=0.f;f32x16 o[2];o[0]=f32x16{};o[1]=f32x16{};
  #define BIAS(C0,C1,t) do{ const float nb_=fq2-mhat; const lds_fptr fk_=Fl+64*(t)+4*hi; \
    _Pragma("unroll") for(int j_=0;j_<4;++j_){ const f32x4v a_=*(const lds_f4ptr)(fk_+8*j_); const f32x4v c_=*(const lds_f4ptr)(fk_+32+8*j_); \
      C0[4*j_]=nb_-a_.x; C0[4*j_+1]=nb_-a_.y; C0[4*j_+2]=nb_-a_.z; C0[4*j_+3]=nb_-a_.w; C1[4*j_]=nb_-c_.x; C1[4*j_+1]=nb_-c_.y; C1[4*j_+2]=nb_-c_.z; C1[4*j_+3]=nb_-c_.w; } }while(0)
  const int qrel=wid*QBLK+r32;
  #define CMASK(P0,P1,t) do{int jb_=(t)-(NT-4); if(jb_>=0)cmask(P0,P1,jb_,qrel,hi);}while(0)
  bool resc=false;
  #define START(P0,P1) do{ const float rm=rowmax(P0,P1); resc=false; \
    { const float dl=rm; mhat=fadd_s(mhat,dl); \
      _Pragma("unroll") for(int r=0;r<16;++r){P0[r]=fsub_s(P0[r],dl);P1[r]=fsub_s(P1[r],dl);} } \
    _Pragma("unroll") for(int r=0;r<16;++r)P0[r]=__builtin_amdgcn_exp2f(P0[r]); }while(0)
  #define RESC() do{ if(resc){ asm volatile("s_waitcnt lgkmcnt(0)":::"memory"); \
      _Pragma("unroll") for(int d_=0;d_<2;++d_) _Pragma("unroll") for(int r=0;r<16;++r)o[d_][r]*=wsf[crow(r,hi)]; } }while(0)
  f32x16 pA0,pA1,pB0,pB1;
  int sl_prev=0,sl_cur=0,sl_next=SLOTB;
  #define ROT() do{sl_prev=sl_cur;sl_cur=sl_next;sl_next=(sl_next==(NSLOT-1)*SLOTB)?0:sl_next+SLOTB;}while(0)
  DMA_K(2,2*SLOTB);
  WAIT_BAR(3);
  BIAS(pA0,pA1,0); qkt(pA0,pA1,Kbase,qr,r32,hi);asm volatile("s_nop 15\n\ts_nop 7":"+v"(pA0),"+v"(pA1));CMASK(pA0,pA1,0);
  START(pA0,pA1);
  _Pragma("unroll") for(int r=0;r<16;++r)pA1[r]=__builtin_amdgcn_exp2f(pA1[r]);
  WAIT_BAR(0);
  DMA_K(3,0);DMA_V(1,SLOTB);
  ROT();
  kload8(kf,kp0+sl_cur);
  WAIT_BAR(2);
  s16x4 vlo[8],vhi[8]; u32x4 pw0,pw1,pw2,pw3;
  #define PKW(P,B) cvtpk_s(P[B],P[B+1])
  #define PAF(k) __builtin_bit_cast(bf16x8,pw##k)
  #define VFR(i) (bf16x8){vlo[i][0],vlo[i][1],vlo[i][2],vlo[i][3],vhi[i][0],vhi[i][1],vhi[i][2],vhi[i][3]}
  #define PIN(x) asm volatile("":"+v"(x))
  #define MX3(a,b,c) __builtin_fmaxf(__builtin_fmaxf((a),(b)),(c))
  #define GAPA(MF,A0,A1,A2,A3,W0,W1,PW) do{ MF; sacc+=A0; sacc+=A1; sacc+=A2; sacc+=A3; PIN(sacc); W0; W1; PIN(PW); SBAR(); }while(0)
  #define EX(v) __builtin_amdgcn_exp2f(v)
  #define GAPB(MF,X,B) do{ MF; X[B]=EX(X[B]); X[B+1]=EX(X[B+1]); X[B+2]=EX(X[B+2]); X[B+3]=EX(X[B+3]); PIN(X); SBAR(); }while(0)
  #define VRD(i) do{ vlo[i]=vtr(vp_+(((i)>>2)*4096+((i)&3)*1024)); vhi[i]=vtr(vp_+(((i)>>2)*4096+((i)&3)*1024+512)); }while(0)
  #define KRD(G,j) do{ if(G){ kload2(kf,kp0+sl_next,j); SBAR(); } }while(0)
  #define STEP(C0,C1,P0,P1,t,GK,GV,GL) do{ BIAS(C0,C1,t); SBAR(); \
    const lds_cptr vp_=vp0+sl_prev; \
    VRD(0); SBAR(); float sacc=(P0[0]+P0[1]); \
    GAPA(C0=__builtin_amdgcn_mfma_f32_32x32x16_bf16(kf[0],qr[0],C0,0,0,0), P0[2],P0[3],P0[4],P0[5],     pw0[0]=PKW(P0,0), pw0[1]=PKW(P0,2), pw0); \
    VRD(4); SBAR(); GAPA(C1=__builtin_amdgcn_mfma_f32_32x32x16_bf16(kf[1],qr[0],C1,0,0,0), P0[6],P0[7],P0[8],P0[9],     pw0[2]=PKW(P0,4), pw0[3]=PKW(P0,6), pw0); \
    VRD(1); SBAR(); GAPA(C0=__builtin_amdgcn_mfma_f32_32x32x16_bf16(kf[2],qr[1],C0,0,0,0),   P0[10],P0[11],P0[12],P0[13], pw1[0]=PKW(P0,8), pw1[1]=PKW(P0,10), pw1); \
    VRD(5); SBAR(); GAPA(C1=__builtin_amdgcn_mfma_f32_32x32x16_bf16(kf[3],qr[1],C1,0,0,0),   P0[14],P0[15],P1[0],P1[1],   pw1[2]=PKW(P0,12),pw1[3]=PKW(P0,14), pw1); \
    VRD(2); SBAR(); GAPA(C0=__builtin_amdgcn_mfma_f32_32x32x16_bf16(kf[4],qr[2],C0,0,0,0),   P1[2],P1[3],P1[4],P1[5],     pw2[0]=PKW(P1,0), pw2[1]=PKW(P1,2), pw2); \
    VRD(6); SBAR(); GAPA(C1=__builtin_amdgcn_mfma_f32_32x32x16_bf16(kf[5],qr[2],C1,0,0,0),   P1[6],P1[7],P1[8],P1[9],     pw2[2]=PKW(P1,4), pw2[3]=PKW(P1,6), pw2); \
    VRD(3); SBAR(); GAPA(C0=__builtin_amdgcn_mfma_f32_32x32x16_bf16(kf[6],qr[3],C0,0,0,0),   P1[10],P1[11],P1[12],P1[13], pw3[0]=PKW(P1,8), pw3[1]=PKW(P1,10), pw3); \
    VRD(7); SBAR(); GAPA(C1=__builtin_amdgcn_mfma_f32_32x32x16_bf16(kf[7],qr[3],C1,0,0,0),   P1[14],P1[15],0.f,0.f,       pw3[2]=PKW(P1,12),pw3[3]=PKW(P1,14), pw3); \
    l_reg+=sacc; \
    if(GK){DMA_K((t)+3,sl_cur);} if(GV){DMA_V((t)+1,sl_next);} \
    CMASK(C0,C1,t); \
    { float a=MX3(C0[0],C0[1],C1[0]),b=MX3(C0[2],C0[3],C1[1]); a=MX3(a,C1[2],C1[3]); \
      _Pragma("unroll") for(int r=4;r<16;r+=4){a=MX3(a,C0[r],C0[r+1]);b=MX3(b,C0[r+2],C0[r+3]);a=MX3(a,C1[r],C1[r+1]);b=MX3(b,C1[r+2],C1[r+3]);} \
      float rm=__builtin_fmaxf(a,b); { auto rr=__builtin_amdgcn_permlane32_swap(__float_as_uint(rm),__float_as_uint(rm),false,false); rm=__builtin_fmaxf(__uint_as_float(rr[0]),__uint_as_float(rr[1])); } \
      resc=false; \
      if(__builtin_expect(__any(rm>(float)THRL),0)){ const float dl=__builtin_fmaxf(rm,0.f); mhat+=dl; \
        _Pragma("unroll") for(int r=0;r<16;++r){C0[r]-=dl;C1[r]-=dl;} \
        const float f=__builtin_amdgcn_exp2f(-dl); l_reg*=f; if(hi==0)wsf[r32]=f; resc=true; } } \
    SBAR(); \
    GAPB(o[0]=__builtin_amdgcn_mfma_f32_32x32x16_bf16(PAF(0),VFR(0),o[0],0,0,0), C0,0); \
    GAPB(o[1]=__builtin_amdgcn_mfma_f32_32x32x16_bf16(PAF(0),VFR(4),o[1],0,0,0), C0,4); \
    KRD(GL,0); GAPB(o[0]=__builtin_amdgcn_mfma_f32_32x32x16_bf16(PAF(1),VFR(1),o[0],0,0,0), C0,8); \
    KRD(GL,1); GAPB(o[1]=__builtin_amdgcn_mfma_f32_32x32x16_bf16(PAF(1),VFR(5),o[1],0,0,0), C0,12); \
    KRD(GL,2); GAPB(o[0]=__builtin_amdgcn_mfma_f32_32x32x16_bf16(PAF(2),VFR(2),o[0],0,0,0), C1,0); \
    KRD(GL,3); GAPB(o[1]=__builtin_amdgcn_mfma_f32_32x32x16_bf16(PAF(2),VFR(6),o[1],0,0,0), C1,4); \
    GAPB(o[0]=__builtin_amdgcn_mfma_f32_32x32x16_bf16(PAF(3),VFR(3),o[0],0,0,0), C1,8); \
    GAPB(o[1]=__builtin_amdgcn_mfma_f32_32x32x16_bf16(PAF(3),VFR(7),o[1],0,0,0), C1,12); \
    }while(0)
  int t=1;
  #undef CMASK
  #define CMASK(P0,P1,t) do{}while(0)
  for(;t+5<NT;t+=2){
    STEP(pB0,pB1,pA0,pA1,t,true,true,true);     WAIT_BAR(2); RESC(); ROT();
    STEP(pA0,pA1,pB0,pB1,t+1,true,true,true);   WAIT_BAR(2); RESC(); ROT();
  }
  #undef CMASK
  #define CMASK(P0,P1,t) do{int jb_=(t)-(NT-4); if(jb_>=0)cmask(P0,P1,jb_,qrel,hi);}while(0)
  #define ENDW(tt) do{ if((tt)+3<NT){WAIT_BAR(2);} else if((tt)+2<NT){WAIT_BAR(1);} else {WAIT_BAR(0);} }while(0)
  for(;t+1<NT;t+=2){
    STEP(pB0,pB1,pA0,pA1,t,(t+3<NT),(t+1<NT),(t+1<NT));       ENDW(t);   RESC(); ROT();
    STEP(pA0,pA1,pB0,pB1,t+1,(t+4<NT),(t+2<NT),(t+2<NT));     ENDW(t+1); RESC(); ROT();
  }
  STEP(pB0,pB1,pA0,pA1,NT-1,false,false,false); RESC();
  { float sacc=pB0[0]+pB0[1]; _Pragma("unroll") for(int r=2;r<16;++r)sacc+=pB0[r]; _Pragma("unroll") for(int r=0;r<16;++r)sacc+=pB1[r]; l_reg+=sacc;
    pw0=(u32x4){PKW(pB0,0),PKW(pB0,2),PKW(pB0,4),PKW(pB0,6)};pw1=(u32x4){PKW(pB0,8),PKW(pB0,10),PKW(pB0,12),PKW(pB0,14)};pw2=(u32x4){PKW(pB1,0),PKW(pB1,2),PKW(pB1,4),PKW(pB1,6)};pw3=(u32x4){PKW(pB1,8),PKW(pB1,10),PKW(pB1,12),PKW(pB1,14)};
    SBAR(); pv(o,vb0+sl_cur,PAF(0),PAF(1),PAF(2),PAF(3)); }
  #undef PKW
  #undef PAF
  #undef VFR
  #undef PIN
  #undef MX3
  #undef GAPA
  #undef GAPB
  #undef EX
  #undef VRD
  #undef KRD
  #undef STEP
  #undef ENDW
  {auto rr=__builtin_amdgcn_permlane32_swap(__float_as_uint(l_reg),__float_as_uint(l_reg),false,false);l_reg=__uint_as_float(rr[0])+__uint_as_float(rr[1]);}
  if(hi==0)wsf[32+r32]=l_reg;asm volatile("s_waitcnt lgkmcnt(0)":::"memory");
  float rli[16];
  #pragma unroll
  for(int r=0;r<16;++r)rli[r]=__builtin_amdgcn_rcpf(wsf[32+crow(r,hi)]);
  bf16*Ow=O+(rowbase+q0+wid*QBLK)*OP+h*D;
  { bf16*stg=(bf16*)(shm+LDS_OST)+wid*2048;
    #pragma unroll
    for(int r=0;r<16;++r){const int orow=crow(r,hi);
      #pragma unroll
      for(int d0=0;d0<2;++d0)stg[orow*64+d0*32+r32]=__float2bfloat16(o[d0][r]*rli[r]);}
    asm volatile("s_waitcnt lgkmcnt(0)":::"memory");
    #pragma unroll
    for(int i=0;i<4;++i){const int row=i*8+(lane>>3),ch=lane&7; const u32x4 v=*(const u32x4*)(stg+row*64+ch*8); ATTN_STORE16(Ow+(long)row*OP+ch*8,v);} }
  asm volatile("s_waitcnt lgkmcnt(0)\n\ts_barrier":::"memory");
  #undef DMA_K
  #undef DMA_V
  #undef CMASK
  #undef START
  #undef RESC
  #undef BIAS
  #undef ROT
}
constexpr int ATTN_LDS_BYTES=LDS_F+LDS_F_BYTES;
#undef SBAR
#undef WAIT_BAR
}
#define GAS __attribute__((address_space(1)))
#define LAS __attribute__((address_space(3)))
typedef unsigned short bf16;
typedef unsigned v4u __attribute__((ext_vector_type(4)));
typedef float f32x4 __attribute__((ext_vector_type(4)));
typedef short bf16x8 __attribute__((ext_vector_type(8)));
typedef GAS unsigned gu32;
typedef GAS unsigned long long gu64;
#define RLX_AGENT __ATOMIC_RELAXED, __HIP_MEMORY_SCOPE_AGENT
#define LDS_WAIT() asm volatile("s_waitcnt lgkmcnt(0)" ::: "memory")
#define VM_WAIT() asm volatile("s_waitcnt vmcnt(0)" ::: "memory")
__device__ __forceinline__ unsigned long long rt() { return __builtin_amdgcn_s_memrealtime(); }
__device__ __forceinline__ unsigned f2bf(float f) { unsigned u = __builtin_bit_cast(unsigned, f); return (u + 0x7fffu + ((u >> 16) & 1u)) >> 16; }
__device__ __forceinline__ unsigned pk2(float lo, float hi) { return f2bf(lo) | (f2bf(hi) << 16); }

#define XB_TMO      128
#define XB_XCNT(j)  (256  + 64 * (j))
#define XB_XSUB(j)  (1280 + 64 * (j))
#define XB_XGEN(j)  (2304 + 64 * (j))
#define XB_TOP      3328
#define XB_TOPGEN   3392
#define XCD_BAR_WORDS 3456
#define XB_SPIN_CAP (1u << 18)

__device__ __forceinline__ unsigned xb_ld(unsigned* p)              { return __hip_atomic_load(p, __ATOMIC_RELAXED, __HIP_MEMORY_SCOPE_AGENT); }
__device__ __forceinline__ unsigned xb_add(unsigned* p, unsigned v) { return __hip_atomic_fetch_add(p, v, __ATOMIC_RELAXED, __HIP_MEMORY_SCOPE_AGENT); }
__device__ __forceinline__ unsigned xb_xcc_id() { return (unsigned)__builtin_amdgcn_s_getreg((3 << 11) | 20) & 0xFu; }
#define XB_SPIN(cond, bar) do { unsigned _sp = 0; while (cond) { __builtin_amdgcn_s_sleep(1); \
    if ((++_sp & 255u) == 0u) { if (xb_ld(&(bar)[XB_TMO])) break; if (_sp > XB_SPIN_CAP) { atomicAdd(&(bar)[XB_TMO], 1u); break; } } } } while (0)

struct XcdBarrier {
    unsigned* bar; unsigned x;
    volatile LAS unsigned* st;
};

__device__ __forceinline__ XcdBarrier xcd_barrier_post(unsigned* bar, volatile LAS unsigned* st) {
    XcdBarrier b; b.bar = bar; b.x = xb_xcc_id(); b.st = st;
    if (threadIdx.x == 0) (void)xb_add(&bar[XB_XCNT(b.x)], 1u);
    return b;
}
__device__ __forceinline__ void xcd_barrier_complete(unsigned* bar, unsigned x, unsigned& nloc, unsigned& nx) {
    const unsigned G = gridDim.x * gridDim.y * gridDim.z;
    unsigned sum, cnt, mine, sp = 0u;
    for (;;) {
        sum = 0u; cnt = 0u; mine = 0u;
#pragma unroll
        for (unsigned j = 0; j < 16; ++j) { const unsigned c = xb_ld(&bar[XB_XCNT(j)]); sum += c; cnt += (c > 0u) ? 1u : 0u; mine = (j == x) ? c : mine; }
        if (sum == G) break;
        __builtin_amdgcn_s_sleep(1);
        if ((++sp & 255u) == 0u) { if (xb_ld(&bar[XB_TMO])) break; if (sp > XB_SPIN_CAP) { atomicAdd(&bar[XB_TMO], 1u); break; } }
    }
    nloc = mine > 0u ? mine : 1u; nx = cnt > 0u ? cnt : 1u;
}

__device__ __forceinline__ void xcd_barrier(const XcdBarrier& b) {
    asm volatile("s_waitcnt vmcnt(0)" ::: "memory");
    __syncthreads();
    if (threadIdx.x == 0) {
        unsigned* bar = b.bar;
        __builtin_amdgcn_s_waitcnt(0);
        unsigned nloc = b.st[0], nx = b.st[1];
        if (nloc == 0u) { xcd_barrier_complete(bar, b.x, nloc, nx); b.st[0] = nloc; b.st[1] = nx; }
        const unsigned old = xb_add(&bar[XB_XSUB(b.x)], 1u);
        const unsigned gen = old / nloc;
        if (old + 1u == (gen + 1u) * nloc) {
            __builtin_amdgcn_fence(__ATOMIC_RELEASE, "agent");
            asm volatile("s_waitcnt vmcnt(0)" ::: "memory");
            const unsigned og = xb_add(&bar[XB_TOP], 1u);
            const unsigned tg = og / nx;
            if (og + 1u == (tg + 1u) * nx) xb_add(&bar[XB_TOPGEN], 1u);
            else XB_SPIN(xb_ld(&bar[XB_TOPGEN]) == tg, bar);
            __builtin_amdgcn_fence(__ATOMIC_ACQUIRE, "agent");
            xb_add(&bar[XB_XGEN(b.x)], 1u);
            asm volatile("s_waitcnt vmcnt(0)" ::: "memory");
        } else {
            XB_SPIN(xb_ld(&bar[XB_XGEN(b.x)]) == gen, bar);
            __builtin_amdgcn_fence(__ATOMIC_ACQUIRE, "agent");
            asm volatile("s_waitcnt vmcnt(0)" ::: "memory");
        }
    }
    __syncthreads();
}
constexpr int NWAVES = 8, NTHR = NWAVES * 64;
constexpr int T_ = 16384, DM_ = 1024, SEQ_ = 4096, NBH = 48, NHEADS = 12;
constexpr int EV_LD = 2828, EV_N = 2816;
constexpr int NEXP = 16, EHID = 256, SLOTS = 36864;
constexpr float EPS_ = 1e-6f, LOG2E = 1.4426950408889634f;
constexpr int NPH = 15;
constexpr size_t MiB = 1u << 20;
constexpr size_t WS_CTL = 0, CTL_ZERO_BYTES = 1 * MiB;
constexpr size_t WS_WIN0 = 1 * MiB, WS_WOUT0 = 7 * MiB, WS_WIN1 = 9 * MiB, WS_WOUT1 = 13 * MiB, WS_WST = 15 * MiB, WS_WGU = 16 * MiB, WS_WD = 48 * MiB;
constexpr size_t WS_XN = 64 * MiB;
constexpr size_t WS_A = 96 * MiB;
constexpr size_t WS_U = WS_A, WS_V = WS_A + 8 * MiB, WS_Q = WS_A + 16 * MiB, WS_K = WS_A + 40 * MiB, WS_VAL = WS_A + 64 * MiB;
constexpr size_t WS_Y = WS_A, WS_H1 = WS_A;
constexpr size_t WS_MIX = 184 * MiB;
constexpr size_t WS_HID = 216 * MiB;
constexpr size_t WS_F2 = 234 * MiB, WS_LIST = 235 * MiB, WS_LISTW = 236 * MiB, WS_TOKE = 237 * MiB, WS_TOKP = 237 * MiB + 512 * 1024, WS_END = 240 * MiB;
static_assert(WS_Y + (size_t)SLOTS * 1024 * 2 <= WS_MIX && WS_HID + (size_t)SLOTS * 256 * 2 <= WS_F2 && WS_VAL + (size_t)T_ * 768 * 2 <= WS_MIX, "ws map");
constexpr int CW_TMO = 0, CW_BAR = 4096, CW_Q = 8192, CW_CNT0 = 16384, CW_CNT1 = 16384 + 1024, CNT_STRIDE = 64;
constexpr int RING_BYTES = 131072, LDSCTL_OFF = RING_BYTES, MISC_OFF = LDSCTL_OFF + 320, LDS_BYTES = 147456;

__device__ __forceinline__ float wave_sum(float v) {
#pragma unroll
    for (int o = 1; o < 64; o <<= 1) v += __shfl_xor(v, o);
    return v;
}
__device__ __forceinline__ float fast_sigmoid(float z) { return __builtin_amdgcn_rcpf(1.f + __builtin_amdgcn_exp2f(-z * LOG2E)); }
__device__ __forceinline__ float gelu_tanh(float x) { const float z = 1.5957691216057308f * x * (1.f + 0.044715f * x * x); return x * fast_sigmoid(z); }
__device__ __forceinline__ float bf2f(unsigned short h) { return __builtin_bit_cast(float, (unsigned)h << 16); }

__device__ __forceinline__ void tr_item(const float* W, int ldw, bf16* WT, int Kp, LAS float* scr, int k0, int n0, int drow0, int lane) {
#pragma unroll 8
    for (int i = 0; i < 32; ++i) { const int kk = 2 * i + (lane >> 5); scr[kk * 33 + (lane & 31)] = W[(size_t)(k0 + kk) * ldw + n0 + (lane & 31)]; }
    LDS_WAIT(); asm volatile("" ::: "memory");
    const int c = lane & 7;
#pragma unroll
    for (int j = 0; j < 4; ++j) { const int n = (lane >> 3) + 8 * j; const LAS float* s = scr + (8 * c) * 33 + n;
        v4u o; o.x = pk2(s[0 * 33], s[1 * 33]); o.y = pk2(s[2 * 33], s[3 * 33]); o.z = pk2(s[4 * 33], s[5 * 33]); o.w = pk2(s[6 * 33], s[7 * 33]);
        *(GAS v4u*)(WT + (size_t)(drow0 + n) * Kp + k0 + 8 * c) = o; }
    LDS_WAIT(); asm volatile("" ::: "memory");
}
struct P0Args { const float* const* in; unsigned char* ws; };
template <class IN_T> __device__ __forceinline__ void p0_prologue(const IN_T in, unsigned char* ws, LAS unsigned char* lds, int G, int vcu) {
    int tid_ = threadIdx.x; asm volatile("" : "+v"(tid_)); const int tid = tid_, lane = tid & 63, wave = __builtin_amdgcn_readfirstlane(tid >> 6);
    LAS float* scr = (LAS float*)(lds + wave * 16384);
    const int gw = vcu * NWAVES + wave, NGW = G * NWAVES;
    constexpr int I0 = 16 * 88, I1 = 16 * 32, I2 = 16 * 64, I3 = 8 * 32, I4 = 32 * 128, NITEMS = I0 + I1 + I2 + I3 + 3 * I4;
    { const float* const w_in0 = in[2]; const float* const w_out0 = in[9]; const float* const w_in1 = in[11]; const float* const w_out1 = in[15]; const float* const w_gate = in[21]; const float* const w_up = in[22]; const float* const w_down = in[23];
    for (int it = gw; it < NITEMS; it += NGW) {
        int r = it;
        if (r < I0) { const int kb = r / 88, nb = r % 88, n0 = 32 * nb, c = n0 & 255;
            tr_item(w_in0, EV_LD, (bf16*)(ws + WS_WIN0), 1024, scr, 64 * kb, n0, (n0 & ~255) + 128 * ((c >> 5) & 1) + 32 * (c >> 6), lane); continue; } r -= I0;
        if (r < I1) { const int kb = r / 32, nb = r % 32; tr_item(w_out0, 1024, (bf16*)(ws + WS_WOUT0), 1024, scr, 64 * kb, 32 * nb, 32 * nb, lane); continue; } r -= I1;
        if (r < I2) { const int kb = r / 64, nb = r % 64; tr_item(w_in1, 2048, (bf16*)(ws + WS_WIN1), 1024, scr, 64 * kb, 32 * nb, 32 * nb, lane); continue; } r -= I2;
        if (r < I3) { const int kb = r / 32, nb = r % 32; tr_item(w_out1, 1024, (bf16*)(ws + WS_WOUT1), 1024, scr, 64 * kb, 32 * nb, 32 * nb, lane); continue; } r -= I3;
        if (r < I4) { const int le = r / 128, rr = r % 128, kb = rr / 8, n0 = 32 * (rr % 8);
            tr_item(w_gate + (size_t)le * 1024 * 256, 256, (bf16*)(ws + WS_WGU) + (size_t)le * 512 * 1024, 1024, scr, 64 * kb, n0, (n0 >> 7) * 256 + (n0 & 127), lane); continue; } r -= I4;
        if (r < I4) { const int le = r / 128, rr = r % 128, kb = rr / 8, n0 = 32 * (rr % 8);
            tr_item(w_up + (size_t)le * 1024 * 256, 256, (bf16*)(ws + WS_WGU) + (size_t)le * 512 * 1024, 1024, scr, 64 * kb, n0, (n0 >> 7) * 256 + 128 + (n0 & 127), lane); continue; } r -= I4;
        { const int le = r / 128, rr = r % 128, kb = rr / 32, n0 = 32 * (rr % 32);
            tr_item(w_down + (size_t)le * 256 * 1024, 1024, (bf16*)(ws + WS_WD) + (size_t)le * 1024 * 256, 256, scr, 64 * kb, n0, n0, lane); }
    } }
    const int gt = vcu * NTHR + tid, NGT = G * NTHR;
    { const float* const w_s = in[4]; for (int i = gt; i < 4 * 128 * 128; i += NGT) { const int s = i & 127, t = (i >> 7) & 127; ((GAS bf16*)(ws + WS_WST))[i] = (s <= t) ? (bf16)f2bf(w_s[i]) : (bf16)0; } }
    { const float* const w_pool = in[13]; const float* const p_scale = in[14]; const float* const w_out1 = in[15];
    for (int i = gt; i < 512 * 1024; i += NGT) { const int n = i & 1023, kk = i >> 10, g = kk >> 7;
        const float* wp = w_pool + (size_t)kk * 128; const float* sc = p_scale + g * 128; const float* wo = w_out1 + (size_t)(512 + g * 128) * 1024 + n;
        float a = 0.f;
#pragma unroll 8
        for (int d = 0; d < 128; ++d) a += wp[d] * sc[d] * wo[(size_t)d * 1024];
        ((GAS bf16*)(ws + WS_WOUT1))[(size_t)n * 1024 + 512 + kk] = (bf16)f2bf(a); } }
    __syncthreads();
    LAS float* wf = (LAS float*)lds;
    const float* const x = in[0]; const float* const gn = in[1]; const float* const b_forget = in[3];
    { const float* const w_in0 = in[2]; for (int i = tid; i < 1024 * 12; i += NTHR) { const int k = i / 12, h = i % 12; wf[i] = w_in0[(size_t)k * EV_LD + EV_N + h] * gn[k]; } }
    __syncthreads();
    for (int m = gw; m < T_; m += NGW) {
        const GAS f32x4* xr = (const GAS f32x4*)(x + (size_t)m * DM_) + lane;
        float ss = 0.f; float a[12];
#pragma unroll
        for (int h = 0; h < 12; ++h) a[h] = 0.f;
#pragma unroll 1
        for (int j = 0; j < 4; ++j) { const f32x4 vj = xr[64 * j]; ss += (vj.x * vj.x + vj.y * vj.y) + (vj.z * vj.z + vj.w * vj.w);
#pragma unroll
            for (int e = 0; e < 4; ++e) { const float xv = vj[e]; const LAS f32x4* w4 = (const LAS f32x4*)(wf + (256 * j + 4 * lane + e) * 12);
                const f32x4 w0 = w4[0], w1 = w4[1], w2 = w4[2];
                a[0] += xv * w0.x; a[1] += xv * w0.y; a[2] += xv * w0.z; a[3] += xv * w0.w; a[4] += xv * w1.x; a[5] += xv * w1.y; a[6] += xv * w1.z; a[7] += xv * w1.w;
                a[8] += xv * w2.x; a[9] += xv * w2.y; a[10] += xv * w2.z; a[11] += xv * w2.w; } }
        const float rstd = __builtin_amdgcn_rsqf(wave_sum(ss) * (1.f / DM_) + EPS_);
        float zsel = 0.f;
#pragma unroll
        for (int h = 0; h < 12; ++h) { const float s = wave_sum(a[h]); zsel = (lane == h) ? s : zsel; }
        if (lane < 12) { const float z = zsel * rstd + b_forget[lane];
            const float ls = (z >= 0.f) ? -log1pf(__expf(-z)) : (z - log1pf(__expf(z)));
            ((GAS float*)(ws + WS_F2))[(size_t)((m >> 12) * NHEADS + lane) * SEQ_ + (m & (SEQ_ - 1))] = ls * LOG2E; }
        GAS unsigned long long* o8 = (GAS unsigned long long*)(ws + WS_XN + (size_t)m * DM_ * 2) + lane;
#pragma unroll 1
        for (int j = 0; j < 4; ++j) { const f32x4 vj = xr[64 * j]; const f32x4 g4 = *((const GAS f32x4*)gn + 64 * j + lane);
            o8[64 * j] = (unsigned long long)pk2(vj.x * rstd * g4.x, vj.y * rstd * g4.y) | ((unsigned long long)pk2(vj.z * rstd * g4.z, vj.w * rstd * g4.w) << 32); }
    }
}

__device__ __forceinline__ void scan_seq(float* f, LAS float* tot) {
    int tid_ = threadIdx.x; asm volatile("" : "+v"(tid_)); const int tid = tid_, lane = tid & 63, wave = tid >> 6;
    GAS f32x4* p = (GAS f32x4*)f + 2 * tid; f32x4 a = p[0], b = p[1];
    a.y += a.x; a.z += a.y; a.w += a.z; b.x += a.w; b.y += b.x; b.z += b.y; b.w += b.z;
    float run = b.w;
#pragma unroll
    for (int o = 1; o < 64; o <<= 1) { const float t = __shfl_up(run, o); if (lane >= o) run += t; }
    if (lane == 63) tot[wave] = run;
    __syncthreads();
    float base = run - b.w;
    for (int w = 0; w < wave; ++w) base += tot[w];
    a = a + base; b = b + base; p[0] = a; p[1] = b;
    __syncthreads();
}

struct EpiInproj0 {
    static constexpr bool PERM = true;
    bf16 *U, *V, *Q, *Kb, *VAL; const float *g_v, *g_q, *g_k;
    __device__ __forceinline__ void operator()(const pg8::f32x4 (&acc)[2][2][4][2], const pg8::Unit& u, int wr, int wc, int fr, int fq) const {
        const int pn = u.pn; const bool act = pn <= 1, nrm = (pn >= 1 && pn <= 7);
        bf16* dst; int pitch, cb; const float* gp = nullptr; float gs = 1.f;
        if (pn == 0) { dst = U; pitch = 256; cb = 0; }
        else if (pn == 1) { dst = V; pitch = 256; cb = 0; gp = g_v + wc * 64; }
        else if (pn <= 4) { dst = Q; pitch = 768; cb = (pn - 2) * 256; gp = g_q; gs = 0.125f * LOG2E; }
        else if (pn <= 7) { dst = Kb; pitch = 768; cb = (pn - 5) * 256; gp = g_k; }
        else { dst = VAL; pitch = 768; cb = (pn - 8) * 256; }
        f32x4 gn[2][2];
#pragma unroll
        for (int bj = 0; bj < 2; ++bj)
#pragma unroll
            for (int n = 0; n < 2; ++n) { gn[bj][n] = (f32x4){1.f, 1.f, 1.f, 1.f}; if (nrm) gn[bj][n] = *(const f32x4*)(gp + 32 * bj + 8 * fq + 4 * n) * gs; }
        const int row0 = u.pm * 256 + wr * 64 + fr, col0 = cb + 64 * wc + 8 * fq;
#pragma unroll
        for (int ai = 0; ai < 2; ++ai)
#pragma unroll
            for (int m = 0; m < 4; ++m) {
                f32x4 x[2][2]; float ss = 0.f;
#pragma unroll
                for (int bj = 0; bj < 2; ++bj)
#pragma unroll
                    for (int n = 0; n < 2; ++n) { f32x4 t = acc[ai][bj][m][n];
                        if (act) { t.x = gelu_tanh(t.x); t.y = gelu_tanh(t.y); t.z = gelu_tanh(t.z); t.w = gelu_tanh(t.w); }
                        ss += (t.x * t.x + t.y * t.y) + (t.z * t.z + t.w * t.w); x[bj][n] = t; }
                float r = 1.f;
                if (nrm) { ss += __shfl_xor(ss, 16); ss += __shfl_xor(ss, 32); r = __builtin_amdgcn_rsqf(ss * (1.f / 64.f) + EPS_); }
                bf16* rowp = dst + (size_t)(row0 + ai * 128 + m * 16) * pitch + col0;
#pragma unroll
                for (int bj = 0; bj < 2; ++bj) { const f32x4 v0 = x[bj][0] * gn[bj][0] * r, v1 = x[bj][1] * gn[bj][1] * r;
                    v4u w; w.x = pg8::cvt_pk_bf16(v0.x, v0.y); w.y = pg8::cvt_pk_bf16(v0.z, v0.w); w.z = pg8::cvt_pk_bf16(v1.x, v1.y); w.w = pg8::cvt_pk_bf16(v1.z, v1.w);
                    *(v4u*)(rowp + 32 * bj) = w; }
            }
    }
};
struct EpiResF32 {
    static constexpr bool PERM = false;
    const float* base; float* out;
    __device__ __forceinline__ void operator()(const pg8::f32x4 (&acc)[2][2][4][2], const pg8::Unit& u, int wr, int wc, int fr, int fq) const {
        const int row0 = u.pm * 256 + wr * 64 + fr, col0 = u.pn * 256 + wc * 32 + 4 * fq;
#pragma unroll
        for (int ai = 0; ai < 2; ++ai)
#pragma unroll
            for (int m = 0; m < 4; ++m) { const size_t off = (size_t)(row0 + ai * 128 + m * 16) * DM_ + col0;
#pragma unroll
                for (int bj = 0; bj < 2; ++bj)
#pragma unroll
                    for (int n = 0; n < 2; ++n) { const f32x4 b = *(const f32x4*)(base + off + bj * 128 + n * 16); *(f32x4*)(out + off + bj * 128 + n * 16) = b + acc[ai][bj][m][n]; }
                if (m & 1) asm volatile("" ::: "memory"); }
    }
};
struct EpiBf16 {
    static constexpr bool PERM = true;
    bf16* O; int ldc;
    __device__ __forceinline__ void operator()(const pg8::f32x4 (&acc)[2][2][4][2], const pg8::Unit& u, int wr, int wc, int fr, int fq) const {
        const int row0 = u.pm * 256 + wr * 64 + fr, col0 = u.pn * 256 + wc * 32 + 8 * fq;
#pragma unroll
        for (int ai = 0; ai < 2; ++ai)
#pragma unroll
            for (int m = 0; m < 4; ++m) { bf16* rowp = O + (size_t)(row0 + ai * 128 + m * 16) * ldc + col0;
#pragma unroll
                for (int bj = 0; bj < 2; ++bj) { const f32x4 v0 = acc[ai][bj][m][0], v1 = acc[ai][bj][m][1];
                    v4u w; w.x = pg8::cvt_pk_bf16(v0.x, v0.y); w.y = pg8::cvt_pk_bf16(v0.z, v0.w); w.z = pg8::cvt_pk_bf16(v1.x, v1.y); w.w = pg8::cvt_pk_bf16(v1.z, v1.w);
                    *(v4u*)(rowp + bj * 128) = w; } }
    }
};
struct EpiGateUp {
    static constexpr bool PERM = true;
    bf16* HID; const float* listw;
    __device__ __forceinline__ void operator()(const pg8::f32x4 (&acc)[2][2][4][2], const pg8::Unit& u, int wr, int wc, int fr, int fq) const {
        const int col0 = u.pn * 128 + wc * 32 + 8 * fq;
#pragma unroll
        for (int ai = 0; ai < 2; ++ai)
#pragma unroll
            for (int m = 0; m < 4; ++m) { const int rt = ai * 128 + wr * 64 + m * 16 + fr, pos = u.j * 256 + rt;
                const float w = (pos < u.cnt) ? listw[(size_t)u.e * T_ + pos] : 0.f;
                f32x4 h[2];
#pragma unroll
                for (int n = 0; n < 2; ++n) { const f32x4 g = acc[ai][0][m][n], up = acc[ai][1][m][n];
                    h[n].x = g.x * fast_sigmoid(g.x) * up.x * w; h[n].y = g.y * fast_sigmoid(g.y) * up.y * w; h[n].z = g.z * fast_sigmoid(g.z) * up.z * w; h[n].w = g.w * fast_sigmoid(g.w) * up.w * w; }
                v4u o; o.x = pg8::cvt_pk_bf16(h[0].x, h[0].y); o.y = pg8::cvt_pk_bf16(h[0].z, h[0].w); o.z = pg8::cvt_pk_bf16(h[1].x, h[1].y); o.w = pg8::cvt_pk_bf16(h[1].z, h[1].w);
                *(v4u*)(HID + (size_t)(u.pm * 256 + rt) * EHID + col0) = o; }
    }
};
struct ProbMoe {
    const char* A; const char* Bt; int K, nN, G, c; unsigned* cnt; const int* list; bool gather; size_t bstride;
    __device__ __forceinline__ bool next(int i, pg8::Unit& u) const {
        const int L = i * G + c, mt = L / nN; int pre = 0; bool found = false;
#pragma unroll
        for (int e = 0; e < NEXP; ++e) { const int ce = (int)__builtin_amdgcn_readfirstlane(__hip_atomic_load(cnt + CNT_STRIDE * e, __ATOMIC_RELAXED, __HIP_MEMORY_SCOPE_AGENT)); const int tl = (ce + 255) >> 8;
            if (mt >= pre && mt < pre + tl) { u.e = e; u.j = mt - pre; u.cnt = ce; found = true; } pre += tl; }
        u.pm = mt; u.pn = L % nN; return found;
    }
    __device__ __forceinline__ unsigned a_off(const pg8::Unit& u, int row) const {
        if (gather) { int pos = u.j * 256 + row; pos = pos < u.cnt ? pos : u.cnt - 1; const int tok = list[(size_t)u.e * T_ + pos]; return (unsigned)tok * (unsigned)(K * 2); }
        return (unsigned)(u.pm * 256 + row) * (unsigned)(K * 2);
    }
    __device__ __forceinline__ const char* b_base(const pg8::Unit& u) const { return Bt + (size_t)u.e * bstride + (size_t)u.pn * 256 * K * 2; }
};

__device__ __forceinline__ void gmlp_unit(int idx, const bf16* U, const bf16* V, const bf16* WST, const float* b_s, bf16* MIX, LAS unsigned char* lds) {
    int tid_ = threadIdx.x; asm volatile("" : "+v"(tid_)); const int tid = tid_, lane = tid & 63, wave = __builtin_amdgcn_readfirstlane(tid >> 6), fr = lane & 15, fq = lane >> 4;
    const int c = idx >> 2, g = idx & 3, tok0 = c * 128;
    LAS bf16* Vt = (LAS bf16*)lds;
#pragma unroll
    for (int i = 0; i < 2; ++i) { const int p = tid + NTHR * i, s = p >> 3, dc = p & 7;
        const v4u q = *(const GAS v4u*)(V + (size_t)(tok0 + s) * 256 + g * 64 + dc * 8);
        const unsigned w[4] = {q.x, q.y, q.z, q.w};
#pragma unroll
        for (int e = 0; e < 4; ++e) { Vt[(dc * 8 + 2 * e) * 136 + s] = (bf16)(w[e] & 0xffffu); Vt[(dc * 8 + 2 * e + 1) * 136 + s] = (bf16)(w[e] >> 16); } }
    __syncthreads();
    const int t0 = 16 * wave;
    pg8::f32x4 acc[4];
#pragma unroll
    for (int n = 0; n < 4; ++n) acc[n] = (pg8::f32x4){0.f, 0.f, 0.f, 0.f};
#pragma unroll
    for (int ks = 0; ks < 4; ++ks) {
        const bf16x8 wfrag = *(const GAS bf16x8*)(WST + (size_t)(g * 128 + t0 + fr) * 128 + 32 * ks + 8 * fq);
#pragma unroll
        for (int n = 0; n < 4; ++n) { const bf16x8 vfrag = *(const LAS bf16x8*)(Vt + (16 * n + fr) * 136 + 32 * ks + 8 * fq);
            acc[n] = __builtin_amdgcn_mfma_f32_16x16x32_bf16(vfrag, wfrag, acc[n], 0, 0, 0); }
    }
    const int t = t0 + fr; const float bs = b_s[g * 128 + t];
#pragma unroll
    for (int n = 0; n < 4; ++n) { const size_t ucol = (size_t)(tok0 + t) * 256 + g * 64 + 16 * n + 4 * fq;
        const unsigned long long uu = *(const GAS unsigned long long*)(U + ucol);
        const float u0 = bf2f((unsigned short)(uu & 0xffff)), u1 = bf2f((unsigned short)((uu >> 16) & 0xffff)), u2 = bf2f((unsigned short)((uu >> 32) & 0xffff)), u3 = bf2f((unsigned short)(uu >> 48));
        const unsigned lo = pk2(u0 * (acc[n].x + bs), u1 * (acc[n].y + bs)), hi = pk2(u2 * (acc[n].z + bs), u3 * (acc[n].w + bs));
        *(GAS unsigned long long*)(MIX + (size_t)(tok0 + t) * 1024 + g * 64 + 16 * n + 4 * fq) = (unsigned long long)lo | ((unsigned long long)hi << 32); }
    __syncthreads();
}

#if MK_NAIVE_ATTN
__device__ __forceinline__ void naive_attn(const bf16* Q, const bf16* K, const bf16* V, const float* F2, bf16* MIXo, int gt, int NGT) {
    for (int r = gt; r < NBH * SEQ_; r += NGT) { const int bh = r / SEQ_, t = r % SEQ_, b = bh / NHEADS, h = bh % NHEADS; const size_t row = (size_t)b * SEQ_ + t;
        float q[64], o[64];
#pragma unroll
        for (int d = 0; d < 64; ++d) { q[d] = bf2f(Q[row * 768 + h * 64 + d]); o[d] = 0.f; }
        float m = -INFINITY, l = 0.f; const float ft = F2[(size_t)bh * SEQ_ + t];
        for (int s = 0; s <= t; ++s) { const size_t rs = (size_t)b * SEQ_ + s; float sc = 0.f;
#pragma unroll
            for (int d = 0; d < 64; ++d) sc += q[d] * bf2f(K[rs * 768 + h * 64 + d]);
            sc += ft - F2[(size_t)bh * SEQ_ + s];
            const float mn = fmaxf(m, sc), al = exp2f(m - mn), p = exp2f(sc - mn); l = l * al + p; m = mn;
#pragma unroll
            for (int d = 0; d < 64; ++d) o[d] = o[d] * al + p * bf2f(V[rs * 768 + h * 64 + d]); }
        const float il = 1.f / l;
#pragma unroll
        for (int d = 0; d < 64; ++d) MIXo[row * 1024 + 256 + h * 64 + d] = (bf16)f2bf(o[d] * il); }
}
#endif

template <class IN_T> __device__ __forceinline__ void phase_route(const IN_T in, int layer, const float* X, unsigned char* ws, unsigned* cnt, LAS unsigned char* lds, int G, int vcu) {
    int tid_ = threadIdx.x; asm volatile("" : "+v"(tid_)); const int tid = tid_, lane = tid & 63, wave = __builtin_amdgcn_readfirstlane(tid >> 6);
    const int gw = vcu * NWAVES + wave, NGW = G * NWAVES;
    LAS float* wt = (LAS float*)lds;
    const float* wg = in[17] + (size_t)layer * 1024 * 4; const float* wrt = in[19] + (size_t)layer * 1024 * 16; const float* gn = in[16] + (size_t)layer * 1024;
    for (int i = tid; i < 1024 * 20; i += NTHR) { const int k = i / 20, j = i % 20; wt[i] = (j < 4 ? wg[k * 4 + j] : wrt[k * 16 + (j - 4)]) * gn[k]; }
    LAS unsigned* lcnt = (LAS unsigned*)(lds + 81920); LAS unsigned* lbase = lcnt + 16; LAS unsigned* info = (LAS unsigned*)(lds + 82048);
    if (tid < 16) lcnt[tid] = 0u;
    __syncthreads();
    const float* bg = in[18] + layer * 4; const float* br = in[20] + layer * 16;
    int ri = 0;
    int* list = (int*)(ws + WS_LIST); float* listw = (float*)(ws + WS_LISTW); int* toke = (int*)(ws + WS_TOKE); int* tokp = (int*)(ws + WS_TOKP);
    for (int m = gw; m < T_; m += NGW) {
        const GAS f32x4* xr = (const GAS f32x4*)(X + (size_t)m * DM_) + lane;
        float ss = 0.f; float a[20];
#pragma unroll
        for (int c = 0; c < 20; ++c) a[c] = 0.f;
#pragma unroll 1
        for (int j = 0; j < 4; ++j) { const f32x4 vj = xr[64 * j]; ss += (vj.x * vj.x + vj.y * vj.y) + (vj.z * vj.z + vj.w * vj.w);
#pragma unroll
            for (int e = 0; e < 4; ++e) { const float xv = vj[e]; const LAS f32x4* w4 = (const LAS f32x4*)(wt + (256 * j + 4 * lane + e) * 20);
#pragma unroll
                for (int q = 0; q < 5; ++q) { const f32x4 w = w4[q]; a[4 * q] += xv * w.x; a[4 * q + 1] += xv * w.y; a[4 * q + 2] += xv * w.z; a[4 * q + 3] += xv * w.w; } } }
        const float rstd = __builtin_amdgcn_rsqf(wave_sum(ss) * (1.f / DM_) + EPS_);
#pragma unroll
        for (int c = 0; c < 20; ++c) a[c] = wave_sum(a[c]) * rstd;
        GAS unsigned long long* o8 = (GAS unsigned long long*)(ws + WS_XN + (size_t)m * DM_ * 2) + lane;
#pragma unroll 1
        for (int j = 0; j < 4; ++j) { const f32x4 vj = xr[64 * j]; const f32x4 g4 = *((const GAS f32x4*)gn + 64 * j + lane);
            o8[64 * j] = (unsigned long long)pk2(vj.x * rstd * g4.x, vj.y * rstd * g4.y) | ((unsigned long long)pk2(vj.z * rstd * g4.z, vj.w * rstd * g4.w) << 32); }
        float lg[4]; int gi = 0; float gmax;
#pragma unroll
        for (int j = 0; j < 4; ++j) lg[j] = a[j] + bg[j];
        gmax = lg[0];
#pragma unroll
        for (int j = 1; j < 4; ++j) if (lg[j] > gmax) { gmax = lg[j]; gi = j; }
        float gsum = 0.f;
#pragma unroll
        for (int j = 0; j < 4; ++j) gsum += __expf(lg[j] - gmax);
        const float gtop = 1.f / gsum;
        float le[4];
#pragma unroll
        for (int e = 0; e < 4; ++e) { float s = 0.f;
#pragma unroll
            for (int j = 0; j < 4; ++j) s = (gi == j) ? (a[4 + 4 * j + e] + br[4 * j + e]) : s;
            le[e] = s; }
        int i1 = 0; float m1 = le[0];
#pragma unroll
        for (int e = 1; e < 4; ++e) if (le[e] > m1) { m1 = le[e]; i1 = e; }
        int i2 = -1; float m2 = -INFINITY;
#pragma unroll
        for (int e = 0; e < 4; ++e) if (e != i1 && le[e] > m2) { m2 = le[e]; i2 = e; }
        const float p2 = __expf(m2 - m1), w1 = gtop / (1.f + p2), w2 = gtop * p2 / (1.f + p2);
        if (lane == 0) {
            const int e1 = gi * 4 + i1, e2 = gi * 4 + i2;
            const unsigned r1 = __hip_atomic_fetch_add(lcnt + e1, 1u, __ATOMIC_RELAXED, __HIP_MEMORY_SCOPE_WORKGROUP), r2 = __hip_atomic_fetch_add(lcnt + e2, 1u, __ATOMIC_RELAXED, __HIP_MEMORY_SCOPE_WORKGROUP);
            LAS unsigned* rec = info + (wave * 64 + ri) * 8;
            rec[0] = (unsigned)m; rec[1] = (unsigned)e1; rec[2] = (unsigned)e2; rec[3] = __builtin_bit_cast(unsigned, w1); rec[4] = __builtin_bit_cast(unsigned, w2); rec[5] = r1; rec[6] = r2;
        }
        ++ri;
    }
    __syncthreads();
    if (tid < 16) lbase[tid] = __hip_atomic_fetch_add(cnt + CNT_STRIDE * tid, lcnt[tid], __ATOMIC_RELAXED, __HIP_MEMORY_SCOPE_AGENT);
    __syncthreads();
    if (lane < ri) {
        const LAS unsigned* rec = info + (wave * 64 + lane) * 8;
        const int m = (int)rec[0], e1 = (int)rec[1], e2 = (int)rec[2]; const float w1 = __builtin_bit_cast(float, rec[3]), w2 = __builtin_bit_cast(float, rec[4]);
        const int p1 = (int)(lbase[e1] + rec[5]), q2 = (int)(lbase[e2] + rec[6]);
        list[(size_t)e1 * T_ + p1] = m; listw[(size_t)e1 * T_ + p1] = w1; list[(size_t)e2 * T_ + q2] = m; listw[(size_t)e2 * T_ + q2] = w2;
        toke[2 * m] = e1; toke[2 * m + 1] = e2; tokp[2 * m] = p1; tokp[2 * m + 1] = q2;
    }
}

template <bool NORM>
__device__ __forceinline__ void phase_combine(float* X, const float* gn, unsigned char* ws, unsigned* cnt, int G, int vcu) {
    int tid_ = threadIdx.x; asm volatile("" : "+v"(tid_)); const int tid = tid_, lane = tid & 63, wave = __builtin_amdgcn_readfirstlane(tid >> 6);
    const int gw = vcu * NWAVES + wave, NGW = G * NWAVES;
    int sb[NEXP]; { int pre = 0;
#pragma unroll
        for (int e = 0; e < NEXP; ++e) { sb[e] = pre * 256; pre += ((int)__builtin_amdgcn_readfirstlane(__hip_atomic_load(cnt + CNT_STRIDE * e, __ATOMIC_RELAXED, __HIP_MEMORY_SCOPE_AGENT)) + 255) >> 8; } }
    const int* toke = (const int*)(ws + WS_TOKE); const int* tokp = (const int*)(ws + WS_TOKP); const bf16* Y = (const bf16*)(ws + WS_Y);
    for (int m = gw; m < T_; m += NGW) {
        const int e1 = toke[2 * m], e2 = toke[2 * m + 1], p1 = tokp[2 * m], p2 = tokp[2 * m + 1]; int s1 = 0, s2 = 0;
#pragma unroll
        for (int e = 0; e < NEXP; ++e) { s1 = (e == e1) ? sb[e] + p1 : s1; s2 = (e == e2) ? sb[e] + p2 : s2; }
        GAS f32x4* xr = (GAS f32x4*)(X + (size_t)m * DM_) + lane;
        const GAS unsigned long long* y1 = (const GAS unsigned long long*)(Y + (size_t)s1 * 1024) + lane; const GAS unsigned long long* y2 = (const GAS unsigned long long*)(Y + (size_t)s2 * 1024) + lane;
        f32x4 v[4]; float ss = 0.f;
#pragma unroll
        for (int j = 0; j < 4; ++j) { v[j] = xr[64 * j]; const unsigned long long a = y1[64 * j], b = y2[64 * j];
            v[j].x += bf2f((unsigned short)(a & 0xffff)) + bf2f((unsigned short)(b & 0xffff)); v[j].y += bf2f((unsigned short)((a >> 16) & 0xffff)) + bf2f((unsigned short)((b >> 16) & 0xffff));
            v[j].z += bf2f((unsigned short)((a >> 32) & 0xffff)) + bf2f((unsigned short)((b >> 32) & 0xffff)); v[j].w += bf2f((unsigned short)(a >> 48)) + bf2f((unsigned short)(b >> 48));
            xr[64 * j] = v[j]; ss += (v[j].x * v[j].x + v[j].y * v[j].y) + (v[j].z * v[j].z + v[j].w * v[j].w); }
        if (NORM) {
            const float rstd = __builtin_amdgcn_rsqf(wave_sum(ss) * (1.f / DM_) + EPS_);
            GAS unsigned long long* o8 = (GAS unsigned long long*)(ws + WS_XN + (size_t)m * DM_ * 2) + lane;
#pragma unroll
            for (int j = 0; j < 4; ++j) { const f32x4 g4 = *((const GAS f32x4*)gn + 64 * j + lane);
                o8[64 * j] = (unsigned long long)pk2(v[j].x * rstd * g4.x, v[j].y * rstd * g4.y) | ((unsigned long long)pk2(v[j].z * rstd * g4.z, v[j].w * rstd * g4.w) << 32); }
        }
    }
}

__device__ __forceinline__ void unpack8(const v4u q, float (&f)[8]) { f[0] = bf2f((unsigned short)(q.x & 0xffff)); f[1] = bf2f((unsigned short)(q.x >> 16)); f[2] = bf2f((unsigned short)(q.y & 0xffff)); f[3] = bf2f((unsigned short)(q.y >> 16));
    f[4] = bf2f((unsigned short)(q.z & 0xffff)); f[5] = bf2f((unsigned short)(q.z >> 16)); f[6] = bf2f((unsigned short)(q.w & 0xffff)); f[7] = bf2f((unsigned short)(q.w >> 16)); }
__device__ __forceinline__ void phase_mix1(const bf16* H1, const float* conv_w, bf16* MIX, int G, int vcu) {
    int tid_ = threadIdx.x; asm volatile("" : "+v"(tid_)); const int gt = vcu * NTHR + tid_, NGT = G * NTHR;
    for (int idx = gt; idx < T_ * 128; idx += NGT) {
        const int cgp = idx & 127, m = idx >> 7, t = m & (SEQ_ - 1); const bf16* hr = H1 + (size_t)m * 2048; float o[8];
        if (cgp < 64) { const int ch = cgp * 8; float bgv[8], y[8];
            unpack8(*(const GAS v4u*)(hr + ch), bgv);
#pragma unroll
            for (int e = 0; e < 8; ++e) y[e] = 0.f;
#pragma unroll
            for (int tap = 0; tap < 3; ++tap) { const int dt = 2 - tap;
                if (t >= dt) { float cgv[8], hcv[8]; unpack8(*(const GAS v4u*)(hr - (size_t)dt * 2048 + 512 + ch), cgv); unpack8(*(const GAS v4u*)(hr - (size_t)dt * 2048 + 1024 + ch), hcv);
                    const f32x4 w0 = *(const GAS f32x4*)(conv_w + tap * 512 + ch), w1 = *(const GAS f32x4*)(conv_w + tap * 512 + ch + 4);
                    const float w[8] = {w0.x, w0.y, w0.z, w0.w, w1.x, w1.y, w1.z, w1.w};
#pragma unroll
                    for (int e = 0; e < 8; ++e) y[e] += w[e] * (cgv[e] * hcv[e]); } }
#pragma unroll
            for (int e = 0; e < 8; ++e) o[e] = bgv[e] * y[e];
            v4u w; w.x = pk2(o[0], o[1]); w.y = pk2(o[2], o[3]); w.z = pk2(o[4], o[5]); w.w = pk2(o[6], o[7]);
            *(GAS v4u*)(MIX + (size_t)m * 1024 + ch) = w;
        } else { const int pc = (cgp - 64) * 8, gi = pc >> 7, win = 2 << gi, n = (t + 1 < win) ? t + 1 : win; float s[8], p0[8];
            unpack8(*(const GAS v4u*)(hr + 1536 + pc), p0);
#pragma unroll
            for (int e = 0; e < 8; ++e) s[e] = p0[e];
            for (int d = 1; d < n; ++d) { float pv[8]; unpack8(*(const GAS v4u*)(hr - (size_t)d * 2048 + 1536 + pc), pv);
#pragma unroll
                for (int e = 0; e < 8; ++e) s[e] += pv[e]; }
            const float inv = 1.f / (float)n;
#pragma unroll
            for (int e = 0; e < 8; ++e) o[e] = s[e] * inv - p0[e];
            v4u w; w.x = pk2(o[0], o[1]); w.y = pk2(o[2], o[3]); w.z = pk2(o[4], o[5]); w.w = pk2(o[6], o[7]);
            *(GAS v4u*)(MIX + (size_t)m * 1024 + 512 + pc) = w; }
    }
}
struct Args { const float* in[24]; float* out; unsigned char* ws; int ph_lo, ph_hi, rep, pad; };
__global__ void __launch_bounds__(NTHR, 2) hybrid_fwd(Args args) {
    extern __shared__ __attribute__((aligned(16))) unsigned char lds_raw[];
    LAS unsigned char* lds = (LAS unsigned char*)lds_raw;
    volatile LAS unsigned* MISC = (volatile LAS unsigned*)(lds + MISC_OFF);
    const int tid = threadIdx.x;
    const int G = gridDim.x; const int bx = blockIdx.x; const int vcu = (G % 8 == 0) ? (bx % 8) * (G / 8) + bx / 8 : bx;
    struct KIn { __device__ __forceinline__ const float* operator[](int k) const { const volatile __attribute__((address_space(4))) unsigned long long* ka = (const volatile __attribute__((address_space(4))) unsigned long long*)__builtin_amdgcn_kernarg_segment_ptr(); return (const float*)(const GAS float*)ka[k]; } };
    const KIn in;
#define out ((float*)in[24])
#define ws ((unsigned char*)in[25])
#define XN ((bf16*)(ws + WS_XN))
#define MIX ((bf16*)(ws + WS_MIX))
#define HID ((bf16*)(ws + WS_HID))
#define Y ((bf16*)(ws + WS_Y))
#define F2 ((float*)(ws + WS_F2))
#define ctl ((gu32*)(ws + WS_CTL))
    for (int u = tid; u < (LDS_BYTES - LDSCTL_OFF) / 4; u += NTHR) ((LAS unsigned*)(lds + LDSCTL_OFF))[u] = 0u;
    __syncthreads();
#if MK_USE_CG
    cooperative_groups::grid_group grid = cooperative_groups::this_grid();
#define GRID_BAR() grid.sync()
#else
    XcdBarrier bar; bar.bar = (unsigned*)(ctl + CW_BAR); bar.x = 0; bar.st = nullptr;
    if (MK_N_LAUNCHES == 1) bar = xcd_barrier_post((unsigned*)(ctl + CW_BAR), MISC + 8);
#define GRID_BAR() xcd_barrier(bar)
#endif
    const int lo = args.ph_lo, hi = args.ph_hi;
#ifndef PH_MASK
#define PH_MASK 0x7fff
#endif
#define IN(k) (((PH_MASK >> (k)) & 1) && lo <= (k) && (k) < hi)
#define SEAM(k) do { if (IN(k) && IN((k) + 1)) GRID_BAR(); } while (0)

    if (IN(0)) { p0_prologue(in, ws, lds, G, vcu); }
    SEAM(0);
    if (IN(1)) {
        if (bx >= G - NBH && G > NBH && args.rep == 0) { scan_seq(F2 + (size_t)(bx - (G - NBH)) * SEQ_, (LAS float*)(lds + MISC_OFF + 64)); }
        pg8::ProbPlain S; S.init(XN, ws + WS_WIN0, T_, EV_N, 1024, G, bx);
        EpiInproj0 E{(bf16*)(ws + WS_U), (bf16*)(ws + WS_V), (bf16*)(ws + WS_Q), (bf16*)(ws + WS_K), (bf16*)(ws + WS_VAL), in[6], in[7], in[8]};
        pg8::gemm_phase<EpiInproj0, pg8::ProbPlain, true>(lds, S, E);
    }
    SEAM(1);
    if (IN(2)) {
#if MK_NAIVE_ATTN
        naive_attn((const bf16*)(ws + WS_Q), (const bf16*)(ws + WS_K), (const bf16*)(ws + WS_VAL), F2, MIX, vcu * NTHR + tid, G * NTHR);
        for (int u = bx; u < 512; u += G) gmlp_unit(u, (const bf16*)(ws + WS_U), (const bf16*)(ws + WS_V), (const bf16*)(ws + WS_WST), in[5], MIX, lds);
#else
        for (;;) {
            if (tid == 0) MISC[0] = __hip_atomic_fetch_add((unsigned*)(ctl + CW_Q + 16 * args.rep), 1u, __ATOMIC_RELAXED, __HIP_MEMORY_SCOPE_AGENT);
            __syncthreads();
            const int u = (int)MISC[0];
            __syncthreads();
            if (u >= 768 + 512) break;
            if (u < 768) { const int qb = 15 - u / NBH, bh = u % NBH;
                attn_body::attn_unit<8>(bh / NHEADS, bh % NHEADS, qb, (const attn_body::bf16*)(ws + WS_Q), (const attn_body::bf16*)(ws + WS_K), (const attn_body::bf16*)(ws + WS_VAL),
                                        (attn_body::bf16*)(ws + WS_MIX) + 256, F2 + (size_t)bh * SEQ_, (char*)lds_raw); }
            else gmlp_unit(u - 768, (const bf16*)(ws + WS_U), (const bf16*)(ws + WS_V), (const bf16*)(ws + WS_WST), in[5], MIX, lds);
        }
#endif
    }
    SEAM(2);
    if (IN(3)) {
        pg8::ProbPlain S; S.init(MIX, ws + WS_WOUT0, T_, 1024, 1024, G, bx);
        EpiResF32 E{in[0], out};
        pg8::gemm_phase<EpiResF32, pg8::ProbPlain, false>(lds, S, E);
    }
    SEAM(3);
#define MOE_LAYER(layer, pb, cntw) do { \
        unsigned* cnt = (unsigned*)(ctl + (cntw)); \
          \
        if (IN(pb)) phase_route(in, layer, out, ws, cnt, lds, G, vcu); \
        SEAM(pb); \
          \
        if (IN((pb) + 1)) { \
            ProbMoe S{(const char*)XN, (const char*)(ws + WS_WGU) + (size_t)(layer) * NEXP * 512 * 1024 * 2, 1024, 2, G, bx, cnt, (const int*)(ws + WS_LIST), true, (size_t)512 * 1024 * 2}; \
            EpiGateUp E{HID, (const float*)(ws + WS_LISTW)}; \
            pg8::gemm_phase<EpiGateUp, ProbMoe, true>(lds, S, E); } \
        SEAM((pb) + 1); \
          \
        if (IN((pb) + 2)) { \
            ProbMoe S{(const char*)HID, (const char*)(ws + WS_WD) + (size_t)(layer) * NEXP * 1024 * 256 * 2, 256, 4, G, bx, cnt, nullptr, false, (size_t)1024 * 256 * 2}; \
            EpiBf16 E{Y, 1024}; \
            pg8::gemm_phase<EpiBf16, ProbMoe, true>(lds, S, E); } \
        SEAM((pb) + 2); \
          \
        if (IN((pb) + 3)) { if ((layer) == 0) phase_combine<true>(out, in[10], ws, cnt, G, vcu); else phase_combine<false>(out, nullptr, ws, cnt, G, vcu); } \
    } while (0)
    MOE_LAYER(0, 4, CW_CNT0);
    SEAM(7);
    if (IN(8)) {
        pg8::ProbPlain S; S.init(XN, ws + WS_WIN1, T_, 2048, 1024, G, bx);
        EpiBf16 E{(bf16*)(ws + WS_H1), 2048};
        pg8::gemm_phase<EpiBf16, pg8::ProbPlain, true>(lds, S, E);
    }
    SEAM(8);
    if (IN(9)) phase_mix1((const bf16*)(ws + WS_H1), in[12], MIX, G, vcu);
    SEAM(9);
    if (IN(10)) {
        pg8::ProbPlain S; S.init(MIX, ws + WS_WOUT1, T_, 1024, 1024, G, bx);
        EpiResF32 E{out, out};
        pg8::gemm_phase<EpiResF32, pg8::ProbPlain, false>(lds, S, E);
    }
    SEAM(10);
    MOE_LAYER(1, 11, CW_CNT1);
#undef MOE_LAYER
#undef XN
#undef MIX
#undef HID
#undef Y
#undef F2
#undef ctl
#undef out
#undef ws
#undef IN
#undef SEAM
#undef GRID_BAR
}

extern "C" void kernel_launch(void* const* d_in, const int* in_sizes, int n_in, void* d_out, int out_size, void* d_ws, size_t ws_size, hipStream_t stream) {
    static int grid = 0;
    if (grid == 0) {
        if (n_in != 24 || in_sizes[0] != T_ * DM_ || out_size != T_ * DM_ || ws_size < WS_END) { fprintf(stderr, "kernel_launch: unexpected shapes (n_in %d, in0 %d, out %d, ws %zu); nothing launched\n", n_in, n_in > 0 ? in_sizes[0] : -1, out_size, ws_size); grid = -1; return; }
        int dev = 0, cus = 0, per_cu = 0;
        if (hipGetDevice(&dev) != hipSuccess || hipDeviceGetAttribute(&cus, hipDeviceAttributeMultiprocessorCount, dev) != hipSuccess) { fprintf(stderr, "kernel_launch: device query failed\n"); grid = -1; return; }
        if (hipFuncSetAttribute((const void*)hybrid_fwd, hipFuncAttributeMaxDynamicSharedMemorySize, LDS_BYTES) != hipSuccess) { fprintf(stderr, "kernel_launch: hipFuncSetAttribute failed\n"); grid = -1; return; }
        if (hipOccupancyMaxActiveBlocksPerMultiprocessor(&per_cu, (const void*)hybrid_fwd, NTHR, LDS_BYTES) != hipSuccess || per_cu < 1) { fprintf(stderr, "kernel_launch: occupancy query reports %d workgroups per CU\n", per_cu); per_cu = 1; }
        (void)hipGetLastError();
        grid = cus;
    }
    if (grid < 0) return;
    if (hipMemsetAsync((char*)d_ws + WS_CTL, 0, CTL_ZERO_BYTES, stream) != hipSuccess) { fprintf(stderr, "kernel_launch: memset failed\n"); return; }
    Args a{};
    for (int i = 0; i < 24; ++i) a.in[i] = (const float*)d_in[i];
    a.out = (float*)d_out; a.ws = (unsigned char*)d_ws;
#if MK_N_LAUNCHES == 1
    a.ph_lo = 0; a.ph_hi = NPH;
#if MK_USE_CG
    void* kargs[] = {&a};
    hipError_t e = hipLaunchCooperativeKernel((const void*)hybrid_fwd, dim3(grid), dim3(NTHR), kargs, LDS_BYTES, stream);
    if (e != hipSuccess) fprintf(stderr, "kernel_launch: cooperative launch failed: %s (grid %d)\n", hipGetErrorString(e), grid);
#else
    hipLaunchKernelGGL(hybrid_fwd, dim3(grid), dim3(NTHR), LDS_BYTES, stream, a);
#endif
#else
    for (int p = 0; p < NPH; ++p) { a.ph_lo = p; a.ph_hi = p + 1; a.rep = 0; hipLaunchKernelGGL(hybrid_fwd, dim3(grid), dim3(NTHR), LDS_BYTES, stream, a);
        if ((MK_REPEAT_MASK >> p) & 1) { a.rep = 1; hipLaunchKernelGGL(hybrid_fwd, dim3(grid), dim3(NTHR), LDS_BYTES, stream, a); } }
#endif
}
```

```cpp
#include <hip/hip_runtime.h>
#include <hip/hip_cooperative_groups.h>
#include <hip/hip_bf16.h>
#include <cstdio>
#include <cstdint>
#include <cmath>

#ifndef MK_N_LAUNCHES
#define MK_N_LAUNCHES 1
#endif
#ifndef MK_USE_CG
#define MK_USE_CG 0
#endif
#ifndef MK_NAIVE_ATTN
#define MK_NAIVE_ATTN 0
#endif
#ifndef MK_REPEAT_MASK
#define MK_REPEAT_MASK 0
#endif
#ifndef MK_REP_MODE
#define MK_REP_MODE 1
#endif
namespace pg8 {
#define PG8_LAS __attribute__((address_space(3)))
typedef unsigned short bf16_t;
typedef short bf16x8 __attribute__((ext_vector_type(8)));
typedef float f32x4 __attribute__((ext_vector_type(4)));
typedef unsigned u32x4 __attribute__((ext_vector_type(4)));
constexpr int BM = 256, BK = 64, HALF = 128, HTB = HALF * BK * 2  , STAGE_BYTES = 8 * HTB, NXCD = 8, WGM = 8;

__host__ __device__ __forceinline__ int lds_byte(int r, int c) { const int st = (r >> 4) * 2 + (c >> 5), rr = r & 15, cc = c & 31, ob = rr * 64 + cc * 2; return st * 1024 + (ob ^ (((ob >> 9) & 1) << 5)); }
__host__ __device__ __forceinline__ void stage_rc(int b, int& R, int& C) { const int st = b / 1024, sb = b % 1024, swz = sb ^ (((sb >> 9) & 1) << 5); R = (st >> 1) * 16 + swz / 64; C = (st & 1) * 32 + (swz % 64) / 2; }
__host__ __device__ __forceinline__ int perm32(int rho) { const int n = rho >> 4, i = rho & 15; return 8 * (i >> 2) + 4 * n + (i & 3); }

struct Unit { int pm, pn, e, j, cnt; };

__device__ __forceinline__ unsigned cvt_pk_bf16(float lo, float hi) { unsigned r; asm volatile("v_cvt_pk_bf16_f32 %0, %1, %2" : "=v"(r) : "v"(lo), "v"(hi)); return r; }

struct ProbPlain {
    const char* A; const char* Bt; int K, nM, nN, nwg, G, c;
    __device__ __forceinline__ void init(const void* A_, const void* Bt_, int M, int N, int K_, int G_, int c_) { A = (const char*)A_; Bt = (const char*)Bt_; K = K_; nM = M / BM; nN = N / BM; nwg = nM * nN; G = G_; c = c_; }
    __device__ __forceinline__ bool next(int i, Unit& u) const {
        const long L = (long)i * G + c; if (L >= nwg) return false;
        int wgid = (int)L; { const int q = nwg / NXCD, r = nwg % NXCD, xcd = wgid % NXCD, off = wgid / NXCD; wgid = (xcd < r ? xcd * (q + 1) : r * (q + 1) + (xcd - r) * q) + off; }
        const int nig = WGM * nN, gid = wgid / nig, fm = gid * WGM, gsz = (nM - fm) < WGM ? (nM - fm) : WGM;
        u.pm = fm + ((wgid % nig) % gsz); u.pn = (wgid % nig) / gsz; u.e = 0; u.j = 0; u.cnt = 0; return true;
    }
    __device__ __forceinline__ unsigned a_off(const Unit& u, int row) const { return (unsigned)(u.pm * BM + row) * (unsigned)(K * 2); }
    __device__ __forceinline__ const char* b_base(const Unit& u) const { return Bt + (size_t)u.pn * BM * K * 2; }
};

template <class Epi, class Prob, bool ALIGN_EPI>
__device__ __forceinline__ void gemm_phase(PG8_LAS unsigned char* lds, const Prob& S, const Epi& E) {
    int tid_ = threadIdx.x; asm volatile("" : "+v"(tid_)); const int tid = tid_, wid = __builtin_amdgcn_readfirstlane(tid >> 6), lane = tid & 63, wr = wid >> 2, wc = wid & 3, fr = lane & 15, fq = lane >> 4;
    const int K = S.K, nt = K / BK;
    int Rr[2], Cb[2]; unsigned voffB[2];
#pragma unroll
    for (int i = 0; i < 2; ++i) { int R, C; stage_rc(tid * 16 + i * 8192, R, C); const int Rb = Epi::PERM ? ((R & ~31) + perm32(R & 31)) : R;
        Rr[i] = R; Cb[i] = C * 2; voffB[i] = (unsigned)(Rb * K + C) * 2u; }
    const size_t kstep = (size_t)(BK * 2);
    const size_t hstep = (size_t)HALF * K * 2;
    const unsigned ldsw = (unsigned)wid * 1024u;
    const int aoff = lds_byte(wr * 64 + fr, fq * 8), boff = lds_byte(wc * 32 + fr, fq * 8);
#define PG8_SA(b, h) (((b) * 2 + (h)) * HTB)
#define PG8_SB(b, h) ((4 + (b) * 2 + (h)) * HTB)
#define PG8_STAGE(bufoff, gbase, voff) do { _Pragma("unroll") for (int _i = 0; _i < 2; ++_i) \
        __builtin_amdgcn_global_load_lds((const unsigned*)((const char*)(gbase) + (voff)[_i]), (PG8_LAS unsigned*)(lds + (bufoff) + ldsw + _i * 8192), 16, 0, 0); } while (0)
#define PG8_LDA(dst, b, h) do { _Pragma("unroll") for (int m = 0; m < 4; ++m) _Pragma("unroll") for (int k = 0; k < 2; ++k) dst[m][k] = *(const PG8_LAS bf16x8*)(lds + PG8_SA(b, h) + aoff + m * 2048 + k * 1024); } while (0)
#define PG8_LDB(dst, b, h) do { _Pragma("unroll") for (int n = 0; n < 2; ++n) _Pragma("unroll") for (int k = 0; k < 2; ++k) dst[n][k] = *(const PG8_LAS bf16x8*)(lds + PG8_SB(b, h) + boff + n * 2048 + k * 1024); } while (0)
#define PG8_MMA(ai, bj, At, Bt) do { __builtin_amdgcn_s_setprio(1); _Pragma("unroll") for (int m = 0; m < 4; ++m) _Pragma("unroll") for (int n = 0; n < 2; ++n) _Pragma("unroll") for (int k = 0; k < 2; ++k) \
        acc[ai][bj][m][n] = __builtin_amdgcn_mfma_f32_16x16x32_bf16(Bt[n][k], At[m][k], acc[ai][bj][m][n], 0, 0, 0); __builtin_amdgcn_s_setprio(0); } while (0)
#define PG8_WAIT_V(n) asm volatile("s_waitcnt vmcnt(" #n ")" ::: "memory")
#define PG8_WAIT_L(n) asm volatile("s_waitcnt lgkmcnt(" #n ")" ::: "memory")
#define PG8_BAR __builtin_amdgcn_s_barrier()
#define PG8_SCHED __builtin_amdgcn_sched_barrier(0)
    Unit cur, nxt; int ui = 0;
    if (!S.next(0, cur)) return;
    f32x4 acc[2][2][4][2];
#pragma unroll
    for (int a = 0; a < 2; ++a)
#pragma unroll
        for (int b = 0; b < 2; ++b)
#pragma unroll
            for (int m = 0; m < 4; ++m)
#pragma unroll
                for (int n = 0; n < 2; ++n) acc[a][b][m][n] = (f32x4){0.f, 0.f, 0.f, 0.f};
    bf16x8 At[4][2], B0[2][2], B1[2][2];
    const char* const Ab = S.A;
    unsigned cA0[2], cA1[2], nA0[2], nA1[2];
#pragma unroll
    for (int i = 0; i < 2; ++i) { cA0[i] = S.a_off(cur, Rr[i]) + (unsigned)Cb[i]; cA1[i] = S.a_off(cur, Rr[i] + HALF) + (unsigned)Cb[i]; }
    const char* cB = S.b_base(cur);
    PG8_STAGE(PG8_SB(0, 0), cB, voffB); PG8_STAGE(PG8_SB(0, 1), cB + hstep, voffB); PG8_STAGE(PG8_SA(0, 0), Ab, cA0); PG8_STAGE(PG8_SA(0, 1), Ab, cA1);
    if (wr == 1) PG8_BAR;
    PG8_WAIT_V(2); PG8_BAR;
    PG8_STAGE(PG8_SB(1, 0), cB + kstep, voffB); PG8_STAGE(PG8_SA(1, 0), Ab + kstep, cA0); PG8_STAGE(PG8_SB(1, 1), cB + hstep + kstep, voffB);
    PG8_WAIT_V(6); PG8_BAR;
    for (;;) {
        const bool has_next = S.next(ui + 1, nxt);
        const char* nB = cB;
#pragma unroll
        for (int i = 0; i < 2; ++i) { nA0[i] = cA0[i]; nA1[i] = cA1[i]; }
        if (has_next) { nB = S.b_base(nxt);
#pragma unroll
            for (int i = 0; i < 2; ++i) { nA0[i] = S.a_off(nxt, Rr[i]) + (unsigned)Cb[i]; nA1[i] = S.a_off(nxt, Rr[i] + HALF) + (unsigned)Cb[i]; } }
        for (int t = 0; t < nt; t += 2) {
            const bool last = (t == nt - 2);
            const char* a1 = Ab + (size_t)(t + 1) * kstep;
            const char* a2 = last ? Ab : Ab + (size_t)(t + 2) * kstep; const char* b2 = last ? nB : cB + (size_t)(t + 2) * kstep;
            const char* a3 = a2 + kstep; const char* b3 = b2 + kstep;
            unsigned x0[2], x1[2];
#pragma unroll
            for (int i = 0; i < 2; ++i) { x0[i] = last ? nA0[i] : cA0[i]; x1[i] = last ? nA1[i] : cA1[i]; }
            PG8_LDB(B0, 0, 0); PG8_LDB(B1, 0, 1); PG8_SCHED; PG8_LDA(At, 0, 0); PG8_STAGE(PG8_SA(1, 1), a1, cA1);
            PG8_WAIT_V(8); PG8_WAIT_L(0); PG8_BAR; PG8_MMA(0, 0, At, B0); PG8_MMA(0, 1, At, B1); PG8_BAR; PG8_SCHED;
            PG8_LDA(At, 0, 1); PG8_STAGE(PG8_SB(0, 0), b2, voffB); PG8_STAGE(PG8_SB(0, 1), b2 + hstep, voffB); PG8_STAGE(PG8_SA(0, 0), a2, x0);
            PG8_WAIT_V(8); PG8_WAIT_L(0); PG8_BAR; PG8_MMA(1, 0, At, B0); PG8_MMA(1, 1, At, B1); PG8_BAR; PG8_SCHED;
            PG8_LDB(B0, 1, 0); PG8_LDB(B1, 1, 1); PG8_SCHED; PG8_LDA(At, 1, 0); PG8_STAGE(PG8_SA(0, 1), a2, x1);
            PG8_WAIT_V(8); PG8_WAIT_L(0); PG8_BAR; PG8_MMA(0, 0, At, B0); PG8_MMA(0, 1, At, B1); PG8_BAR; PG8_SCHED;
            PG8_LDA(At, 1, 1); PG8_STAGE(PG8_SB(1, 0), b3, voffB); PG8_STAGE(PG8_SB(1, 1), b3 + hstep, voffB); PG8_STAGE(PG8_SA(1, 0), a3, x0);
            PG8_WAIT_V(8); PG8_WAIT_L(0); PG8_BAR; PG8_MMA(1, 0, At, B0); PG8_MMA(1, 1, At, B1); PG8_BAR; PG8_SCHED;
        }
        if constexpr (ALIGN_EPI) { if (wr == 0) PG8_BAR; }
        E(acc, cur, wr, wc, fr, fq);
        if (!has_next) break;
#pragma unroll
        for (int a = 0; a < 2; ++a)
#pragma unroll
            for (int b = 0; b < 2; ++b)
#pragma unroll
                for (int m = 0; m < 4; ++m)
#pragma unroll
                    for (int n = 0; n < 2; ++n) acc[a][b][m][n] = (f32x4){0.f, 0.f, 0.f, 0.f};
        cur = nxt; cB = nB; ++ui;
#pragma unroll
        for (int i = 0; i < 2; ++i) { cA0[i] = nA0[i]; cA1[i] = nA1[i]; }
        if constexpr (ALIGN_EPI) { if (wr == 1) PG8_BAR; }
    }
    PG8_WAIT_V(0);
    if constexpr (!ALIGN_EPI) { if (wr == 0) PG8_BAR; }
    PG8_BAR;
#undef PG8_SA
#undef PG8_SB
#undef PG8_STAGE
#undef PG8_LDA
#undef PG8_LDB
#undef PG8_MMA
#undef PG8_WAIT_V
#undef PG8_WAIT_L
#undef PG8_BAR
#undef PG8_SCHED
}
}
namespace attn_body {
using bf16=__hip_bfloat16;
using bf16x8=__attribute__((ext_vector_type(8)))short;
using s16x4=__attribute__((ext_vector_type(4)))short;
using f32x16=__attribute__((ext_vector_type(16)))float;
using u32x4=__attribute__((ext_vector_type(4)))unsigned;
using f32x4v=__attribute__((ext_vector_type(4)))float;
constexpr int BATCH=4,NHEAD=12,SEQ=4096,D=64;
constexpr int QP=768,KP=768,VP=768,OP=1024;
constexpr int NW=8,QBLK=32,QB=QBLK*NW,KVBLK=64,NQB=SEQ/QB;
constexpr int ATTN_UNIT_ROWS=QB;
__device__ __forceinline__ int crow(int r,int hi){return (r&3)+8*(r>>2)+4*hi;}
#define SBAR() __builtin_amdgcn_sched_barrier(0)
__device__ __forceinline__ void cmask(f32x16&p0,f32x16&p1,int jb,int qrel,int hi){
  const float NEG=-INFINITY; int kb=64*jb+4*hi;
  #pragma unroll
  for(int r=0;r<16;++r){int kv=kb+(r&3)+8*(r>>2); if(kv>qrel)p0[r]=NEG; if(kv+32>qrel)p1[r]=NEG;}
}

constexpr int NSLOT=3, SLOTB=8192;
constexpr int LDS_K=0, LDS_V=NSLOT*SLOTB, LDS_WS=2*NSLOT*SLOTB, LDS_OST=LDS_WS+NW*64*4, LDS_BYTES=LDS_OST+NW*4096, LDS_F=86016, LDS_F_BYTES=16384;
constexpr float C2=0.125f*1.4426950408889634f;
__device__ __forceinline__ void glds16(const void*gsrc,unsigned lds_dst){unsigned keep;
  asm volatile("s_mov_b32 %0, m0\n\ts_mov_b32 m0, %2\n\ts_nop 0\n\tglobal_load_lds_dwordx4 %1, off\n\ts_mov_b32 m0, %0":"=&s"(keep):"v"(gsrc),"s"(lds_dst):"memory");}
__device__ __forceinline__ float max3f(float a,float b,float c){float r;asm("v_max3_f32 %0, %1, %2, %3":"=v"(r):"v"(a),"v"(b),"v"(c));return r;}
__device__ __forceinline__ float max2f(float a,float b){float r;asm("v_max_f32_e32 %0, %1, %2":"=v"(r):"v"(a),"v"(b));return r;}
__device__ __forceinline__ float fadd_s(float a,float b){float r;asm("v_add_f32_e32 %0, %1, %2":"=v"(r):"v"(a),"v"(b));return r;}
__device__ __forceinline__ float fsub_s(float a,float b){float r;asm("v_sub_f32_e32 %0, %1, %2":"=v"(r):"v"(a),"v"(b));return r;}
typedef float f32x2_t __attribute__((ext_vector_type(2))); typedef __bf16 bf16x2_t __attribute__((ext_vector_type(2)));
__device__ __forceinline__ unsigned cvtpk_s(float lo,float hi){f32x2_t v={lo,hi};bf16x2_t b=__builtin_convertvector(v,bf16x2_t);return __builtin_bit_cast(unsigned,b);}
#define WAIT_BAR(N) asm volatile("s_waitcnt vmcnt(" #N ") lgkmcnt(0)\n\ts_barrier":::"memory")

__device__ __forceinline__ void qkt(f32x16&p0,f32x16&p1,const char*Kslot,const bf16x8*qr,int r32,int hi){
  const char*kb=Kslot+hi*1024+r32*16;
  #pragma unroll
  for(int d0=0;d0<4;++d0){
    const bf16x8 b0=*reinterpret_cast<const bf16x8*>(kb+d0*2048);
    const bf16x8 b1=*reinterpret_cast<const bf16x8*>(kb+d0*2048+512);
    p0=__builtin_amdgcn_mfma_f32_32x32x16_bf16(b0,qr[d0],p0,0,0,0);p1=__builtin_amdgcn_mfma_f32_32x32x16_bf16(b1,qr[d0],p1,0,0,0);}
}
typedef __attribute__((address_space(3))) const char* lds_cptr;
typedef short v4i16_t __attribute__((ext_vector_type(4)));
__device__ __forceinline__ void kload8(bf16x8*kf,lds_cptr kp){
  kf[0]=*(const __attribute__((address_space(3))) bf16x8*)(kp);      kf[1]=*(const __attribute__((address_space(3))) bf16x8*)(kp+512);
  kf[2]=*(const __attribute__((address_space(3))) bf16x8*)(kp+2048); kf[3]=*(const __attribute__((address_space(3))) bf16x8*)(kp+2560);
  kf[4]=*(const __attribute__((address_space(3))) bf16x8*)(kp+4096); kf[5]=*(const __attribute__((address_space(3))) bf16x8*)(kp+4608);
  kf[6]=*(const __attribute__((address_space(3))) bf16x8*)(kp+6144); kf[7]=*(const __attribute__((address_space(3))) bf16x8*)(kp+6656);
}
__device__ __forceinline__ void kload2(bf16x8*kf,lds_cptr kp,int j){ kf[2*j]=*(const __attribute__((address_space(3))) bf16x8*)(kp+j*2048); kf[2*j+1]=*(const __attribute__((address_space(3))) bf16x8*)(kp+j*2048+512); }
__device__ __forceinline__ s16x4 vtr(lds_cptr p){ return __builtin_bit_cast(s16x4,__builtin_amdgcn_ds_read_tr16_b64_v4i16((__attribute__((address_space(3))) v4i16_t*)p)); }
__device__ __forceinline__ float rowmax(const f32x16&p0,const f32x16&p1){
  float a=max3f(p0[0],p0[1],p1[0]),b=max3f(p0[2],p0[3],p1[1]);a=max3f(a,p1[2],p1[3]);
  #pragma unroll
  for(int r=4;r<16;r+=4){a=max3f(a,p0[r],p0[r+1]);b=max3f(b,p0[r+2],p0[r+3]);a=max3f(a,p1[r],p1[r+1]);b=max3f(b,p1[r+2],p1[r+3]);}
  const float m=max2f(a,b);
  auto rr=__builtin_amdgcn_permlane32_swap(__float_as_uint(m),__float_as_uint(m),false,false);
  return max2f(__uint_as_float(rr[0]),__uint_as_float(rr[1]));
}
__device__ __forceinline__ void pv(f32x16*o,int vb,bf16x8 pa0,bf16x8 pa1,bf16x8 pa2,bf16x8 pa3){
  #pragma unroll
  for(int d0=0;d0<2;++d0){s16x4 lo[4],hi[4];
    #pragma unroll
    for(int ks=0;ks<4;++ks){
      asm volatile("ds_read_b64_tr_b16 %0,%1 offset:%c2":"=&v"(lo[ks]):"v"(vb),"i"(d0*4096+ks*1024):"memory");
      asm volatile("ds_read_b64_tr_b16 %0,%1 offset:%c2":"=&v"(hi[ks]):"v"(vb),"i"(d0*4096+ks*1024+512):"memory");}
    asm volatile("s_waitcnt lgkmcnt(0)":::"memory");SBAR();
    #define PK(k) (bf16x8){lo[k][0],lo[k][1],lo[k][2],lo[k][3],hi[k][0],hi[k][1],hi[k][2],hi[k][3]}
    o[d0]=__builtin_amdgcn_mfma_f32_32x32x16_bf16(pa0,PK(0),o[d0],0,0,0);
    o[d0]=__builtin_amdgcn_mfma_f32_32x32x16_bf16(pa1,PK(1),o[d0],0,0,0);
    o[d0]=__builtin_amdgcn_mfma_f32_32x32x16_bf16(pa2,PK(2),o[d0],0,0,0);
    o[d0]=__builtin_amdgcn_mfma_f32_32x32x16_bf16(pa3,PK(3),o[d0],0,0,0);
    #undef PK
  }
}

#ifndef ATTN_STORE16
#define ATTN_STORE16(p,v) (*(u32x4*)(p)=(v))
#endif
template<int THRL> __device__ __forceinline__ void attn_unit(int b,int h,int qb,const bf16*Q,const bf16*__restrict__ K,const bf16*__restrict__ V,bf16*O,const float*F2seq,float skipthr,char*shm){
  int tid_ = threadIdx.x; asm volatile("" : "+v"(tid_)); const int tid = tid_,lane=tid&63,r32=lane&31,hi=lane>>5; const int wid=__builtin_amdgcn_readfirstlane(tid>>6);
  const long rowbase=(long)b*SEQ; const int q0=qb*QB;
  int ts=0; { const int nb=q0>>6; bool c_=false; if(lane<nb) c_=(F2seq[q0]-F2seq[64*(lane+1)-1])<-skipthr; ts=__builtin_amdgcn_readfirstlane((int)__popcll(__ballot(c_))&~1); }
  typedef __attribute__((address_space(3))) float* lds_fptr; typedef __attribute__((address_space(3))) f32x4v* lds_f4ptr;
  const lds_fptr Fl=(lds_fptr)(shm+LDS_F);
  { const f32x4v*Fg=(const f32x4v*)(F2seq+64*ts); const int nF=(q0+QB-64*ts)>>2; for(int i=tid;i<nF;i+=NW*64)((lds_f4ptr)Fl)[i]=Fg[i]; }
  const float fq2=F2seq[q0+wid*QBLK+r32];
  const bf16*Qw=Q+(rowbase+q0+wid*QBLK)*QP+h*D;
  const bf16*Kh=K+(rowbase+64*ts)*KP+h*D,*Vh=V+(rowbase+64*ts)*VP+h*D;
  const unsigned lds0=(unsigned)(uintptr_t)shm;
  float*wsf=(float*)(shm+LDS_WS)+wid*64;
  const bf16*ksrc=Kh+(long)lane*KP+wid*8;
  const bf16*vsrc=Vh+(long)(16*(wid&3)+(lane>>2))*VP+(wid>>2)*32+(lane&3)*8;
  const unsigned kdst=lds0+LDS_K+wid*1024, vdst=lds0+LDS_V+wid*1024;
  #define DMA_K(t,slot) glds16(ksrc+(long)(t)*KVBLK*KP,(unsigned)__builtin_amdgcn_readfirstlane(kdst+(slot)))
  #define DMA_V(t,slot) glds16(vsrc+(long)(t)*KVBLK*VP,(unsigned)__builtin_amdgcn_readfirstlane(vdst+(slot)))
  const int vb0=(int)(lds0+LDS_V)+((lane>>4)&1)*32+(lane&3)*8+(4*hi+((lane&15)>>2))*64;
  const char*Kbase=shm+LDS_K; bf16x8 kf[8];
  const lds_cptr shm3=(lds_cptr)shm; const lds_cptr kp0=shm3+LDS_K+hi*1024+r32*16; const lds_cptr vp0=shm3+LDS_V+((lane>>4)&1)*32+(lane&3)*8+(4*hi+((lane&15)>>2))*64;
  const int NT=(q0+QB)/KVBLK-ts;
  DMA_K(0,0);DMA_V(0,0);DMA_K(1,SLOTB);
  bf16x8 qr[4];
  #pragma unroll
  for(int d0=0;d0<4;++d0)qr[d0]=*reinterpret_cast<const bf16x8*>(&Qw[(long)r32*QP+d0*16+hi*8]);
  float mhat=0.f,l_reg=0.f;f32x16 o[2];o[0]=f32x16{};o[1]=f32x16{};
  #define BIAS(C0,C1,t) do{ const float nb_=fq2-mhat; const lds_fptr fk_=Fl+64*(t)+4*hi; \
    _Pragma("unroll") for(int j_=0;j_<4;++j_){ const f32x4v a_=*(const lds_f4ptr)(fk_+8*j_); const f32x4v c_=*(const lds_f4ptr)(fk_+32+8*j_); \
      C0[4*j_]=nb_-a_.x; C0[4*j_+1]=nb_-a_.y; C0[4*j_+2]=nb_-a_.z; C0[4*j_+3]=nb_-a_.w; C1[4*j_]=nb_-c_.x; C1[4*j_+1]=nb_-c_.y; C1[4*j_+2]=nb_-c_.z; C1[4*j_+3]=nb_-c_.w; } }while(0)
  const int qrel=wid*QBLK+r32;
  #define CMASK(P0,P1,t) do{int jb_=(t)-(NT-4); if(jb_>=0)cmask(P0,P1,jb_,qrel,hi);}while(0)
  bool resc=false;
  #define START(P0,P1) do{ const float rm=rowmax(P0,P1); resc=false; \
    { const float dl=rm; mhat=fadd_s(mhat,dl); \
      _Pragma("unroll") for(int r=0;r<16;++r){P0[r]=fsub_s(P0[r],dl);P1[r]=fsub_s(P1[r],dl);} } \
    _Pragma("unroll") for(int r=0;r<16;++r)P0[r]=__builtin_amdgcn_exp2f(P0[r]); }while(0)
  #define RESC() do{ if(resc){ asm volatile("s_waitcnt lgkmcnt(0)":::"memory"); \
      _Pragma("unroll") for(int d_=0;d_<2;++d_) _Pragma("unroll") for(int r=0;r<16;++r)o[d_][r]*=wsf[crow(r,hi)]; } }while(0)
  f32x16 pA0,pA1,pB0,pB1;
  int sl_prev=0,sl_cur=0,sl_next=SLOTB;
  #define ROT() do{sl_prev=sl_cur;sl_cur=sl_next;sl_next=(sl_next==(NSLOT-1)*SLOTB)?0:sl_next+SLOTB;}while(0)
  DMA_K(2,2*SLOTB);
  WAIT_BAR(3);
  BIAS(pA0,pA1,0); qkt(pA0,pA1,Kbase,qr,r32,hi);asm volatile("s_nop 15\n\ts_nop 7":"+v"(pA0),"+v"(pA1));CMASK(pA0,pA1,0);
  START(pA0,pA1);
  _Pragma("unroll") for(int r=0;r<16;++r)pA1[r]=__builtin_amdgcn_exp2f(pA1[r]);
  WAIT_BAR(0);
  DMA_K(3,0);DMA_V(1,SLOTB);
  ROT();
  kload8(kf,kp0+sl_cur);
  WAIT_BAR(2);
  s16x4 vlo[8],vhi[8]; u32x4 pw0,pw1,pw2,pw3;
  #define PKW(P,B) cvtpk_s(P[B],P[B+1])
  #define PAF(k) __builtin_bit_cast(bf16x8,pw##k)
  #define VFR(i) (bf16x8){vlo[i][0],vlo[i][1],vlo[i][2],vlo[i][3],vhi[i][0],vhi[i][1],vhi[i][2],vhi[i][3]}
  #define PIN(x) asm volatile("":"+v"(x))
  #define MX3(a,b,c) __builtin_fmaxf(__builtin_fmaxf((a),(b)),(c))
  #define GAPA(MF,A0,A1,A2,A3,W0,W1,PW) do{ MF; sacc+=A0; sacc+=A1; sacc+=A2; sacc+=A3; PIN(sacc); W0; W1; PIN(PW); SBAR(); }while(0)
  #define EX(v) __builtin_amdgcn_exp2f(v)
  #define GAPB(MF,X,B) do{ MF; X[B]=EX(X[B]); X[B+1]=EX(X[B+1]); X[B+2]=EX(X[B+2]); X[B+3]=EX(X[B+3]); PIN(X); SBAR(); }while(0)
  #define VRD(i) do{ vlo[i]=vtr(vp_+(((i)>>2)*4096+((i)&3)*1024)); vhi[i]=vtr(vp_+(((i)>>2)*4096+((i)&3)*1024+512)); }while(0)
  #define KRD(G,j) do{ if(G){ kload2(kf,kp0+sl_next,j); SBAR(); } }while(0)
  #define STEP(C0,C1,P0,P1,t,GK,GV,GL) do{ BIAS(C0,C1,t); SBAR(); \
    const lds_cptr vp_=vp0+sl_prev; \
    VRD(0); SBAR(); float sacc=(P0[0]+P0[1]); \
    GAPA(C0=__builtin_amdgcn_mfma_f32_32x32x16_bf16(kf[0],qr[0],C0,0,0,0), P0[2],P0[3],P0[4],P0[5],     pw0[0]=PKW(P0,0), pw0[1]=PKW(P0,2), pw0); \
    VRD(4); SBAR(); GAPA(C1=__builtin_amdgcn_mfma_f32_32x32x16_bf16(kf[1],qr[0],C1,0,0,0), P0[6],P0[7],P0[8],P0[9],     pw0[2]=PKW(P0,4), pw0[3]=PKW(P0,6), pw0); \
    VRD(1); SBAR(); GAPA(C0=__builtin_amdgcn_mfma_f32_32x32x16_bf16(kf[2],qr[1],C0,0,0,0),   P0[10],P0[11],P0[12],P0[13], pw1[0]=PKW(P0,8), pw1[1]=PKW(P0,10), pw1); \
    VRD(5); SBAR(); GAPA(C1=__builtin_amdgcn_mfma_f32_32x32x16_bf16(kf[3],qr[1],C1,0,0,0),   P0[14],P0[15],P1[0],P1[1],   pw1[2]=PKW(P0,12),pw1[3]=PKW(P0,14), pw1); \
    VRD(2); SBAR(); GAPA(C0=__builtin_amdgcn_mfma_f32_32x32x16_bf16(kf[4],qr[2],C0,0,0,0),   P1[2],P1[3],P1[4],P1[5],     pw2[0]=PKW(P1,0), pw2[1]=PKW(P1,2), pw2); \
    VRD(6); SBAR(); GAPA(C1=__builtin_amdgcn_mfma_f32_32x32x16_bf16(kf[5],qr[2],C1,0,0,0),   P1[6],P1[7],P1[8],P1[9],     pw2[2]=PKW(P1,4), pw2[3]=PKW(P1,6), pw2); \
    VRD(3); SBAR(); GAPA(C0=__builtin_amdgcn_mfma_f32_32x32x16_bf16(kf[6],qr[3],C0,0,0,0),   P1[10],P1[11],P1[12],P1[13], pw3[0]=PKW(P1,8), pw3[1]=PKW(P1,10), pw3); \
    VRD(7); SBAR(); GAPA(C1=__builtin_amdgcn_mfma_f32_32x32x16_bf16(kf[7],qr[3],C1,0,0,0),   P1[14],P1[15],0.f,0.f,       pw3[2]=PKW(P1,12),pw3[3]=PKW(P1,14), pw3); \
    l_reg+=sacc; \
    if(GK){DMA_K((t)+3,sl_cur);} if(GV){DMA_V((t)+1,sl_next);} \
    CMASK(C0,C1,t); \
    { float a=MX3(C0[0],C0[1],C1[0]),b=MX3(C0[2],C0[3],C1[1]); a=MX3(a,C1[2],C1[3]); \
      _Pragma("unroll") for(int r=4;r<16;r+=4){a=MX3(a,C0[r],C0[r+1]);b=MX3(b,C0[r+2],C0[r+3]);a=MX3(a,C1[r],C1[r+1]);b=MX3(b,C1[r+2],C1[r+3]);} \
      float rm=__builtin_fmaxf(a,b); { auto rr=__builtin_amdgcn_permlane32_swap(__float_as_uint(rm),__float_as_uint(rm),false,false); rm=__builtin_fmaxf(__uint_as_float(rr[0]),__uint_as_float(rr[1])); } \
      resc=false; \
      if(__builtin_expect(__any(rm>(float)THRL),0)){ const float dl=__builtin_fmaxf(rm,0.f); mhat+=dl; \
        _Pragma("unroll") for(int r=0;r<16;++r){C0[r]-=dl;C1[r]-=dl;} \
        const float f=__builtin_amdgcn_exp2f(-dl); l_reg*=f; if(hi==0)wsf[r32]=f; resc=true; } } \
    SBAR(); \
    GAPB(o[0]=__builtin_amdgcn_mfma_f32_32x32x16_bf16(PAF(0),VFR(0),o[0],0,0,0), C0,0); \
    GAPB(o[1]=__builtin_amdgcn_mfma_f32_32x32x16_bf16(PAF(0),VFR(4),o[1],0,0,0), C0,4); \
    KRD(GL,0); GAPB(o[0]=__builtin_amdgcn_mfma_f32_32x32x16_bf16(PAF(1),VFR(1),o[0],0,0,0), C0,8); \
    KRD(GL,1); GAPB(o[1]=__builtin_amdgcn_mfma_f32_32x32x16_bf16(PAF(1),VFR(5),o[1],0,0,0), C0,12); \
    KRD(GL,2); GAPB(o[0]=__builtin_amdgcn_mfma_f32_32x32x16_bf16(PAF(2),VFR(2),o[0],0,0,0), C1,0); \
    KRD(GL,3); GAPB(o[1]=__builtin_amdgcn_mfma_f32_32x32x16_bf16(PAF(2),VFR(6),o[1],0,0,0), C1,4); \
    GAPB(o[0]=__builtin_amdgcn_mfma_f32_32x32x16_bf16(PAF(3),VFR(3),o[0],0,0,0), C1,8); \
    GAPB(o[1]=__builtin_amdgcn_mfma_f32_32x32x16_bf16(PAF(3),VFR(7),o[1],0,0,0), C1,12); \
    }while(0)
  int t=1;
  #undef CMASK
  #define CMASK(P0,P1,t) do{}while(0)
  for(;t+5<NT;t+=2){
    STEP(pB0,pB1,pA0,pA1,t,true,true,true);     WAIT_BAR(2); RESC(); ROT();
    STEP(pA0,pA1,pB0,pB1,t+1,true,true,true);   WAIT_BAR(2); RESC(); ROT();
  }
  #undef CMASK
  #define CMASK(P0,P1,t) do{int jb_=(t)-(NT-4); if(jb_>=0)cmask(P0,P1,jb_,qrel,hi);}while(0)
  #define ENDW(tt) do{ if((tt)+3<NT){WAIT_BAR(2);} else if((tt)+2<NT){WAIT_BAR(1);} else {WAIT_BAR(0);} }while(0)
  for(;t+1<NT;t+=2){
    STEP(pB0,pB1,pA0,pA1,t,(t+3<NT),(t+1<NT),(t+1<NT));       ENDW(t);   RESC(); ROT();
    STEP(pA0,pA1,pB0,pB1,t+1,(t+4<NT),(t+2<NT),(t+2<NT));     ENDW(t+1); RESC(); ROT();
  }
  STEP(pB0,pB1,pA0,pA1,NT-1,false,false,false); RESC();
  { float sacc=pB0[0]+pB0[1]; _Pragma("unroll") for(int r=2;r<16;++r)sacc+=pB0[r]; _Pragma("unroll") for(int r=0;r<16;++r)sacc+=pB1[r]; l_reg+=sacc;
    pw0=(u32x4){PKW(pB0,0),PKW(pB0,2),PKW(pB0,4),PKW(pB0,6)};pw1=(u32x4){PKW(pB0,8),PKW(pB0,10),PKW(pB0,12),PKW(pB0,14)};pw2=(u32x4){PKW(pB1,0),PKW(pB1,2),PKW(pB1,4),PKW(pB1,6)};pw3=(u32x4){PKW(pB1,8),PKW(pB1,10),PKW(pB1,12),PKW(pB1,14)};
    SBAR(); pv(o,vb0+sl_cur,PAF(0),PAF(1),PAF(2),PAF(3)); }
  #undef PKW
  #undef PAF
  #undef VFR
  #undef PIN
  #undef MX3
  #undef GAPA
  #undef GAPB
  #undef EX
  #undef VRD
  #undef KRD
  #undef STEP
  #undef ENDW
  {auto rr=__builtin_amdgcn_permlane32_swap(__float_as_uint(l_reg),__float_as_uint(l_reg),false,false);l_reg=__uint_as_float(rr[0])+__uint_as_float(rr[1]);}
  if(hi==0)wsf[32+r32]=l_reg;asm volatile("s_waitcnt lgkmcnt(0)":::"memory");
  float rli[16];
  #pragma unroll
  for(int r=0;r<16;++r)rli[r]=__builtin_amdgcn_rcpf(wsf[32+crow(r,hi)]);
  bf16*Ow=O+(rowbase+q0+wid*QBLK)*OP+h*D;
  { bf16*stg=(bf16*)(shm+LDS_OST)+wid*2048;
    #pragma unroll
    for(int r=0;r<16;++r){const int orow=crow(r,hi);
      #pragma unroll
      for(int d0=0;d0<2;++d0)stg[orow*64+d0*32+r32]=__float2bfloat16(o[d0][r]*rli[r]);}
    asm volatile("s_waitcnt lgkmcnt(0)":::"memory");
    #pragma unroll
    for(int i=0;i<4;++i){const int row=i*8+(lane>>3),ch=lane&7; const u32x4 v=*(const u32x4*)(stg+row*64+ch*8); ATTN_STORE16(Ow+(long)row*OP+ch*8,v);} }
  asm volatile("s_waitcnt lgkmcnt(0)\n\ts_barrier":::"memory");
  #undef DMA_K
  #undef DMA_V
  #undef CMASK
  #undef START
  #undef RESC
  #undef BIAS
  #undef ROT
}
constexpr int ATTN_LDS_BYTES=LDS_F+LDS_F_BYTES;
#undef SBAR
#undef WAIT_BAR
}
#define GAS __attribute__((address_space(1)))
#define LAS __attribute__((address_space(3)))
typedef unsigned short bf16;
typedef unsigned v4u __attribute__((ext_vector_type(4)));
typedef float f32x4 __attribute__((ext_vector_type(4)));
typedef short bf16x8 __attribute__((ext_vector_type(8)));
typedef GAS unsigned gu32;
typedef GAS unsigned long long gu64;
#define RLX_AGENT __ATOMIC_RELAXED, __HIP_MEMORY_SCOPE_AGENT
#define LDS_WAIT() asm volatile("s_waitcnt lgkmcnt(0)" ::: "memory")
#define VM_WAIT() asm volatile("s_waitcnt vmcnt(0)" ::: "memory")
__device__ __forceinline__ unsigned long long rt() { return __builtin_amdgcn_s_memrealtime(); }
__device__ __forceinline__ unsigned f2bf(float f) { unsigned u = __builtin_bit_cast(unsigned, f); return (u + 0x7fffu + ((u >> 16) & 1u)) >> 16; }
__device__ __forceinline__ unsigned pk2(float lo, float hi) { return f2bf(lo) | (f2bf(hi) << 16); }

#define XB_TMO      128
#define XB_XCNT(j)  (256  + 64 * (j))
#define XB_XSUB(j)  (1280 + 64 * (j))
#define XB_XGEN(j)  (2304 + 64 * (j))
#define XB_TOP      3328
#define XB_TOPGEN   3392
#define XCD_BAR_WORDS 3456
#define XB_SPIN_CAP (1u << 18)

__device__ __forceinline__ unsigned xb_ld(unsigned* p)              { return __hip_atomic_load(p, __ATOMIC_RELAXED, __HIP_MEMORY_SCOPE_AGENT); }
__device__ __forceinline__ unsigned xb_add(unsigned* p, unsigned v) { return __hip_atomic_fetch_add(p, v, __ATOMIC_RELAXED, __HIP_MEMORY_SCOPE_AGENT); }
__device__ __forceinline__ unsigned xb_xcc_id() { return (unsigned)__builtin_amdgcn_s_getreg((3 << 11) | 20) & 0xFu; }
#define XB_SPIN(cond, bar) do { unsigned _sp = 0; while (cond) { __builtin_amdgcn_s_sleep(1); \
    if ((++_sp & 255u) == 0u) { if (xb_ld(&(bar)[XB_TMO])) break; if (_sp > XB_SPIN_CAP) { atomicAdd(&(bar)[XB_TMO], 1u); break; } } } } while (0)

struct XcdBarrier {
    unsigned* bar; unsigned x;
    volatile LAS unsigned* st;
};

__device__ __forceinline__ XcdBarrier xcd_barrier_post(unsigned* bar, volatile LAS unsigned* st) {
    XcdBarrier b; b.bar = bar; b.x = xb_xcc_id(); b.st = st;
    if (threadIdx.x == 0) (void)xb_add(&bar[XB_XCNT(b.x)], 1u);
    return b;
}
__device__ __forceinline__ void xcd_barrier_complete(unsigned* bar, unsigned x, unsigned& nloc, unsigned& nx) {
    const unsigned G = gridDim.x * gridDim.y * gridDim.z;
    unsigned sum, cnt, mine, sp = 0u;
    for (;;) {
        sum = 0u; cnt = 0u; mine = 0u;
#pragma unroll
        for (unsigned j = 0; j < 16; ++j) { const unsigned c = xb_ld(&bar[XB_XCNT(j)]); sum += c; cnt += (c > 0u) ? 1u : 0u; mine = (j == x) ? c : mine; }
        if (sum == G) break;
        __builtin_amdgcn_s_sleep(1);
        if ((++sp & 255u) == 0u) { if (xb_ld(&bar[XB_TMO])) break; if (sp > XB_SPIN_CAP) { atomicAdd(&bar[XB_TMO], 1u); break; } }
    }
    nloc = mine > 0u ? mine : 1u; nx = cnt > 0u ? cnt : 1u;
}

__device__ __forceinline__ void xcd_barrier(const XcdBarrier& b) {
    asm volatile("s_waitcnt vmcnt(0)" ::: "memory");
    __syncthreads();
    if (threadIdx.x == 0) {
        unsigned* bar = b.bar;
        __builtin_amdgcn_s_waitcnt(0);
        unsigned nloc = b.st[0], nx = b.st[1];
        if (nloc == 0u) { xcd_barrier_complete(bar, b.x, nloc, nx); b.st[0] = nloc; b.st[1] = nx; }
        const unsigned old = xb_add(&bar[XB_XSUB(b.x)], 1u);
        const unsigned gen = old / nloc;
        if (old + 1u == (gen + 1u) * nloc) {
            __builtin_amdgcn_fence(__ATOMIC_RELEASE, "agent");
            asm volatile("s_waitcnt vmcnt(0)" ::: "memory");
            const unsigned og = xb_add(&bar[XB_TOP], 1u);
            const unsigned tg = og / nx;
            if (og + 1u == (tg + 1u) * nx) xb_add(&bar[XB_TOPGEN], 1u);
            else XB_SPIN(xb_ld(&bar[XB_TOPGEN]) == tg, bar);
            __builtin_amdgcn_fence(__ATOMIC_ACQUIRE, "agent");
            xb_add(&bar[XB_XGEN(b.x)], 1u);
            asm volatile("s_waitcnt vmcnt(0)" ::: "memory");
        } else {
            XB_SPIN(xb_ld(&bar[XB_XGEN(b.x)]) == gen, bar);
            __builtin_amdgcn_fence(__ATOMIC_ACQUIRE, "agent");
            asm volatile("s_waitcnt vmcnt(0)" ::: "memory");
        }
    }
    __syncthreads();
}
constexpr int NWAVES = 8, NTHR = NWAVES * 64;
constexpr int T_ = 16384, DM_ = 1024, SEQ_ = 4096, NBH = 48, NHEADS = 12;
constexpr int EV_LD = 2828, EV_N = 2816;
constexpr int NEXP = 16, EHID = 256, SLOTS = 36864;
constexpr float EPS_ = 1e-6f, LOG2E = 1.4426950408889634f;
constexpr int NPH = 15;
constexpr size_t MiB = 1u << 20;
constexpr size_t WS_CTL = 0, CTL_ZERO_BYTES = 1 * MiB;
constexpr size_t WS_WIN0 = 1 * MiB, WS_WOUT0 = 7 * MiB, WS_WIN1 = 9 * MiB, WS_WOUT1 = 13 * MiB, WS_WST = 15 * MiB, WS_WGU = 16 * MiB, WS_WD = 48 * MiB;
constexpr size_t WS_XN = 64 * MiB;
constexpr size_t WS_A = 96 * MiB;
constexpr size_t WS_U = WS_A, WS_V = WS_A + 8 * MiB, WS_Q = WS_A + 16 * MiB, WS_K = WS_A + 40 * MiB, WS_VAL = WS_A + 64 * MiB;
constexpr size_t WS_Y = WS_A, WS_H1 = WS_A;
constexpr size_t WS_MIX = 184 * MiB;
constexpr size_t WS_HID = 216 * MiB;
constexpr size_t WS_F2 = 234 * MiB, WS_LIST = 235 * MiB, WS_LISTW = 236 * MiB, WS_TOKE = 237 * MiB, WS_TOKP = 237 * MiB + 512 * 1024, WS_END = 240 * MiB;
static_assert(WS_Y + (size_t)SLOTS * 1024 * 2 <= WS_MIX && WS_HID + (size_t)SLOTS * 256 * 2 <= WS_F2 && WS_VAL + (size_t)T_ * 768 * 2 <= WS_MIX, "ws map");
constexpr int CW_TMO = 0, CW_BAR = 4096, CW_Q = 8192, CW_CNT0 = 16384, CW_CNT1 = 16384 + 1024, CW_CNTD = 16384 + 2048, CNT_STRIDE = 64;
constexpr int RING_BYTES = 131072, LDSCTL_OFF = RING_BYTES, MISC_OFF = LDSCTL_OFF + 320, LDS_BYTES = 147456;

__device__ __forceinline__ float wave_sum(float v) {
#pragma unroll
    for (int o = 1; o < 64; o <<= 1) v += __shfl_xor(v, o);
    return v;
}
__device__ __forceinline__ float fast_sigmoid(float z) { return __builtin_amdgcn_rcpf(1.f + __builtin_amdgcn_exp2f(-z * LOG2E)); }
__device__ __forceinline__ float gelu_tanh(float x) { const float z = 1.5957691216057308f * x * (1.f + 0.044715f * x * x); return x * fast_sigmoid(z); }
__device__ __forceinline__ float bf2f(unsigned short h) { return __builtin_bit_cast(float, (unsigned)h << 16); }


constexpr int TP = 1028;
template <int NC>
__device__ __forceinline__ void skinny_core(const float* X, int row0, const LAS float* wt, LAS float* part, LAS float* ssq, int wave, int lane) {
    const int rg = wave & 3, kh = wave >> 2, r = lane & 15, kq = lane >> 4, col = lane & 15;
    const GAS float* xp = (const GAS float*)X + (size_t)(row0 + 16 * rg + r) * DM_ + 512 * kh + 4 * kq;
    const LAS float* b0p = wt + (col < NC ? col : NC - 1) * TP + 512 * kh + 4 * kq;
    const LAS float* b1p = wt + ((NC > 16) ? (16 + (col & 3)) : 0) * TP + 512 * kh + 4 * kq;
    f32x4 acc0 = (f32x4){0.f, 0.f, 0.f, 0.f}, acc1 = (f32x4){0.f, 0.f, 0.f, 0.f}; float ss = 0.f;
#pragma unroll 1
    for (int jb = 0; jb < 2; ++jb) {
        f32x4 xv[16];
#pragma unroll
        for (int jj = 0; jj < 16; ++jj) xv[jj] = *(const GAS f32x4*)(xp + 16 * (16 * jb + jj));
#pragma unroll
        for (int jj = 0; jj < 16; ++jj) { const f32x4 b0 = *(const LAS f32x4*)(b0p + 16 * (16 * jb + jj)); const f32x4 x4 = xv[jj];
            ss += (x4.x * x4.x + x4.y * x4.y) + (x4.z * x4.z + x4.w * x4.w);
            acc0 = __builtin_amdgcn_mfma_f32_16x16x4f32(x4.x, b0.x, acc0, 0, 0, 0); acc0 = __builtin_amdgcn_mfma_f32_16x16x4f32(x4.y, b0.y, acc0, 0, 0, 0);
            acc0 = __builtin_amdgcn_mfma_f32_16x16x4f32(x4.z, b0.z, acc0, 0, 0, 0); acc0 = __builtin_amdgcn_mfma_f32_16x16x4f32(x4.w, b0.w, acc0, 0, 0, 0);
            if (NC > 16) { const f32x4 b1 = *(const LAS f32x4*)(b1p + 16 * (16 * jb + jj));
                acc1 = __builtin_amdgcn_mfma_f32_16x16x4f32(x4.x, b1.x, acc1, 0, 0, 0); acc1 = __builtin_amdgcn_mfma_f32_16x16x4f32(x4.y, b1.y, acc1, 0, 0, 0);
                acc1 = __builtin_amdgcn_mfma_f32_16x16x4f32(x4.z, b1.z, acc1, 0, 0, 0); acc1 = __builtin_amdgcn_mfma_f32_16x16x4f32(x4.w, b1.w, acc1, 0, 0, 0); } }
    }
    ss += __shfl_xor(ss, 16); ss += __shfl_xor(ss, 32);
    if (lane < 16) ssq[kh * 64 + 16 * rg + r] = ss;
#pragma unroll
    for (int i = 0; i < 4; ++i) { LAS float* pr = part + (kh * 64 + 16 * rg + 4 * kq + i) * 32; pr[col] = acc0[i]; if (NC > 16 && col < 4) pr[16 + col] = acc1[i]; }
    __syncthreads();
}
__device__ __forceinline__ void xn_tile(const float* X, const float* gn, unsigned char* ws, int row0, const LAS float* rstd_l, int wave, int lane) {
    f32x4 g4[4];
#pragma unroll
    for (int j = 0; j < 4; ++j) g4[j] = *((const GAS f32x4*)gn + 64 * j + lane);
#pragma unroll 4
    for (int i = 0; i < 8; ++i) { const int m = row0 + 8 * wave + i; const float rstd = rstd_l[8 * wave + i];
        const GAS f32x4* xr = (const GAS f32x4*)(X + (size_t)m * DM_) + lane; GAS unsigned long long* o8 = (GAS unsigned long long*)(ws + WS_XN + (size_t)m * DM_ * 2) + lane;
        f32x4 v[4];
#pragma unroll
        for (int j = 0; j < 4; ++j) v[j] = xr[64 * j];
#pragma unroll
        for (int j = 0; j < 4; ++j) o8[64 * j] = (unsigned long long)pk2(v[j].x * rstd * g4[j].x, v[j].y * rstd * g4[j].y) | ((unsigned long long)pk2(v[j].z * rstd * g4[j].z, v[j].w * rstd * g4[j].w) << 32); }
}
struct TrItem { const float* src; bf16* dst; int ldw2, kp8; };
struct TrSrc { const float *w_in0, *w_out0, *w_in1, *w_out1, *w_gate, *w_up, *w_down; };
__device__ __forceinline__ TrItem tr_decode(int it, const TrSrc& S, unsigned char* ws, int lane) {
    constexpr int I0 = 16 * 88, I1 = 16 * 32, I2 = 16 * 64, I3 = 8 * 32, I4 = 32 * 128;
    const float* W; int ldw, Kp, k0, n0, drow0; bf16* WT; int r = it;
    if (r < I0) { const int kb = r / 88, nb = r % 88, c = (32 * nb) & 255; W = S.w_in0; ldw = EV_LD; WT = (bf16*)(ws + WS_WIN0); Kp = 1024; k0 = 64 * kb; n0 = 32 * nb; drow0 = (n0 & ~255) + 128 * ((c >> 5) & 1) + 32 * (c >> 6); }
    else if ((r -= I0) < I1) { const int kb = r / 32, nb = r % 32; W = S.w_out0; ldw = 1024; WT = (bf16*)(ws + WS_WOUT0); Kp = 1024; k0 = 64 * kb; n0 = 32 * nb; drow0 = n0; }
    else if ((r -= I1) < I2) { const int kb = r / 64, nb = r % 64; W = S.w_in1; ldw = 2048; WT = (bf16*)(ws + WS_WIN1); Kp = 1024; k0 = 64 * kb; n0 = 32 * nb; drow0 = n0; }
    else if ((r -= I2) < I3) { const int kb = r / 32, nb = r % 32; W = S.w_out1; ldw = 1024; WT = (bf16*)(ws + WS_WOUT1); Kp = 1024; k0 = 64 * kb; n0 = 32 * nb; drow0 = n0; }
    else if ((r -= I3) < I4) { const int le = r / 128, rr = r % 128; W = S.w_gate + (size_t)le * 1024 * 256; ldw = 256; WT = (bf16*)(ws + WS_WGU) + (size_t)le * 512 * 1024; Kp = 1024; k0 = 64 * (rr / 8); n0 = 32 * (rr % 8); drow0 = (n0 >> 7) * 256 + (n0 & 127); }
    else if ((r -= I4) < I4) { const int le = r / 128, rr = r % 128; W = S.w_up + (size_t)le * 1024 * 256; ldw = 256; WT = (bf16*)(ws + WS_WGU) + (size_t)le * 512 * 1024; Kp = 1024; k0 = 64 * (rr / 8); n0 = 32 * (rr % 8); drow0 = (n0 >> 7) * 256 + 128 + (n0 & 127); }
    else { r -= I4; const int le = r / 128, rr = r % 128; W = S.w_down + (size_t)le * 256 * 1024; ldw = 1024; WT = (bf16*)(ws + WS_WD) + (size_t)le * 1024 * 256; Kp = 256; k0 = 64 * (rr / 32); n0 = 32 * (rr % 32); drow0 = n0; }
    TrItem t; t.src = W + (size_t)(k0 + (lane >> 5)) * ldw + n0 + (lane & 31); t.ldw2 = 2 * ldw; t.dst = WT + (size_t)(drow0 + (lane >> 3)) * Kp + k0 + 8 * (lane & 7); t.kp8 = 8 * Kp; return t;
}
template <class IN_T> __device__ __forceinline__ void p0_prologue(const IN_T in, unsigned char* ws, LAS unsigned char* lds, int G, int vcu) {
    int tid_ = threadIdx.x; asm volatile("" : "+v"(tid_)); const int tid = tid_, lane = tid & 63, wave = __builtin_amdgcn_readfirstlane(tid >> 6);
    LAS float* scr = (LAS float*)(lds + wave * 16384);
    const int gw = vcu * NWAVES + wave, NGW = G * NWAVES;
    constexpr int NITEMS = 16 * 88 + 16 * 32 + 16 * 64 + 8 * 32 + 3 * 32 * 128;
    { TrSrc S{in[2], in[9], in[11], in[15], in[21], in[22], in[23]};
      float tv[32], tn[32]; TrItem cur{nullptr, nullptr, 0, 0};
      if (gw < NITEMS) { cur = tr_decode(gw, S, ws, lane);
#pragma unroll
          for (int i = 0; i < 32; ++i) tv[i] = cur.src[(size_t)i * cur.ldw2]; }
      for (int it = gw; it < NITEMS; it += NGW) {
          TrItem nx = cur; const bool more = it + NGW < NITEMS;
          if (more) { nx = tr_decode(it + NGW, S, ws, lane);
#pragma unroll
              for (int i = 0; i < 32; ++i) tn[i] = nx.src[(size_t)i * nx.ldw2]; }
#pragma unroll
          for (int i = 0; i < 32; ++i) scr[(2 * i + (lane >> 5)) * 33 + (lane & 31)] = tv[i];
          LDS_WAIT(); asm volatile("" ::: "memory");
          const int c = lane & 7;
#pragma unroll
          for (int j = 0; j < 4; ++j) { const LAS float* s = scr + (8 * c) * 33 + (lane >> 3) + 8 * j;
              v4u o; o.x = pk2(s[0 * 33], s[1 * 33]); o.y = pk2(s[2 * 33], s[3 * 33]); o.z = pk2(s[4 * 33], s[5 * 33]); o.w = pk2(s[6 * 33], s[7 * 33]);
              *(GAS v4u*)(cur.dst + (size_t)j * cur.kp8) = o; }
          LDS_WAIT(); asm volatile("" ::: "memory");
          cur = nx;
#pragma unroll
          for (int i = 0; i < 32; ++i) tv[i] = tn[i];
      } }
    const int gt = vcu * NTHR + tid, NGT = G * NTHR;
    { const float* const w_s = in[4]; for (int i = gt; i < 4 * 128 * 128; i += NGT) { const int s = i & 127, t = (i >> 7) & 127; ((GAS bf16*)(ws + WS_WST))[i] = (s <= t) ? (bf16)f2bf(w_s[i]) : (bf16)0; } }
    { const float* const w_pool = in[13]; const float* const p_scale = in[14]; const float* const w_out1 = in[15];
      for (int it = gw; it < 4 * 16 * 16; it += NGW) {
        const int itu = __builtin_amdgcn_readfirstlane(it), g = itu >> 8, c0 = ((itu >> 4) & 15) * 8, n = (itu & 15) * 64 + lane;
        const float* wp = w_pool + (size_t)(g * 128 + c0) * 128; const float* sc = p_scale + g * 128; const float* wo = w_out1 + (size_t)(512 + g * 128) * 1024 + n;
        float a[8];
#pragma unroll
        for (int c = 0; c < 8; ++c) a[c] = 0.f;
#pragma unroll 16
        for (int d = 0; d < 128; ++d) { const float t = sc[d] * wo[(size_t)d * 1024];
#pragma unroll
            for (int c = 0; c < 8; ++c) a[c] += wp[c * 128 + d] * t; }
        v4u o; o.x = pk2(a[0], a[1]); o.y = pk2(a[2], a[3]); o.z = pk2(a[4], a[5]); o.w = pk2(a[6], a[7]);
        *(GAS v4u*)((bf16*)(ws + WS_WOUT1) + (size_t)n * 1024 + 512 + g * 128 + c0) = o; } }
    __syncthreads();
    LAS float* wf = (LAS float*)lds; LAS float* part = (LAS float*)(lds + 98304); LAS float* ssq = part + 2 * 64 * 32; LAS float* rstd_l = ssq + 128;
    const float* const x = in[0]; const float* const gn = in[1]; const float* const b_forget = in[3];
    { const float* const w_in0 = in[2];
#pragma unroll
      for (int kk = 0; kk < 2; ++kk) { const int k = tid + NTHR * kk; const GAS f32x4* src = (const GAS f32x4*)(w_in0 + (size_t)k * EV_LD + EV_N); const f32x4 q0 = src[0], q1 = src[1], q2 = src[2]; const float g = gn[k];
          wf[0 * TP + k] = q0.x * g; wf[1 * TP + k] = q0.y * g; wf[2 * TP + k] = q0.z * g; wf[3 * TP + k] = q0.w * g; wf[4 * TP + k] = q1.x * g; wf[5 * TP + k] = q1.y * g; wf[6 * TP + k] = q1.z * g; wf[7 * TP + k] = q1.w * g;
          wf[8 * TP + k] = q2.x * g; wf[9 * TP + k] = q2.y * g; wf[10 * TP + k] = q2.z * g; wf[11 * TP + k] = q2.w * g; } }
    __syncthreads();
    for (int tile = vcu; tile < T_ / 64; tile += G) { const int row0 = tile * 64;
        skinny_core<12>(x, row0, wf, part, ssq, wave, lane);
        if (tid < 64) { const int m = row0 + tid; const float rstd = __builtin_amdgcn_rsqf((ssq[tid] + ssq[64 + tid]) * (1.f / DM_) + EPS_); rstd_l[tid] = rstd;
            GAS float* f2 = (GAS float*)(ws + WS_F2) + (size_t)((m >> 12) * NHEADS) * SEQ_ + (m & (SEQ_ - 1));
#pragma unroll
            for (int h = 0; h < 12; ++h) { const float z = (part[tid * 32 + h] + part[(64 + tid) * 32 + h]) * rstd + b_forget[h];
                const float ls = (z >= 0.f) ? -log1pf(__expf(-z)) : (z - log1pf(__expf(z)));
                f2[(size_t)h * SEQ_] = ls * LOG2E; } }
        __syncthreads();
        xn_tile(x, gn, ws, row0, rstd_l, wave, lane);
        __syncthreads();
    }
}

__device__ __forceinline__ void scan_seq(float* f, LAS float* tot) {
    int tid_ = threadIdx.x; asm volatile("" : "+v"(tid_)); const int tid = tid_, lane = tid & 63, wave = tid >> 6;
    GAS f32x4* p = (GAS f32x4*)f + 2 * tid; f32x4 a = p[0], b = p[1];
    a.y += a.x; a.z += a.y; a.w += a.z; b.x += a.w; b.y += b.x; b.z += b.y; b.w += b.z;
    float run = b.w;
#pragma unroll
    for (int o = 1; o < 64; o <<= 1) { const float t = __shfl_up(run, o); if (lane >= o) run += t; }
    if (lane == 63) tot[wave] = run;
    __syncthreads();
    float base = run - b.w;
    for (int w = 0; w < wave; ++w) base += tot[w];
    a = a + base; b = b + base; p[0] = a; p[1] = b;
    __syncthreads();
}

struct EpiInproj0 {
    static constexpr bool PERM = true;
    bf16 *U, *V, *Q, *Kb, *VAL; const float *g_v, *g_q, *g_k;
    __device__ __forceinline__ void operator()(const pg8::f32x4 (&acc)[2][2][4][2], const pg8::Unit& u, int wr, int wc, int fr, int fq) const {
        const int pn = u.pn; const bool act = pn <= 1, nrm = (pn >= 1 && pn <= 7);
        bf16* dst; int pitch, cb; const float* gp = nullptr; float gs = 1.f;
        if (pn == 0) { dst = U; pitch = 256; cb = 0; }
        else if (pn == 1) { dst = V; pitch = 256; cb = 0; gp = g_v + wc * 64; }
        else if (pn <= 4) { dst = Q; pitch = 768; cb = (pn - 2) * 256; gp = g_q; gs = 0.125f * LOG2E; }
        else if (pn <= 7) { dst = Kb; pitch = 768; cb = (pn - 5) * 256; gp = g_k; }
        else { dst = VAL; pitch = 768; cb = (pn - 8) * 256; }
        f32x4 gn[2][2];
#pragma unroll
        for (int bj = 0; bj < 2; ++bj)
#pragma unroll
            for (int n = 0; n < 2; ++n) { gn[bj][n] = (f32x4){1.f, 1.f, 1.f, 1.f}; if (nrm) gn[bj][n] = *(const f32x4*)(gp + 32 * bj + 8 * fq + 4 * n) * gs; }
        const int row0 = u.pm * 256 + wr * 64 + fr, col0 = cb + 64 * wc + 8 * fq;
#pragma unroll
        for (int ai = 0; ai < 2; ++ai)
#pragma unroll
            for (int m = 0; m < 4; ++m) {
                f32x4 x[2][2]; float ss = 0.f;
#pragma unroll
                for (int bj = 0; bj < 2; ++bj)
#pragma unroll
                    for (int n = 0; n < 2; ++n) { f32x4 t = acc[ai][bj][m][n];
                        if (act) { t.x = gelu_tanh(t.x); t.y = gelu_tanh(t.y); t.z = gelu_tanh(t.z); t.w = gelu_tanh(t.w); }
                        ss += (t.x * t.x + t.y * t.y) + (t.z * t.z + t.w * t.w); x[bj][n] = t; }
                float r = 1.f;
                if (nrm) { ss += __shfl_xor(ss, 16); ss += __shfl_xor(ss, 32); r = __builtin_amdgcn_rsqf(ss * (1.f / 64.f) + EPS_); }
                bf16* rowp = dst + (size_t)(row0 + ai * 128 + m * 16) * pitch + col0;
#pragma unroll
                for (int bj = 0; bj < 2; ++bj) { const f32x4 v0 = x[bj][0] * gn[bj][0] * r, v1 = x[bj][1] * gn[bj][1] * r;
                    v4u w; w.x = pg8::cvt_pk_bf16(v0.x, v0.y); w.y = pg8::cvt_pk_bf16(v0.z, v0.w); w.z = pg8::cvt_pk_bf16(v1.x, v1.y); w.w = pg8::cvt_pk_bf16(v1.z, v1.w);
                    *(v4u*)(rowp + 32 * bj) = w; }
            }
    }
};
struct EpiResF32 {
    static constexpr bool PERM = false;
    const float* base; float* out;
    __device__ __forceinline__ void operator()(const pg8::f32x4 (&acc)[2][2][4][2], const pg8::Unit& u, int wr, int wc, int fr, int fq) const {
        const int row0 = u.pm * 256 + wr * 64 + fr, col0 = u.pn * 256 + wc * 32 + 4 * fq;
#pragma unroll
        for (int ai = 0; ai < 2; ++ai)
#pragma unroll
            for (int m = 0; m < 4; ++m) { const size_t off = (size_t)(row0 + ai * 128 + m * 16) * DM_ + col0;
#pragma unroll
                for (int bj = 0; bj < 2; ++bj)
#pragma unroll
                    for (int n = 0; n < 2; ++n) { const f32x4 b = *(const f32x4*)(base + off + bj * 128 + n * 16); *(f32x4*)(out + off + bj * 128 + n * 16) = b + acc[ai][bj][m][n]; }
                if (m & 1) asm volatile("" ::: "memory"); }
    }
};
struct EpiBf16 {
    static constexpr bool PERM = true;
    bf16* O; int ldc;
    __device__ __forceinline__ void operator()(const pg8::f32x4 (&acc)[2][2][4][2], const pg8::Unit& u, int wr, int wc, int fr, int fq) const {
        const int row0 = u.pm * 256 + wr * 64 + fr, col0 = u.pn * 256 + wc * 32 + 8 * fq;
#pragma unroll
        for (int ai = 0; ai < 2; ++ai)
#pragma unroll
            for (int m = 0; m < 4; ++m) { bf16* rowp = O + (size_t)(row0 + ai * 128 + m * 16) * ldc + col0;
#pragma unroll
                for (int bj = 0; bj < 2; ++bj) { const f32x4 v0 = acc[ai][bj][m][0], v1 = acc[ai][bj][m][1];
                    v4u w; w.x = pg8::cvt_pk_bf16(v0.x, v0.y); w.y = pg8::cvt_pk_bf16(v0.z, v0.w); w.z = pg8::cvt_pk_bf16(v1.x, v1.y); w.w = pg8::cvt_pk_bf16(v1.z, v1.w);
                    *(v4u*)(rowp + bj * 128) = w; } }
    }
};
struct EpiGateUp {
    static constexpr bool PERM = true;
    bf16* HID; const float* listw;
    __device__ __forceinline__ void operator()(const pg8::f32x4 (&acc)[2][2][4][2], const pg8::Unit& u, int wr, int wc, int fr, int fq) const {
        const int col0 = u.pn * 128 + wc * 32 + 8 * fq;
#pragma unroll
        for (int ai = 0; ai < 2; ++ai)
#pragma unroll
            for (int m = 0; m < 4; ++m) { const int rt = ai * 128 + wr * 64 + m * 16 + fr, pos = u.j * 256 + rt;
                const float w = (pos < u.cnt) ? listw[(size_t)u.e * T_ + pos] : 0.f;
                f32x4 h[2];
#pragma unroll
                for (int n = 0; n < 2; ++n) { const f32x4 g = acc[ai][0][m][n], up = acc[ai][1][m][n];
                    h[n].x = g.x * fast_sigmoid(g.x) * up.x * w; h[n].y = g.y * fast_sigmoid(g.y) * up.y * w; h[n].z = g.z * fast_sigmoid(g.z) * up.z * w; h[n].w = g.w * fast_sigmoid(g.w) * up.w * w; }
                v4u o; o.x = pg8::cvt_pk_bf16(h[0].x, h[0].y); o.y = pg8::cvt_pk_bf16(h[0].z, h[0].w); o.z = pg8::cvt_pk_bf16(h[1].x, h[1].y); o.w = pg8::cvt_pk_bf16(h[1].z, h[1].w);
                *(v4u*)(HID + (size_t)(u.pm * 256 + rt) * EHID + col0) = o; }
    }
};
struct ProbMoe {
    const char* A; const char* Bt; int K, nN, G, c; unsigned* cnt; const int* list; bool gather; size_t bstride;
    __device__ __forceinline__ bool next(int i, pg8::Unit& u) const {
        const int L = i * G + c, mt = L / nN; int pre = 0; bool found = false;
#pragma unroll
        for (int e = 0; e < NEXP; ++e) { const int ce = (int)__builtin_amdgcn_readfirstlane(__hip_atomic_load(cnt + CNT_STRIDE * e, __ATOMIC_RELAXED, __HIP_MEMORY_SCOPE_AGENT)); const int tl = (ce + 255) >> 8;
            if (mt >= pre && mt < pre + tl) { u.e = e; u.j = mt - pre; u.cnt = ce; found = true; } pre += tl; }
        u.pm = mt; u.pn = L % nN; return found;
    }
    __device__ __forceinline__ unsigned a_off(const pg8::Unit& u, int row) const {
        if (gather) { int pos = u.j * 256 + row; pos = pos < u.cnt ? pos : u.cnt - 1; const int tok = list[(size_t)u.e * T_ + pos]; return (unsigned)tok * (unsigned)(K * 2); }
        return (unsigned)(u.pm * 256 + row) * (unsigned)(K * 2);
    }
    __device__ __forceinline__ const char* b_base(const pg8::Unit& u) const { return Bt + (size_t)u.e * bstride + (size_t)u.pn * 256 * K * 2; }
};

__device__ __forceinline__ void gmlp_unit(int idx, const bf16* U, const bf16* V, const bf16* WST, const float* b_s, bf16* MIX, LAS unsigned char* lds) {
    int tid_ = threadIdx.x; asm volatile("" : "+v"(tid_)); const int tid = tid_, lane = tid & 63, wave = __builtin_amdgcn_readfirstlane(tid >> 6), fr = lane & 15, fq = lane >> 4;
    const int c = idx >> 2, g = idx & 3, tok0 = c * 128;
    LAS bf16* Vt = (LAS bf16*)lds;
#pragma unroll
    for (int i = 0; i < 2; ++i) { const int p = tid + NTHR * i, s = p >> 3, dc = p & 7;
        const v4u q = *(const GAS v4u*)(V + (size_t)(tok0 + s) * 256 + g * 64 + dc * 8);
        const unsigned w[4] = {q.x, q.y, q.z, q.w};
#pragma unroll
        for (int e = 0; e < 4; ++e) { Vt[(dc * 8 + 2 * e) * 136 + s] = (bf16)(w[e] & 0xffffu); Vt[(dc * 8 + 2 * e + 1) * 136 + s] = (bf16)(w[e] >> 16); } }
    __syncthreads();
    const int t0 = 16 * wave;
    pg8::f32x4 acc[4];
#pragma unroll
    for (int n = 0; n < 4; ++n) acc[n] = (pg8::f32x4){0.f, 0.f, 0.f, 0.f};
#pragma unroll
    for (int ks = 0; ks < 4; ++ks) {
        const bf16x8 wfrag = *(const GAS bf16x8*)(WST + (size_t)(g * 128 + t0 + fr) * 128 + 32 * ks + 8 * fq);
#pragma unroll
        for (int n = 0; n < 4; ++n) { const bf16x8 vfrag = *(const LAS bf16x8*)(Vt + (16 * n + fr) * 136 + 32 * ks + 8 * fq);
            acc[n] = __builtin_amdgcn_mfma_f32_16x16x32_bf16(vfrag, wfrag, acc[n], 0, 0, 0); }
    }
    const int t = t0 + fr; const float bs = b_s[g * 128 + t];
#pragma unroll
    for (int n = 0; n < 4; ++n) { const size_t ucol = (size_t)(tok0 + t) * 256 + g * 64 + 16 * n + 4 * fq;
        const unsigned long long uu = *(const GAS unsigned long long*)(U + ucol);
        const float u0 = bf2f((unsigned short)(uu & 0xffff)), u1 = bf2f((unsigned short)((uu >> 16) & 0xffff)), u2 = bf2f((unsigned short)((uu >> 32) & 0xffff)), u3 = bf2f((unsigned short)(uu >> 48));
        const unsigned lo = pk2(u0 * (acc[n].x + bs), u1 * (acc[n].y + bs)), hi = pk2(u2 * (acc[n].z + bs), u3 * (acc[n].w + bs));
        *(GAS unsigned long long*)(MIX + (size_t)(tok0 + t) * 1024 + g * 64 + 16 * n + 4 * fq) = (unsigned long long)lo | ((unsigned long long)hi << 32); }
    __syncthreads();
}

#if MK_NAIVE_ATTN
__device__ __forceinline__ void naive_attn(const bf16* Q, const bf16* K, const bf16* V, const float* F2, bf16* MIXo, int gt, int NGT) {
    for (int r = gt; r < NBH * SEQ_; r += NGT) { const int bh = r / SEQ_, t = r % SEQ_, b = bh / NHEADS, h = bh % NHEADS; const size_t row = (size_t)b * SEQ_ + t;
        float q[64], o[64];
#pragma unroll
        for (int d = 0; d < 64; ++d) { q[d] = bf2f(Q[row * 768 + h * 64 + d]); o[d] = 0.f; }
        float m = -INFINITY, l = 0.f; const float ft = F2[(size_t)bh * SEQ_ + t];
        for (int s = 0; s <= t; ++s) { const size_t rs = (size_t)b * SEQ_ + s; float sc = 0.f;
#pragma unroll
            for (int d = 0; d < 64; ++d) sc += q[d] * bf2f(K[rs * 768 + h * 64 + d]);
            sc += ft - F2[(size_t)bh * SEQ_ + s];
            const float mn = fmaxf(m, sc), al = exp2f(m - mn), p = exp2f(sc - mn); l = l * al + p; m = mn;
#pragma unroll
            for (int d = 0; d < 64; ++d) o[d] = o[d] * al + p * bf2f(V[rs * 768 + h * 64 + d]); }
        const float il = 1.f / l;
#pragma unroll
        for (int d = 0; d < 64; ++d) MIXo[row * 1024 + 256 + h * 64 + d] = (bf16)f2bf(o[d] * il); }
}
#endif

template <class IN_T> __device__ __forceinline__ void phase_route(const IN_T in, int layer, const float* X, unsigned char* ws, unsigned* cnt, LAS unsigned char* lds, int G, int vcu, int rep) {
    int tid_ = threadIdx.x; asm volatile("" : "+v"(tid_)); const int tid = tid_, lane = tid & 63, wave = __builtin_amdgcn_readfirstlane(tid >> 6);
    LAS float* wt = (LAS float*)lds;
    LAS float* part = (LAS float*)(lds + 98304); LAS float* ssq = part + 2 * 64 * 32; LAS float* rstd_l = ssq + 128; LAS unsigned* lcnt = (LAS unsigned*)(rstd_l + 64); LAS unsigned* lbase = lcnt + 16;
    const float* wg = in[17] + (size_t)layer * 1024 * 4; const float* wrt = in[19] + (size_t)layer * 1024 * 16; const float* gn = in[16] + (size_t)layer * 1024;
#pragma unroll
    for (int kk = 0; kk < 2; ++kk) { const int k = tid + NTHR * kk; const f32x4 q0 = *(const GAS f32x4*)(wg + k * 4); const GAS f32x4* rs = (const GAS f32x4*)(wrt + k * 16); const f32x4 q1 = rs[0], q2 = rs[1], q3 = rs[2], q4 = rs[3]; const float g = gn[k];
        wt[0 * TP + k] = q0.x * g; wt[1 * TP + k] = q0.y * g; wt[2 * TP + k] = q0.z * g; wt[3 * TP + k] = q0.w * g;
        wt[4 * TP + k] = q1.x * g; wt[5 * TP + k] = q1.y * g; wt[6 * TP + k] = q1.z * g; wt[7 * TP + k] = q1.w * g; wt[8 * TP + k] = q2.x * g; wt[9 * TP + k] = q2.y * g; wt[10 * TP + k] = q2.z * g; wt[11 * TP + k] = q2.w * g;
        wt[12 * TP + k] = q3.x * g; wt[13 * TP + k] = q3.y * g; wt[14 * TP + k] = q3.z * g; wt[15 * TP + k] = q3.w * g; wt[16 * TP + k] = q4.x * g; wt[17 * TP + k] = q4.y * g; wt[18 * TP + k] = q4.z * g; wt[19 * TP + k] = q4.w * g; }
    const float* bg = in[18] + layer * 4; const float* br = in[20] + layer * 16;
    int* list = (int*)(ws + WS_LIST); float* listw = (float*)(ws + WS_LISTW); int* toke = (int*)(ws + WS_TOKE); int* tokp = (int*)(ws + WS_TOKP);
    for (int tile = vcu; tile < T_ / 64; tile += G) { const int row0 = tile * 64;
        if (tid < 16) lcnt[tid] = 0u;
        __syncthreads();
        skinny_core<20>(X, row0, wt, part, ssq, wave, lane);
        int e1 = 0, e2 = 0; float w1 = 0.f, w2 = 0.f; unsigned r1 = 0, r2 = 0;
        if (tid < 64) {
            const float rstd = __builtin_amdgcn_rsqf((ssq[tid] + ssq[64 + tid]) * (1.f / DM_) + EPS_); rstd_l[tid] = rstd;
            float a[20];
#pragma unroll
            for (int c = 0; c < 20; ++c) a[c] = (part[tid * 32 + c] + part[(64 + tid) * 32 + c]) * rstd;
            float lg[4]; int gi = 0; float gmax;
#pragma unroll
            for (int j = 0; j < 4; ++j) lg[j] = a[j] + bg[j];
            gmax = lg[0];
#pragma unroll
            for (int j = 1; j < 4; ++j) if (lg[j] > gmax) { gmax = lg[j]; gi = j; }
            float gsum = 0.f;
#pragma unroll
            for (int j = 0; j < 4; ++j) gsum += __expf(lg[j] - gmax);
            const float gtop = 1.f / gsum;
            float le[4];
#pragma unroll
            for (int e = 0; e < 4; ++e) { float s = 0.f;
#pragma unroll
                for (int j = 0; j < 4; ++j) s = (gi == j) ? (a[4 + 4 * j + e] + br[4 * j + e]) : s;
                le[e] = s; }
            int i1 = 0; float m1 = le[0];
#pragma unroll
            for (int e = 1; e < 4; ++e) if (le[e] > m1) { m1 = le[e]; i1 = e; }
            int i2 = -1; float m2 = -INFINITY;
#pragma unroll
            for (int e = 0; e < 4; ++e) if (e != i1 && le[e] > m2) { m2 = le[e]; i2 = e; }
            const float p2 = __expf(m2 - m1); w1 = gtop / (1.f + p2); w2 = gtop * p2 / (1.f + p2);
            e1 = gi * 4 + i1; e2 = gi * 4 + i2;
            r1 = __hip_atomic_fetch_add(lcnt + e1, 1u, __ATOMIC_RELAXED, __HIP_MEMORY_SCOPE_WORKGROUP); r2 = __hip_atomic_fetch_add(lcnt + e2, 1u, __ATOMIC_RELAXED, __HIP_MEMORY_SCOPE_WORKGROUP);
        }
        __syncthreads();
        if (tid < 16) lbase[tid] = __hip_atomic_fetch_add(cnt + CNT_STRIDE * tid, lcnt[tid], __ATOMIC_RELAXED, __HIP_MEMORY_SCOPE_AGENT);
        __syncthreads();
        if (tid < 64 && rep == 0) { const int m = row0 + tid; const int p1 = (int)(lbase[e1] + r1), q2 = (int)(lbase[e2] + r2);
            list[(size_t)e1 * T_ + p1] = m; listw[(size_t)e1 * T_ + p1] = w1; list[(size_t)e2 * T_ + q2] = m; listw[(size_t)e2 * T_ + q2] = w2;
            toke[2 * m] = e1; toke[2 * m + 1] = e2; tokp[2 * m] = p1; tokp[2 * m + 1] = q2; }
        xn_tile(X, gn, ws, row0, rstd_l, wave, lane);
        __syncthreads();
    }
}

template <bool NORM>
__device__ __forceinline__ void phase_combine(float* X, const float* gn, unsigned char* ws, unsigned* cnt, int G, int vcu, int rep) {
    int tid_ = threadIdx.x; asm volatile("" : "+v"(tid_)); const int tid = tid_, lane = tid & 63, wave = __builtin_amdgcn_readfirstlane(tid >> 6);
    const int gw = vcu * NWAVES + wave, NGW = G * NWAVES;
    int sb[NEXP]; { int pre = 0;
#pragma unroll
        for (int e = 0; e < NEXP; ++e) { sb[e] = pre * 256; pre += ((int)__builtin_amdgcn_readfirstlane(__hip_atomic_load(cnt + CNT_STRIDE * e, __ATOMIC_RELAXED, __HIP_MEMORY_SCOPE_AGENT)) + 255) >> 8; } }
    const int* toke = (const int*)(ws + WS_TOKE); const int* tokp = (const int*)(ws + WS_TOKP); const bf16* Y = (const bf16*)(ws + WS_Y);
    const GAS unsigned long long* te8 = (const GAS unsigned long long*)toke; const GAS unsigned long long* tp8 = (const GAS unsigned long long*)tokp;
    for (int m0 = gw; m0 < T_; m0 += 2 * NGW) {
        unsigned long long ee[2], pp[2]; int mm[2]; bool ok[2];
#pragma unroll
        for (int r = 0; r < 2; ++r) { mm[r] = m0 + r * NGW; ok[r] = mm[r] < T_; if (!ok[r]) mm[r] = m0; ee[r] = te8[mm[r]]; pp[r] = tp8[mm[r]]; }
        f32x4 v[2][4]; unsigned long long ya[2][4], yb[2][4];
#pragma unroll
        for (int r = 0; r < 2; ++r) { const int e1 = (int)(ee[r] & 0xffffffffu), e2 = (int)(ee[r] >> 32), p1 = (int)(pp[r] & 0xffffffffu), p2 = (int)(pp[r] >> 32); int s1 = 0, s2 = 0;
#pragma unroll
            for (int e = 0; e < NEXP; ++e) { s1 = (e == e1) ? sb[e] + p1 : s1; s2 = (e == e2) ? sb[e] + p2 : s2; }
            const GAS f32x4* xr = (const GAS f32x4*)(X + (size_t)mm[r] * DM_) + lane;
            const GAS unsigned long long* y1 = (const GAS unsigned long long*)(Y + (size_t)s1 * 1024) + lane; const GAS unsigned long long* y2 = (const GAS unsigned long long*)(Y + (size_t)s2 * 1024) + lane;
#pragma unroll
            for (int j = 0; j < 4; ++j) { v[r][j] = xr[64 * j]; ya[r][j] = y1[64 * j]; yb[r][j] = y2[64 * j]; } }
#pragma unroll
        for (int r = 0; r < 2; ++r) { if (!ok[r]) continue;
            GAS f32x4* xw = (GAS f32x4*)(X + (size_t)mm[r] * DM_) + lane; float ss = 0.f;
#pragma unroll
            for (int j = 0; j < 4; ++j) { const unsigned long long a = ya[r][j], b = yb[r][j]; f32x4 t = v[r][j];
                t.x += bf2f((unsigned short)(a & 0xffff)) + bf2f((unsigned short)(b & 0xffff)); t.y += bf2f((unsigned short)((a >> 16) & 0xffff)) + bf2f((unsigned short)((b >> 16) & 0xffff));
                t.z += bf2f((unsigned short)((a >> 32) & 0xffff)) + bf2f((unsigned short)((b >> 32) & 0xffff)); t.w += bf2f((unsigned short)(a >> 48)) + bf2f((unsigned short)(b >> 48));
                if (rep == 0) xw[64 * j] = t; v[r][j] = t; ss += (t.x * t.x + t.y * t.y) + (t.z * t.z + t.w * t.w); }
            if (NORM && rep == 0) {
                const float rstd = __builtin_amdgcn_rsqf(wave_sum(ss) * (1.f / DM_) + EPS_);
                GAS unsigned long long* o8 = (GAS unsigned long long*)(ws + WS_XN + (size_t)mm[r] * DM_ * 2) + lane;
#pragma unroll
                for (int j = 0; j < 4; ++j) { const f32x4 g4 = *((const GAS f32x4*)gn + 64 * j + lane); const f32x4 t = v[r][j];
                    o8[64 * j] = (unsigned long long)pk2(t.x * rstd * g4.x, t.y * rstd * g4.y) | ((unsigned long long)pk2(t.z * rstd * g4.z, t.w * rstd * g4.w) << 32); }
            }
        }
    }
}

__device__ __forceinline__ void unpack8(const v4u q, float (&f)[8]) { f[0] = bf2f((unsigned short)(q.x & 0xffff)); f[1] = bf2f((unsigned short)(q.x >> 16)); f[2] = bf2f((unsigned short)(q.y & 0xffff)); f[3] = bf2f((unsigned short)(q.y >> 16));
    f[4] = bf2f((unsigned short)(q.z & 0xffff)); f[5] = bf2f((unsigned short)(q.z >> 16)); f[6] = bf2f((unsigned short)(q.w & 0xffff)); f[7] = bf2f((unsigned short)(q.w >> 16)); }
__device__ __forceinline__ void phase_mix1(const bf16* H1, const float* conv_w, bf16* MIX, int G, int vcu) {
    int tid_ = threadIdx.x; asm volatile("" : "+v"(tid_)); const int gt = vcu * NTHR + tid_, NGT = G * NTHR;
    for (int idx = gt; idx < (T_ / 16) * 128; idx += NGT) {
        const int cgp = idx & 127, m0 = (idx >> 7) * 16, t0 = m0 & (SEQ_ - 1); const bf16* hr = H1 + (size_t)m0 * 2048;
        if (cgp < 64) { const int ch = cgp * 8; float z1[8], z2[8], w[3][8];
#pragma unroll
            for (int tap = 0; tap < 3; ++tap) { const f32x4 w0 = *(const GAS f32x4*)(conv_w + tap * 512 + ch), w1 = *(const GAS f32x4*)(conv_w + tap * 512 + ch + 4);
                w[tap][0] = w0.x; w[tap][1] = w0.y; w[tap][2] = w0.z; w[tap][3] = w0.w; w[tap][4] = w1.x; w[tap][5] = w1.y; w[tap][6] = w1.z; w[tap][7] = w1.w; }
#pragma unroll
            for (int e = 0; e < 8; ++e) { z1[e] = 0.f; z2[e] = 0.f; }
            if (t0 >= 2) { float a[8], b[8]; unpack8(*(const GAS v4u*)(hr - 2048 + 512 + ch), a); unpack8(*(const GAS v4u*)(hr - 2048 + 1024 + ch), b);
#pragma unroll
                for (int e = 0; e < 8; ++e) z1[e] = a[e] * b[e];
                unpack8(*(const GAS v4u*)(hr - 4096 + 512 + ch), a); unpack8(*(const GAS v4u*)(hr - 4096 + 1024 + ch), b);
#pragma unroll
                for (int e = 0; e < 8; ++e) z2[e] = a[e] * b[e]; }
#pragma unroll 4
            for (int i = 0; i < 16; ++i) { const bf16* r = hr + (size_t)i * 2048; float bgv[8], cgv[8], hcv[8], o[8];
                unpack8(*(const GAS v4u*)(r + ch), bgv); unpack8(*(const GAS v4u*)(r + 512 + ch), cgv); unpack8(*(const GAS v4u*)(r + 1024 + ch), hcv);
#pragma unroll
                for (int e = 0; e < 8; ++e) { const float z0 = cgv[e] * hcv[e]; o[e] = bgv[e] * (w[0][e] * z2[e] + w[1][e] * z1[e] + w[2][e] * z0); z2[e] = z1[e]; z1[e] = z0; }
                v4u q; q.x = pk2(o[0], o[1]); q.y = pk2(o[2], o[3]); q.z = pk2(o[4], o[5]); q.w = pk2(o[6], o[7]);
                *(GAS v4u*)(MIX + (size_t)(m0 + i) * 1024 + ch) = q; }
        } else { const int pc = (cgp - 64) * 8, gi = pc >> 7, win = 2 << gi; float s[8];
#pragma unroll
            for (int e = 0; e < 8; ++e) s[e] = 0.f;
            const int nb = (t0 < win - 1) ? t0 : win - 1;
            for (int d = 1; d <= nb; ++d) { float pv[8]; unpack8(*(const GAS v4u*)(hr - (size_t)d * 2048 + 1536 + pc), pv);
#pragma unroll
                for (int e = 0; e < 8; ++e) s[e] += pv[e]; }
#pragma unroll 4
            for (int i = 0; i < 16; ++i) { const int t = t0 + i; const bf16* r = hr + (size_t)i * 2048; float cur[8], o[8];
                unpack8(*(const GAS v4u*)(r + 1536 + pc), cur);
                const int n = (t + 1 < win) ? t + 1 : win; const float inv = 1.f / (float)n;
#pragma unroll
                for (int e = 0; e < 8; ++e) { s[e] += cur[e]; o[e] = s[e] * inv - cur[e]; }
                if (t + 1 >= win) { float old[8]; unpack8(*(const GAS v4u*)(r - (size_t)(win - 1) * 2048 + 1536 + pc), old);
#pragma unroll
                    for (int e = 0; e < 8; ++e) s[e] -= old[e]; }
                v4u q; q.x = pk2(o[0], o[1]); q.y = pk2(o[2], o[3]); q.z = pk2(o[4], o[5]); q.w = pk2(o[6], o[7]);
                *(GAS v4u*)(MIX + (size_t)(m0 + i) * 1024 + 512 + pc) = q; }
        }
    }
}
struct Args { const float* in[24]; float* out; unsigned char* ws; int ph_lo, ph_hi, rep, pad; };
__global__ void __launch_bounds__(NTHR, 2) hybrid_fwd(Args args) {
    extern __shared__ __attribute__((aligned(16))) unsigned char lds_raw[];
    LAS unsigned char* lds = (LAS unsigned char*)lds_raw;
    volatile LAS unsigned* MISC = (volatile LAS unsigned*)(lds + MISC_OFF);
    const int tid = threadIdx.x;
    const int G = gridDim.x; const int bx = blockIdx.x; const int vcu = (G % 8 == 0) ? (bx % 8) * (G / 8) + bx / 8 : bx;
    struct KIn { __device__ __forceinline__ const float* operator[](int k) const { const volatile __attribute__((address_space(4))) unsigned long long* ka = (const volatile __attribute__((address_space(4))) unsigned long long*)__builtin_amdgcn_kernarg_segment_ptr(); return (const float*)(const GAS float*)ka[k]; } };
    const KIn in;
#define out ((float*)in[24])
#define ws ((unsigned char*)in[25])
#define XN ((bf16*)(ws + WS_XN))
#define MIX ((bf16*)(ws + WS_MIX))
#define HID ((bf16*)(ws + WS_HID))
#define Y ((bf16*)(ws + WS_Y))
#define F2 ((float*)(ws + WS_F2))
#define ctl ((gu32*)(ws + WS_CTL))
    for (int u = tid; u < (LDS_BYTES - LDSCTL_OFF) / 4; u += NTHR) ((LAS unsigned*)(lds + LDSCTL_OFF))[u] = 0u;
    __syncthreads();
#if MK_USE_CG
    cooperative_groups::grid_group grid = cooperative_groups::this_grid();
#define GRID_BAR() grid.sync()
#else
    XcdBarrier bar; bar.bar = (unsigned*)(ctl + CW_BAR); bar.x = 0; bar.st = nullptr;
    if (MK_N_LAUNCHES == 1) bar = xcd_barrier_post((unsigned*)(ctl + CW_BAR), MISC + 8);
#define GRID_BAR() xcd_barrier(bar)
#endif
    const int lo = args.ph_lo, hi = args.ph_hi;
#ifndef PH_MASK
#define PH_MASK 0x7fff
#endif
#define IN(k) (((PH_MASK >> (k)) & 1) && lo <= (k) && (k) < hi)
#define SEAM(k) do { if (IN(k) && IN((k) + 1)) GRID_BAR(); } while (0)

    if (IN(0)) { p0_prologue(in, ws, lds, G, vcu); }
    SEAM(0);
    if (IN(1)) {
        if (bx >= G - NBH && G > NBH && args.rep == 0) { scan_seq(F2 + (size_t)(bx - (G - NBH)) * SEQ_, (LAS float*)(lds + MISC_OFF + 64)); }
        pg8::ProbPlain S; S.init(XN, ws + WS_WIN0, T_, EV_N, 1024, G, bx);
        EpiInproj0 E{(bf16*)(ws + WS_U), (bf16*)(ws + WS_V), (bf16*)(ws + WS_Q), (bf16*)(ws + WS_K), (bf16*)(ws + WS_VAL), in[6], in[7], in[8]};
        pg8::gemm_phase<EpiInproj0, pg8::ProbPlain, true>(lds, S, E);
    }
    SEAM(1);
    if (IN(2)) {
#if MK_NAIVE_ATTN
        naive_attn((const bf16*)(ws + WS_Q), (const bf16*)(ws + WS_K), (const bf16*)(ws + WS_VAL), F2, MIX, vcu * NTHR + tid, G * NTHR);
        for (int u = bx; u < 512; u += G) gmlp_unit(u, (const bf16*)(ws + WS_U), (const bf16*)(ws + WS_V), (const bf16*)(ws + WS_WST), in[5], MIX, lds);
#else
        float skipthr; { const float gq = fabsf(in[7][tid & 63]), gk = fabsf(in[8][tid & 63]); float mq = gq, mk = gk;
#pragma unroll
            for (int o = 1; o < 64; o <<= 1) { mq = fmaxf(mq, __shfl_xor(mq, o)); mk = fmaxf(mk, __shfl_xor(mk, o)); }
            skipthr = 40.f + 2.f * 1.02f * (0.125f * LOG2E * 64.f) * mq * mk; }
        for (;;) {
            if (tid == 0) MISC[0] = __hip_atomic_fetch_add((unsigned*)(ctl + CW_Q + 16 * args.rep), 1u, __ATOMIC_RELAXED, __HIP_MEMORY_SCOPE_AGENT);
            __syncthreads();
            const int u = (int)MISC[0];
            __syncthreads();
            if (u >= 768 + 512) break;
            if (u < 768) { const int qb = 15 - u / NBH, bh = u % NBH;
                attn_body::attn_unit<8>(bh / NHEADS, bh % NHEADS, qb, (const attn_body::bf16*)(ws + WS_Q), (const attn_body::bf16*)(ws + WS_K), (const attn_body::bf16*)(ws + WS_VAL),
                                        (attn_body::bf16*)(ws + WS_MIX) + 256, F2 + (size_t)bh * SEQ_, skipthr, (char*)lds_raw); }
            else gmlp_unit(u - 768, (const bf16*)(ws + WS_U), (const bf16*)(ws + WS_V), (const bf16*)(ws + WS_WST), in[5], MIX, lds);
        }
#endif
    }
    SEAM(2);
    if (IN(3)) {
        pg8::ProbPlain S; S.init(MIX, ws + WS_WOUT0, T_, 1024, 1024, G, bx);
        EpiResF32 E{in[0], out};
        pg8::gemm_phase<EpiResF32, pg8::ProbPlain, false>(lds, S, E);
    }
    SEAM(3);
#define MOE_LAYER(layer, pb, cntw) do { \
        unsigned* cnt = (unsigned*)(ctl + (cntw)); \
          \
        if (IN(pb)) phase_route(in, layer, out, ws, args.rep ? (unsigned*)(ctl + CW_CNTD) : cnt, lds, G, vcu, args.rep); \
        SEAM(pb); \
          \
        if (IN((pb) + 1)) { \
            ProbMoe S{(const char*)XN, (const char*)(ws + WS_WGU) + (size_t)(layer) * NEXP * 512 * 1024 * 2, 1024, 2, G, bx, cnt, (const int*)(ws + WS_LIST), true, (size_t)512 * 1024 * 2}; \
            EpiGateUp E{HID, (const float*)(ws + WS_LISTW)}; \
            pg8::gemm_phase<EpiGateUp, ProbMoe, true>(lds, S, E); } \
        SEAM((pb) + 1); \
          \
        if (IN((pb) + 2)) { \
            ProbMoe S{(const char*)HID, (const char*)(ws + WS_WD) + (size_t)(layer) * NEXP * 1024 * 256 * 2, 256, 4, G, bx, cnt, nullptr, false, (size_t)1024 * 256 * 2}; \
            EpiBf16 E{Y, 1024}; \
            pg8::gemm_phase<EpiBf16, ProbMoe, true>(lds, S, E); } \
        SEAM((pb) + 2); \
          \
        if (IN((pb) + 3)) { if ((layer) == 0) phase_combine<true>(out, in[10], ws, cnt, G, vcu, args.rep); else phase_combine<false>(out, nullptr, ws, cnt, G, vcu, args.rep); } \
    } while (0)
    MOE_LAYER(0, 4, CW_CNT0);
    SEAM(7);
    if (IN(8)) {
        pg8::ProbPlain S; S.init(XN, ws + WS_WIN1, T_, 2048, 1024, G, bx);
        EpiBf16 E{(bf16*)(ws + WS_H1), 2048};
        pg8::gemm_phase<EpiBf16, pg8::ProbPlain, true>(lds, S, E);
    }
    SEAM(8);
    if (IN(9)) phase_mix1((const bf16*)(ws + WS_H1), in[12], MIX, G, vcu);
    SEAM(9);
    if (IN(10)) {
        pg8::ProbPlain S; S.init(MIX, ws + WS_WOUT1, T_, 1024, 1024, G, bx);
        EpiResF32 E{out, out};
        pg8::gemm_phase<EpiResF32, pg8::ProbPlain, false>(lds, S, E);
    }
    SEAM(10);
    MOE_LAYER(1, 11, CW_CNT1);
#undef MOE_LAYER
#undef XN
#undef MIX
#undef HID
#undef Y
#undef F2
#undef ctl
#undef out
#undef ws
#undef IN
#undef SEAM
#undef GRID_BAR
}

extern "C" void kernel_launch(void* const* d_in, const int* in_sizes, int n_in, void* d_out, int out_size, void* d_ws, size_t ws_size, hipStream_t stream) {
    static int grid = 0;
    if (grid == 0) {
        if (n_in != 24 || in_sizes[0] != T_ * DM_ || out_size != T_ * DM_ || ws_size < WS_END) { fprintf(stderr, "kernel_launch: unexpected shapes (n_in %d, in0 %d, out %d, ws %zu); nothing launched\n", n_in, n_in > 0 ? in_sizes[0] : -1, out_size, ws_size); grid = -1; return; }
        int dev = 0, cus = 0, per_cu = 0;
        if (hipGetDevice(&dev) != hipSuccess || hipDeviceGetAttribute(&cus, hipDeviceAttributeMultiprocessorCount, dev) != hipSuccess) { fprintf(stderr, "kernel_launch: device query failed\n"); grid = -1; return; }
        if (hipFuncSetAttribute((const void*)hybrid_fwd, hipFuncAttributeMaxDynamicSharedMemorySize, LDS_BYTES) != hipSuccess) { fprintf(stderr, "kernel_launch: hipFuncSetAttribute failed\n"); grid = -1; return; }
        if (hipOccupancyMaxActiveBlocksPerMultiprocessor(&per_cu, (const void*)hybrid_fwd, NTHR, LDS_BYTES) != hipSuccess || per_cu < 1) { fprintf(stderr, "kernel_launch: occupancy query reports %d workgroups per CU\n", per_cu); per_cu = 1; }
        (void)hipGetLastError();
        grid = cus;
    }
    if (grid < 0) return;
    if (hipMemsetAsync((char*)d_ws + WS_CTL, 0, CTL_ZERO_BYTES, stream) != hipSuccess) { fprintf(stderr, "kernel_launch: memset failed\n"); return; }
    Args a{};
    for (int i = 0; i < 24; ++i) a.in[i] = (const float*)d_in[i];
    a.out = (float*)d_out; a.ws = (unsigned char*)d_ws;
#if MK_N_LAUNCHES == 1
    a.ph_lo = 0; a.ph_hi = NPH;
#if MK_USE_CG
    void* kargs[] = {&a};
    hipError_t e = hipLaunchCooperativeKernel((const void*)hybrid_fwd, dim3(grid), dim3(NTHR), kargs, LDS_BYTES, stream);
    if (e != hipSuccess) fprintf(stderr, "kernel_launch: cooperative launch failed: %s (grid %d)\n", hipGetErrorString(e), grid);
#else
    hipLaunchKernelGGL(hybrid_fwd, dim3(grid), dim3(NTHR), LDS_BYTES, stream, a);
#endif
#else
    for (int p = 0; p < NPH; ++p) { a.ph_lo = p; a.ph_hi = p + 1; a.rep = 0; hipLaunchKernelGGL(hybrid_fwd, dim3(grid), dim3(NTHR), LDS_BYTES, stream, a);
        if ((MK_REPEAT_MASK >> p) & 1) { a.rep = MK_REP_MODE; hipLaunchKernelGGL(hybrid_fwd, dim3(grid), dim3(NTHR), LDS_BYTES, stream, a); } }
#endif
}
```

```cpp
#include <hip/hip_runtime.h>
#include <hip/hip_cooperative_groups.h>
#include <hip/hip_bf16.h>
#include <cstdio>
#include <cstdint>
#include <cmath>

#ifndef MK_N_LAUNCHES
#define MK_N_LAUNCHES 1
#endif
#ifndef MK_USE_CG
#define MK_USE_CG 0
#endif
#ifndef MK_NAIVE_ATTN
#define MK_NAIVE_ATTN 0
#endif
#ifndef MK_REPEAT_MASK
#define MK_REPEAT_MASK 0
#endif
#ifndef MK_REP_MODE
#define MK_REP_MODE 1
#endif
namespace pg8 {
#define PG8_LAS __attribute__((address_space(3)))
typedef unsigned short bf16_t;
typedef short bf16x8 __attribute__((ext_vector_type(8)));
typedef float f32x4 __attribute__((ext_vector_type(4)));
typedef unsigned u32x4 __attribute__((ext_vector_type(4)));
constexpr int BM = 256, BK = 64, HALF = 128, HTB = HALF * BK * 2  , STAGE_BYTES = 8 * HTB, NXCD = 8, WGM = 8;

__host__ __device__ __forceinline__ int lds_byte(int r, int c) { const int st = (r >> 4) * 2 + (c >> 5), rr = r & 15, cc = c & 31, ob = rr * 64 + cc * 2; return st * 1024 + (ob ^ (((ob >> 9) & 1) << 5)); }
__host__ __device__ __forceinline__ void stage_rc(int b, int& R, int& C) { const int st = b / 1024, sb = b % 1024, swz = sb ^ (((sb >> 9) & 1) << 5); R = (st >> 1) * 16 + swz / 64; C = (st & 1) * 32 + (swz % 64) / 2; }
__host__ __device__ __forceinline__ int perm32(int rho) { const int n = rho >> 4, i = rho & 15; return 8 * (i >> 2) + 4 * n + (i & 3); }

struct Unit { int pm, pn, e, j, cnt; };

__device__ __forceinline__ unsigned cvt_pk_bf16(float lo, float hi) { unsigned r; asm volatile("v_cvt_pk_bf16_f32 %0, %1, %2" : "=v"(r) : "v"(lo), "v"(hi)); return r; }

struct ProbPlain {
    const char* A; const char* Bt; int K, nM, nN, nwg, G, c;
    __device__ __forceinline__ void init(const void* A_, const void* Bt_, int M, int N, int K_, int G_, int c_) { A = (const char*)A_; Bt = (const char*)Bt_; K = K_; nM = M / BM; nN = N / BM; nwg = nM * nN; G = G_; c = c_; }
    __device__ __forceinline__ bool next(int i, Unit& u) const {
        const long L = (long)i * G + c; if (L >= nwg) return false;
        int wgid = (int)L; { const int q = nwg / NXCD, r = nwg % NXCD, xcd = wgid % NXCD, off = wgid / NXCD; wgid = (xcd < r ? xcd * (q + 1) : r * (q + 1) + (xcd - r) * q) + off; }
        const int nig = WGM * nN, gid = wgid / nig, fm = gid * WGM, gsz = (nM - fm) < WGM ? (nM - fm) : WGM;
        u.pm = fm + ((wgid % nig) % gsz); u.pn = (wgid % nig) / gsz; u.e = 0; u.j = 0; u.cnt = 0; return true;
    }
    __device__ __forceinline__ unsigned a_off(const Unit& u, int row) const { return (unsigned)(u.pm * BM + row) * (unsigned)(K * 2); }
    __device__ __forceinline__ const char* b_base(const Unit& u) const { return Bt + (size_t)u.pn * BM * K * 2; }
};

template <class Epi, class Prob, bool ALIGN_EPI>
__device__ __forceinline__ void gemm_phase(PG8_LAS unsigned char* lds, const Prob& S, const Epi& E) {
    int tid_ = threadIdx.x; asm volatile("" : "+v"(tid_)); const int tid = tid_, wid = __builtin_amdgcn_readfirstlane(tid >> 6), lane = tid & 63, wr = wid >> 2, wc = wid & 3, fr = lane & 15, fq = lane >> 4;
    const int K = S.K, nt = K / BK;
    int Rr[2], Cb[2]; unsigned voffB[2];
#pragma unroll
    for (int i = 0; i < 2; ++i) { int R, C; stage_rc(tid * 16 + i * 8192, R, C); const int Rb = Epi::PERM ? ((R & ~31) + perm32(R & 31)) : R;
        Rr[i] = R; Cb[i] = C * 2; voffB[i] = (unsigned)(Rb * K + C) * 2u; }
    const size_t kstep = (size_t)(BK * 2);
    const size_t hstep = (size_t)HALF * K * 2;
    const unsigned ldsw = (unsigned)wid * 1024u;
    const int aoff = lds_byte(wr * 64 + fr, fq * 8), boff = lds_byte(wc * 32 + fr, fq * 8);
#define PG8_SA(b, h) (((b) * 2 + (h)) * HTB)
#define PG8_SB(b, h) ((4 + (b) * 2 + (h)) * HTB)
#define PG8_STAGE(bufoff, gbase, voff) do { _Pragma("unroll") for (int _i = 0; _i < 2; ++_i) \
        __builtin_amdgcn_global_load_lds((const unsigned*)((const char*)(gbase) + (voff)[_i]), (PG8_LAS unsigned*)(lds + (bufoff) + ldsw + _i * 8192), 16, 0, 0); } while (0)
#define PG8_LDA(dst, b, h) do { _Pragma("unroll") for (int m = 0; m < 4; ++m) _Pragma("unroll") for (int k = 0; k < 2; ++k) dst[m][k] = *(const PG8_LAS bf16x8*)(lds + PG8_SA(b, h) + aoff + m * 2048 + k * 1024); } while (0)
#define PG8_LDB(dst, b, h) do { _Pragma("unroll") for (int n = 0; n < 2; ++n) _Pragma("unroll") for (int k = 0; k < 2; ++k) dst[n][k] = *(const PG8_LAS bf16x8*)(lds + PG8_SB(b, h) + boff + n * 2048 + k * 1024); } while (0)
#define PG8_MMA(ai, bj, At, Bt) do { __builtin_amdgcn_s_setprio(1); _Pragma("unroll") for (int m = 0; m < 4; ++m) _Pragma("unroll") for (int n = 0; n < 2; ++n) _Pragma("unroll") for (int k = 0; k < 2; ++k) \
        acc[ai][bj][m][n] = __builtin_amdgcn_mfma_f32_16x16x32_bf16(Bt[n][k], At[m][k], acc[ai][bj][m][n], 0, 0, 0); __builtin_amdgcn_s_setprio(0); } while (0)
#define PG8_WAIT_V(n) asm volatile("s_waitcnt vmcnt(" #n ")" ::: "memory")
#define PG8_WAIT_L(n) asm volatile("s_waitcnt lgkmcnt(" #n ")" ::: "memory")
#define PG8_BAR __builtin_amdgcn_s_barrier()
#define PG8_SCHED __builtin_amdgcn_sched_barrier(0)
    Unit cur, nxt; int ui = 0;
    if (!S.next(0, cur)) return;
    f32x4 acc[2][2][4][2];
#pragma unroll
    for (int a = 0; a < 2; ++a)
#pragma unroll
        for (int b = 0; b < 2; ++b)
#pragma unroll
            for (int m = 0; m < 4; ++m)
#pragma unroll
                for (int n = 0; n < 2; ++n) acc[a][b][m][n] = (f32x4){0.f, 0.f, 0.f, 0.f};
    bf16x8 At[4][2], B0[2][2], B1[2][2];
    const char* const Ab = S.A;
    unsigned cA0[2], cA1[2], nA0[2], nA1[2];
#pragma unroll
    for (int i = 0; i < 2; ++i) { cA0[i] = S.a_off(cur, Rr[i]) + (unsigned)Cb[i]; cA1[i] = S.a_off(cur, Rr[i] + HALF) + (unsigned)Cb[i]; }
    const char* cB = S.b_base(cur);
    PG8_STAGE(PG8_SB(0, 0), cB, voffB); PG8_STAGE(PG8_SB(0, 1), cB + hstep, voffB); PG8_STAGE(PG8_SA(0, 0), Ab, cA0); PG8_STAGE(PG8_SA(0, 1), Ab, cA1);
    if (wr == 1) PG8_BAR;
    PG8_WAIT_V(2); PG8_BAR;
    PG8_STAGE(PG8_SB(1, 0), cB + kstep, voffB); PG8_STAGE(PG8_SA(1, 0), Ab + kstep, cA0); PG8_STAGE(PG8_SB(1, 1), cB + hstep + kstep, voffB);
    PG8_WAIT_V(6); PG8_BAR;
    for (;;) {
        const bool has_next = S.next(ui + 1, nxt);
        const char* nB = cB;
#pragma unroll
        for (int i = 0; i < 2; ++i) { nA0[i] = cA0[i]; nA1[i] = cA1[i]; }
        if (has_next) { nB = S.b_base(nxt);
#pragma unroll
            for (int i = 0; i < 2; ++i) { nA0[i] = S.a_off(nxt, Rr[i]) + (unsigned)Cb[i]; nA1[i] = S.a_off(nxt, Rr[i] + HALF) + (unsigned)Cb[i]; } }
        for (int t = 0; t < nt; t += 2) {
            const bool last = (t == nt - 2);
            const char* a1 = Ab + (size_t)(t + 1) * kstep;
            const char* a2 = last ? Ab : Ab + (size_t)(t + 2) * kstep; const char* b2 = last ? nB : cB + (size_t)(t + 2) * kstep;
            const char* a3 = a2 + kstep; const char* b3 = b2 + kstep;
            unsigned x0[2], x1[2];
#pragma unroll
            for (int i = 0; i < 2; ++i) { x0[i] = last ? nA0[i] : cA0[i]; x1[i] = last ? nA1[i] : cA1[i]; }
            PG8_LDB(B0, 0, 0); PG8_LDB(B1, 0, 1); PG8_SCHED; PG8_LDA(At, 0, 0); PG8_STAGE(PG8_SA(1, 1), a1, cA1);
            PG8_WAIT_V(8); PG8_WAIT_L(0); PG8_BAR; PG8_MMA(0, 0, At, B0); PG8_MMA(0, 1, At, B1); PG8_BAR; PG8_SCHED;
            PG8_LDA(At, 0, 1); PG8_STAGE(PG8_SB(0, 0), b2, voffB); PG8_STAGE(PG8_SB(0, 1), b2 + hstep, voffB); PG8_STAGE(PG8_SA(0, 0), a2, x0);
            PG8_WAIT_V(8); PG8_WAIT_L(0); PG8_BAR; PG8_MMA(1, 0, At, B0); PG8_MMA(1, 1, At, B1); PG8_BAR; PG8_SCHED;
            PG8_LDB(B0, 1, 0); PG8_LDB(B1, 1, 1); PG8_SCHED; PG8_LDA(At, 1, 0); PG8_STAGE(PG8_SA(0, 1), a2, x1);
            PG8_WAIT_V(8); PG8_WAIT_L(0); PG8_BAR; PG8_MMA(0, 0, At, B0); PG8_MMA(0, 1, At, B1); PG8_BAR; PG8_SCHED;
            PG8_LDA(At, 1, 1); PG8_STAGE(PG8_SB(1, 0), b3, voffB); PG8_STAGE(PG8_SB(1, 1), b3 + hstep, voffB); PG8_STAGE(PG8_SA(1, 0), a3, x0);
            PG8_WAIT_V(8); PG8_WAIT_L(0); PG8_BAR; PG8_MMA(1, 0, At, B0); PG8_MMA(1, 1, At, B1); PG8_BAR; PG8_SCHED;
        }
        if constexpr (ALIGN_EPI) { if (wr == 0) PG8_BAR; }
        E(acc, cur, wr, wc, fr, fq);
        if (!has_next) break;
#pragma unroll
        for (int a = 0; a < 2; ++a)
#pragma unroll
            for (int b = 0; b < 2; ++b)
#pragma unroll
                for (int m = 0; m < 4; ++m)
#pragma unroll
                    for (int n = 0; n < 2; ++n) acc[a][b][m][n] = (f32x4){0.f, 0.f, 0.f, 0.f};
        cur = nxt; cB = nB; ++ui;
#pragma unroll
        for (int i = 0; i < 2; ++i) { cA0[i] = nA0[i]; cA1[i] = nA1[i]; }
        if constexpr (ALIGN_EPI) { if (wr == 1) PG8_BAR; }
    }
    PG8_WAIT_V(0);
    if constexpr (!ALIGN_EPI) { if (wr == 0) PG8_BAR; }
    PG8_BAR;
#undef PG8_SA
#undef PG8_SB
#undef PG8_STAGE
#undef PG8_LDA
#undef PG8_LDB
#undef PG8_MMA
#undef PG8_WAIT_V
#undef PG8_WAIT_L
#undef PG8_BAR
#undef PG8_SCHED
}
}
namespace attn_body {
using bf16=__hip_bfloat16;
using bf16x8=__attribute__((ext_vector_type(8)))short;
using s16x4=__attribute__((ext_vector_type(4)))short;
using f32x16=__attribute__((ext_vector_type(16)))float;
using u32x4=__attribute__((ext_vector_type(4)))unsigned;
using f32x4v=__attribute__((ext_vector_type(4)))float;
constexpr int BATCH=4,NHEAD=12,SEQ=4096,D=64;
constexpr int QP=768,KP=768,VP=768,OP=1024;
constexpr int NW=8,QBLK=32,QB=QBLK*NW,KVBLK=64,NQB=SEQ/QB;
constexpr int ATTN_UNIT_ROWS=QB;
__device__ __forceinline__ int crow(int r,int hi){return (r&3)+8*(r>>2)+4*hi;}
#define SBAR() __builtin_amdgcn_sched_barrier(0)
__device__ __forceinline__ void cmask(f32x16&p0,f32x16&p1,int jb,int qrel,int hi){
  const float NEG=-INFINITY; int kb=64*jb+4*hi;
  #pragma unroll
  for(int r=0;r<16;++r){int kv=kb+(r&3)+8*(r>>2); if(kv>qrel)p0[r]=NEG; if(kv+32>qrel)p1[r]=NEG;}
}

constexpr int NSLOT=3, SLOTB=8192;
constexpr int LDS_K=0, LDS_V=NSLOT*SLOTB, LDS_WS=2*NSLOT*SLOTB, LDS_OST=LDS_WS+NW*64*4, LDS_BYTES=LDS_OST+NW*4096, LDS_F=86016, LDS_F_BYTES=16384;
constexpr float C2=0.125f*1.4426950408889634f;
__device__ __forceinline__ void glds16(const void*gsrc,unsigned lds_dst){unsigned keep;
  asm volatile("s_mov_b32 %0, m0\n\ts_mov_b32 m0, %2\n\ts_nop 0\n\tglobal_load_lds_dwordx4 %1, off\n\ts_mov_b32 m0, %0":"=&s"(keep):"v"(gsrc),"s"(lds_dst):"memory");}
__device__ __forceinline__ float max3f(float a,float b,float c){float r;asm("v_max3_f32 %0, %1, %2, %3":"=v"(r):"v"(a),"v"(b),"v"(c));return r;}
__device__ __forceinline__ float max2f(float a,float b){float r;asm("v_max_f32_e32 %0, %1, %2":"=v"(r):"v"(a),"v"(b));return r;}
__device__ __forceinline__ float fadd_s(float a,float b){float r;asm("v_add_f32_e32 %0, %1, %2":"=v"(r):"v"(a),"v"(b));return r;}
__device__ __forceinline__ float fsub_s(float a,float b){float r;asm("v_sub_f32_e32 %0, %1, %2":"=v"(r):"v"(a),"v"(b));return r;}
typedef float f32x2_t __attribute__((ext_vector_type(2))); typedef __bf16 bf16x2_t __attribute__((ext_vector_type(2)));
__device__ __forceinline__ unsigned cvtpk_s(float lo,float hi){f32x2_t v={lo,hi};bf16x2_t b=__builtin_convertvector(v,bf16x2_t);return __builtin_bit_cast(unsigned,b);}
#define WAIT_BAR(N) asm volatile("s_waitcnt vmcnt(" #N ") lgkmcnt(0)\n\ts_barrier":::"memory")

__device__ __forceinline__ void qkt(f32x16&p0,f32x16&p1,const char*Kslot,const bf16x8*qr,int r32,int hi){
  const char*kb=Kslot+hi*1024+r32*16;
  #pragma unroll
  for(int d0=0;d0<4;++d0){
    const bf16x8 b0=*reinterpret_cast<const bf16x8*>(kb+d0*2048);
    const bf16x8 b1=*reinterpret_cast<const bf16x8*>(kb+d0*2048+512);
    p0=__builtin_amdgcn_mfma_f32_32x32x16_bf16(b0,qr[d0],p0,0,0,0);p1=__builtin_amdgcn_mfma_f32_32x32x16_bf16(b1,qr[d0],p1,0,0,0);}
}
typedef __attribute__((address_space(3))) const char* lds_cptr;
typedef short v4i16_t __attribute__((ext_vector_type(4)));
__device__ __forceinline__ void kload8(bf16x8*kf,lds_cptr kp){
  kf[0]=*(const __attribute__((address_space(3))) bf16x8*)(kp);      kf[1]=*(const __attribute__((address_space(3))) bf16x8*)(kp+512);
  kf[2]=*(const __attribute__((address_space(3))) bf16x8*)(kp+2048); kf[3]=*(const __attribute__((address_space(3))) bf16x8*)(kp+2560);
  kf[4]=*(const __attribute__((address_space(3))) bf16x8*)(kp+4096); kf[5]=*(const __attribute__((address_space(3))) bf16x8*)(kp+4608);
  kf[6]=*(const __attribute__((address_space(3))) bf16x8*)(kp+6144); kf[7]=*(const __attribute__((address_space(3))) bf16x8*)(kp+6656);
}
__device__ __forceinline__ void kload2(bf16x8*kf,lds_cptr kp,int j){ kf[2*j]=*(const __attribute__((address_space(3))) bf16x8*)(kp+j*2048); kf[2*j+1]=*(const __attribute__((address_space(3))) bf16x8*)(kp+j*2048+512); }
__device__ __forceinline__ s16x4 vtr(lds_cptr p){ return __builtin_bit_cast(s16x4,__builtin_amdgcn_ds_read_tr16_b64_v4i16((__attribute__((address_space(3))) v4i16_t*)p)); }
__device__ __forceinline__ float rowmax(const f32x16&p0,const f32x16&p1){
  float a=max3f(p0[0],p0[1],p1[0]),b=max3f(p0[2],p0[3],p1[1]);a=max3f(a,p1[2],p1[3]);
  #pragma unroll
  for(int r=4;r<16;r+=4){a=max3f(a,p0[r],p0[r+1]);b=max3f(b,p0[r+2],p0[r+3]);a=max3f(a,p1[r],p1[r+1]);b=max3f(b,p1[r+2],p1[r+3]);}
  const float m=max2f(a,b);
  auto rr=__builtin_amdgcn_permlane32_swap(__float_as_uint(m),__float_as_uint(m),false,false);
  return max2f(__uint_as_float(rr[0]),__uint_as_float(rr[1]));
}
__device__ __forceinline__ void pv(f32x16*o,int vb,bf16x8 pa0,bf16x8 pa1,bf16x8 pa2,bf16x8 pa3){
  #pragma unroll
  for(int d0=0;d0<2;++d0){s16x4 lo[4],hi[4];
    #pragma unroll
    for(int ks=0;ks<4;++ks){
      asm volatile("ds_read_b64_tr_b16 %0,%1 offset:%c2":"=&v"(lo[ks]):"v"(vb),"i"(d0*4096+ks*1024):"memory");
      asm volatile("ds_read_b64_tr_b16 %0,%1 offset:%c2":"=&v"(hi[ks]):"v"(vb),"i"(d0*4096+ks*1024+512):"memory");}
    asm volatile("s_waitcnt lgkmcnt(0)":::"memory");SBAR();
    #define PK(k) (bf16x8){lo[k][0],lo[k][1],lo[k][2],lo[k][3],hi[k][0],hi[k][1],hi[k][2],hi[k][3]}
    o[d0]=__builtin_amdgcn_mfma_f32_32x32x16_bf16(pa0,PK(0),o[d0],0,0,0);
    o[d0]=__builtin_amdgcn_mfma_f32_32x32x16_bf16(pa1,PK(1),o[d0],0,0,0);
    o[d0]=__builtin_amdgcn_mfma_f32_32x32x16_bf16(pa2,PK(2),o[d0],0,0,0);
    o[d0]=__builtin_amdgcn_mfma_f32_32x32x16_bf16(pa3,PK(3),o[d0],0,0,0);
    #undef PK
  }
}

#ifndef ATTN_STORE16
#define ATTN_STORE16(p,v) (*(u32x4*)(p)=(v))
#endif
template<int THRL> __device__ __forceinline__ void attn_unit(int b,int h,int qb,const bf16*Q,const bf16*__restrict__ K,const bf16*__restrict__ V,bf16*O,const float*F2seq,float skipthr,float bmax,char*shm){
  int tid_ = threadIdx.x; asm volatile("" : "+v"(tid_)); const int tid = tid_,lane=tid&63,r32=lane&31,hi=lane>>5; const int wid=__builtin_amdgcn_readfirstlane(tid>>6);
  const long rowbase=(long)b*SEQ; const int q0=qb*QB;
  int ts=0; { const int nb=q0>>6; bool c_=false; if(lane<nb) c_=(F2seq[q0]-F2seq[64*(lane+1)-1])<-skipthr; ts=__builtin_amdgcn_readfirstlane((int)__popcll(__ballot(c_))&~1); }
  typedef __attribute__((address_space(3))) float* lds_fptr; typedef __attribute__((address_space(3))) f32x4v* lds_f4ptr;
  const lds_fptr Fl=(lds_fptr)(shm+LDS_F);
  { const f32x4v*Fg=(const f32x4v*)(F2seq+64*ts); const int nF=(q0+QB-64*ts)>>2; for(int i=tid;i<nF;i+=NW*64)((lds_f4ptr)Fl)[i]=Fg[i]; }
  const float fq2=F2seq[q0+wid*QBLK+r32];
  const bf16*Qw=Q+(rowbase+q0+wid*QBLK)*QP+h*D;
  const bf16*Kh=K+(rowbase+64*ts)*KP+h*D,*Vh=V+(rowbase+64*ts)*VP+h*D;
  const unsigned lds0=(unsigned)(uintptr_t)shm;
  float*wsf=(float*)(shm+LDS_WS)+wid*64;
  const bf16*ksrc=Kh+(long)lane*KP+wid*8;
  const bf16*vsrc=Vh+(long)(16*(wid&3)+(lane>>2))*VP+(wid>>2)*32+(lane&3)*8;
  const unsigned kdst=lds0+LDS_K+wid*1024, vdst=lds0+LDS_V+wid*1024;
  #define DMA_K(t,slot) glds16(ksrc+(long)(t)*KVBLK*KP,(unsigned)__builtin_amdgcn_readfirstlane(kdst+(slot)))
  #define DMA_V(t,slot) glds16(vsrc+(long)(t)*KVBLK*VP,(unsigned)__builtin_amdgcn_readfirstlane(vdst+(slot)))
  const int vb0=(int)(lds0+LDS_V)+((lane>>4)&1)*32+(lane&3)*8+(4*hi+((lane&15)>>2))*64;
  const char*Kbase=shm+LDS_K; bf16x8 kf[8];
  const lds_cptr shm3=(lds_cptr)shm; const lds_cptr kp0=shm3+LDS_K+hi*1024+r32*16; const lds_cptr vp0=shm3+LDS_V+((lane>>4)&1)*32+(lane&3)*8+(4*hi+((lane&15)>>2))*64;
  const int NT=(q0+QB)/KVBLK-ts;
  DMA_K(0,0);DMA_V(0,0);DMA_K(1,SLOTB);
  bf16x8 qr[4];
  #pragma unroll
  for(int d0=0;d0<4;++d0)qr[d0]=*reinterpret_cast<const bf16x8*>(&Qw[(long)r32*QP+d0*16+hi*8]);
  float mhat=bmax,l_reg=0.f;
  f32x16 o[2];o[0]=f32x16{};o[1]=f32x16{};
  #define BIAS(C0,C1,t) do{ const float nb_=fq2-mhat; const lds_fptr fk_=Fl+64*(t)+4*hi; \
    _Pragma("unroll") for(int j_=0;j_<4;++j_){ const f32x4v a_=*(const lds_f4ptr)(fk_+8*j_); const f32x4v c_=*(const lds_f4ptr)(fk_+32+8*j_); \
      C0[4*j_]=nb_-a_.x; C0[4*j_+1]=nb_-a_.y; C0[4*j_+2]=nb_-a_.z; C0[4*j_+3]=nb_-a_.w; C1[4*j_]=nb_-c_.x; C1[4*j_+1]=nb_-c_.y; C1[4*j_+2]=nb_-c_.z; C1[4*j_+3]=nb_-c_.w; } }while(0)
  const int qrel=wid*QBLK+r32;
  #define CMASK(P0,P1,t) do{int jb_=(t)-(NT-4); if(jb_>=0)cmask(P0,P1,jb_,qrel,hi);}while(0)
  bool resc=false;
  #define START(P0,P1) do{ const float rm=rowmax(P0,P1); resc=false; \
    { const float dl=max2f(rm,0.f); mhat=fadd_s(mhat,dl); \
      _Pragma("unroll") for(int r=0;r<16;++r){P0[r]=fsub_s(P0[r],dl);P1[r]=fsub_s(P1[r],dl);} } \
    _Pragma("unroll") for(int r=0;r<16;++r)P0[r]=__builtin_amdgcn_exp2f(P0[r]); }while(0)
  #define RESC() do{ if(resc){ asm volatile("s_waitcnt lgkmcnt(0)":::"memory"); \
      _Pragma("unroll") for(int d_=0;d_<2;++d_) _Pragma("unroll") for(int r=0;r<16;++r)o[d_][r]*=wsf[crow(r,hi)]; } }while(0)
  f32x16 pA0,pA1,pB0,pB1;
  int sl_prev=0,sl_cur=0,sl_next=SLOTB;
  #define ROT() do{sl_prev=sl_cur;sl_cur=sl_next;sl_next=(sl_next==(NSLOT-1)*SLOTB)?0:sl_next+SLOTB;}while(0)
  DMA_K(2,2*SLOTB);
  WAIT_BAR(3);
  BIAS(pA0,pA1,0); qkt(pA0,pA1,Kbase,qr,r32,hi);asm volatile("s_nop 15\n\ts_nop 7":"+v"(pA0),"+v"(pA1));CMASK(pA0,pA1,0);
  START(pA0,pA1);
  _Pragma("unroll") for(int r=0;r<16;++r)pA1[r]=__builtin_amdgcn_exp2f(pA1[r]);
  WAIT_BAR(0);
  DMA_K(3,0);DMA_V(1,SLOTB);
  ROT();
  kload8(kf,kp0+sl_cur);
  WAIT_BAR(2);
  s16x4 vlo[8],vhi[8]; u32x4 pw0,pw1,pw2,pw3;
  #define PKW(P,B) cvtpk_s(P[B],P[B+1])
  #define PAF(k) __builtin_bit_cast(bf16x8,pw##k)
  #define VFR(i) (bf16x8){vlo[i][0],vlo[i][1],vlo[i][2],vlo[i][3],vhi[i][0],vhi[i][1],vhi[i][2],vhi[i][3]}
  #define PIN(x) asm volatile("":"+v"(x))
  #define MX3(a,b,c) __builtin_fmaxf(__builtin_fmaxf((a),(b)),(c))
  #define GAPA(MF,A0,A1,A2,A3,W0,W1,PW) do{ MF; sacc+=A0; sacc+=A1; sacc+=A2; sacc+=A3; PIN(sacc); W0; W1; PIN(PW); SBAR(); }while(0)
  #define EX(v) __builtin_amdgcn_exp2f(v)
  #define GAPB(MF,X,B) do{ MF; X[B]=EX(X[B]); X[B+1]=EX(X[B+1]); X[B+2]=EX(X[B+2]); X[B+3]=EX(X[B+3]); PIN(X); SBAR(); }while(0)
  #define VRD(i) do{ vlo[i]=vtr(vp_+(((i)>>2)*4096+((i)&3)*1024)); vhi[i]=vtr(vp_+(((i)>>2)*4096+((i)&3)*1024+512)); }while(0)
  #define KRD(G,j) do{ if(G){ kload2(kf,kp0+sl_next,j); SBAR(); } }while(0)
  #define STEP(C0,C1,P0,P1,t,GK,GV,GL) do{ BIAS(C0,C1,t); SBAR(); \
    const lds_cptr vp_=vp0+sl_prev; \
    VRD(0); SBAR(); float sacc=(P0[0]+P0[1]); \
    GAPA(C0=__builtin_amdgcn_mfma_f32_32x32x16_bf16(kf[0],qr[0],C0,0,0,0), P0[2],P0[3],P0[4],P0[5],     pw0[0]=PKW(P0,0), pw0[1]=PKW(P0,2), pw0); \
    VRD(4); SBAR(); GAPA(C1=__builtin_amdgcn_mfma_f32_32x32x16_bf16(kf[1],qr[0],C1,0,0,0), P0[6],P0[7],P0[8],P0[9],     pw0[2]=PKW(P0,4), pw0[3]=PKW(P0,6), pw0); \
    VRD(1); SBAR(); GAPA(C0=__builtin_amdgcn_mfma_f32_32x32x16_bf16(kf[2],qr[1],C0,0,0,0),   P0[10],P0[11],P0[12],P0[13], pw1[0]=PKW(P0,8), pw1[1]=PKW(P0,10), pw1); \
    VRD(5); SBAR(); GAPA(C1=__builtin_amdgcn_mfma_f32_32x32x16_bf16(kf[3],qr[1],C1,0,0,0),   P0[14],P0[15],P1[0],P1[1],   pw1[2]=PKW(P0,12),pw1[3]=PKW(P0,14), pw1); \
    VRD(2); SBAR(); GAPA(C0=__builtin_amdgcn_mfma_f32_32x32x16_bf16(kf[4],qr[2],C0,0,0,0),   P1[2],P1[3],P1[4],P1[5],     pw2[0]=PKW(P1,0), pw2[1]=PKW(P1,2), pw2); \
    VRD(6); SBAR(); GAPA(C1=__builtin_amdgcn_mfma_f32_32x32x16_bf16(kf[5],qr[2],C1,0,0,0),   P1[6],P1[7],P1[8],P1[9],     pw2[2]=PKW(P1,4), pw2[3]=PKW(P1,6), pw2); \
    VRD(3); SBAR(); GAPA(C0=__builtin_amdgcn_mfma_f32_32x32x16_bf16(kf[6],qr[3],C0,0,0,0),   P1[10],P1[11],P1[12],P1[13], pw3[0]=PKW(P1,8), pw3[1]=PKW(P1,10), pw3); \
    VRD(7); SBAR(); GAPA(C1=__builtin_amdgcn_mfma_f32_32x32x16_bf16(kf[7],qr[3],C1,0,0,0),   P1[14],P1[15],0.f,0.f,       pw3[2]=PKW(P1,12),pw3[3]=PKW(P1,14), pw3); \
    l_reg+=sacc; \
    if(GK){DMA_K((t)+3,sl_cur);} if(GV){DMA_V((t)+1,sl_next);} \
    CMASK(C0,C1,t); \
    { float a=MX3(C0[0],C0[1],C1[0]),b=MX3(C0[2],C0[3],C1[1]); a=MX3(a,C1[2],C1[3]); \
      _Pragma("unroll") for(int r=4;r<16;r+=4){a=MX3(a,C0[r],C0[r+1]);b=MX3(b,C0[r+2],C0[r+3]);a=MX3(a,C1[r],C1[r+1]);b=MX3(b,C1[r+2],C1[r+3]);} \
      float rm=__builtin_fmaxf(a,b); { auto rr=__builtin_amdgcn_permlane32_swap(__float_as_uint(rm),__float_as_uint(rm),false,false); rm=__builtin_fmaxf(__uint_as_float(rr[0]),__uint_as_float(rr[1])); } \
      resc=false; \
      if(__builtin_expect(__any(rm>(float)THRL),0)){ const float dl=__builtin_fmaxf(rm,0.f); mhat+=dl; \
        _Pragma("unroll") for(int r=0;r<16;++r){C0[r]-=dl;C1[r]-=dl;} \
        const float f=__builtin_amdgcn_exp2f(-dl); l_reg*=f; if(hi==0)wsf[r32]=f; resc=true; } } \
    SBAR(); \
    GAPB(o[0]=__builtin_amdgcn_mfma_f32_32x32x16_bf16(PAF(0),VFR(0),o[0],0,0,0), C0,0); \
    GAPB(o[1]=__builtin_amdgcn_mfma_f32_32x32x16_bf16(PAF(0),VFR(4),o[1],0,0,0), C0,4); \
    KRD(GL,0); GAPB(o[0]=__builtin_amdgcn_mfma_f32_32x32x16_bf16(PAF(1),VFR(1),o[0],0,0,0), C0,8); \
    KRD(GL,1); GAPB(o[1]=__builtin_amdgcn_mfma_f32_32x32x16_bf16(PAF(1),VFR(5),o[1],0,0,0), C0,12); \
    KRD(GL,2); GAPB(o[0]=__builtin_amdgcn_mfma_f32_32x32x16_bf16(PAF(2),VFR(2),o[0],0,0,0), C1,0); \
    KRD(GL,3); GAPB(o[1]=__builtin_amdgcn_mfma_f32_32x32x16_bf16(PAF(2),VFR(6),o[1],0,0,0), C1,4); \
    GAPB(o[0]=__builtin_amdgcn_mfma_f32_32x32x16_bf16(PAF(3),VFR(3),o[0],0,0,0), C1,8); \
    GAPB(o[1]=__builtin_amdgcn_mfma_f32_32x32x16_bf16(PAF(3),VFR(7),o[1],0,0,0), C1,12); \
    }while(0)
  int t=1;
  #undef CMASK
  #define CMASK(P0,P1,t) do{}while(0)
  for(;t+5<NT;t+=2){
    STEP(pB0,pB1,pA0,pA1,t,true,true,true);     WAIT_BAR(2); RESC(); ROT();
    STEP(pA0,pA1,pB0,pB1,t+1,true,true,true);   WAIT_BAR(2); RESC(); ROT();
  }
  #undef CMASK
  #define CMASK(P0,P1,t) do{int jb_=(t)-(NT-4); if(jb_>=0)cmask(P0,P1,jb_,qrel,hi);}while(0)
  #define ENDW(tt) do{ if((tt)+3<NT){WAIT_BAR(2);} else if((tt)+2<NT){WAIT_BAR(1);} else {WAIT_BAR(0);} }while(0)
  for(;t+1<NT;t+=2){
    STEP(pB0,pB1,pA0,pA1,t,(t+3<NT),(t+1<NT),(t+1<NT));       ENDW(t);   RESC(); ROT();
    STEP(pA0,pA1,pB0,pB1,t+1,(t+4<NT),(t+2<NT),(t+2<NT));     ENDW(t+1); RESC(); ROT();
  }
  STEP(pB0,pB1,pA0,pA1,NT-1,false,false,false); RESC();
  { float sacc=pB0[0]+pB0[1]; _Pragma("unroll") for(int r=2;r<16;++r)sacc+=pB0[r]; _Pragma("unroll") for(int r=0;r<16;++r)sacc+=pB1[r]; l_reg+=sacc;
    pw0=(u32x4){PKW(pB0,0),PKW(pB0,2),PKW(pB0,4),PKW(pB0,6)};pw1=(u32x4){PKW(pB0,8),PKW(pB0,10),PKW(pB0,12),PKW(pB0,14)};pw2=(u32x4){PKW(pB1,0),PKW(pB1,2),PKW(pB1,4),PKW(pB1,6)};pw3=(u32x4){PKW(pB1,8),PKW(pB1,10),PKW(pB1,12),PKW(pB1,14)};
    SBAR(); pv(o,vb0+sl_cur,PAF(0),PAF(1),PAF(2),PAF(3)); }
  #undef PKW
  #undef PAF
  #undef VFR
  #undef PIN
  #undef MX3
  #undef GAPA
  #undef GAPB
  #undef EX
  #undef VRD
  #undef KRD
  #undef STEP
  #undef ENDW
  {auto rr=__builtin_amdgcn_permlane32_swap(__float_as_uint(l_reg),__float_as_uint(l_reg),false,false);l_reg=__uint_as_float(rr[0])+__uint_as_float(rr[1]);}
  if(hi==0)wsf[32+r32]=l_reg;asm volatile("s_waitcnt lgkmcnt(0)":::"memory");
  float rli[16];
  #pragma unroll
  for(int r=0;r<16;++r)rli[r]=__builtin_amdgcn_rcpf(wsf[32+crow(r,hi)]);
  bf16*Ow=O+(rowbase+q0+wid*QBLK)*OP+h*D;
  { bf16*stg=(bf16*)(shm+LDS_OST)+wid*2048;
    #pragma unroll
    for(int r=0;r<16;++r){const int orow=crow(r,hi);
      #pragma unroll
      for(int d0=0;d0<2;++d0)stg[orow*64+d0*32+r32]=__float2bfloat16(o[d0][r]*rli[r]);}
    asm volatile("s_waitcnt lgkmcnt(0)":::"memory");
    #pragma unroll
    for(int i=0;i<4;++i){const int row=i*8+(lane>>3),ch=lane&7; const u32x4 v=*(const u32x4*)(stg+row*64+ch*8); ATTN_STORE16(Ow+(long)row*OP+ch*8,v);} }
  asm volatile("s_waitcnt lgkmcnt(0)\n\ts_barrier":::"memory");
  #undef DMA_K
  #undef DMA_V
  #undef CMASK
  #undef START
  #undef RESC
  #undef BIAS
  #undef ROT
}
constexpr int ATTN_LDS_BYTES=LDS_F+LDS_F_BYTES;
#undef SBAR
#undef WAIT_BAR
}
#define GAS __attribute__((address_space(1)))
#define LAS __attribute__((address_space(3)))
typedef unsigned short bf16;
typedef unsigned v4u __attribute__((ext_vector_type(4)));
typedef float f32x4 __attribute__((ext_vector_type(4)));
typedef short bf16x8 __attribute__((ext_vector_type(8)));
typedef GAS unsigned gu32;
typedef GAS unsigned long long gu64;
#define RLX_AGENT __ATOMIC_RELAXED, __HIP_MEMORY_SCOPE_AGENT
#define LDS_WAIT() asm volatile("s_waitcnt lgkmcnt(0)" ::: "memory")
#define VM_WAIT() asm volatile("s_waitcnt vmcnt(0)" ::: "memory")
__device__ __forceinline__ unsigned long long rt() { return __builtin_amdgcn_s_memrealtime(); }
__device__ __forceinline__ unsigned f2bf(float f) { unsigned u = __builtin_bit_cast(unsigned, f); return (u + 0x7fffu + ((u >> 16) & 1u)) >> 16; }
__device__ __forceinline__ unsigned pk2(float lo, float hi) { return f2bf(lo) | (f2bf(hi) << 16); }

#define XB_TMO      128
#define XB_XCNT(j)  (256  + 64 * (j))
#define XB_XSUB(j)  (1280 + 64 * (j))
#define XB_XGEN(j)  (2304 + 64 * (j))
#define XB_TOP      3328
#define XB_TOPGEN   3392
#define XCD_BAR_WORDS 3456
#define XB_SPIN_CAP (1u << 18)

__device__ __forceinline__ unsigned xb_ld(unsigned* p)              { return __hip_atomic_load(p, __ATOMIC_RELAXED, __HIP_MEMORY_SCOPE_AGENT); }
__device__ __forceinline__ unsigned xb_add(unsigned* p, unsigned v) { return __hip_atomic_fetch_add(p, v, __ATOMIC_RELAXED, __HIP_MEMORY_SCOPE_AGENT); }
__device__ __forceinline__ unsigned xb_xcc_id() { return (unsigned)__builtin_amdgcn_s_getreg((3 << 11) | 20) & 0xFu; }
#define XB_SPIN(cond, bar) do { unsigned _sp = 0; while (cond) { __builtin_amdgcn_s_sleep(1); \
    if ((++_sp & 255u) == 0u) { if (xb_ld(&(bar)[XB_TMO])) break; if (_sp > XB_SPIN_CAP) { atomicAdd(&(bar)[XB_TMO], 1u); break; } } } } while (0)

struct XcdBarrier {
    unsigned* bar; unsigned x;
    volatile LAS unsigned* st;
};

__device__ __forceinline__ XcdBarrier xcd_barrier_post(unsigned* bar, volatile LAS unsigned* st) {
    XcdBarrier b; b.bar = bar; b.x = xb_xcc_id(); b.st = st;
    if (threadIdx.x == 0) (void)xb_add(&bar[XB_XCNT(b.x)], 1u);
    return b;
}
__device__ __forceinline__ void xcd_barrier_complete(unsigned* bar, unsigned x, unsigned& nloc, unsigned& nx) {
    const unsigned G = gridDim.x * gridDim.y * gridDim.z;
    unsigned sum, cnt, mine, sp = 0u;
    for (;;) {
        sum = 0u; cnt = 0u; mine = 0u;
#pragma unroll
        for (unsigned j = 0; j < 16; ++j) { const unsigned c = xb_ld(&bar[XB_XCNT(j)]); sum += c; cnt += (c > 0u) ? 1u : 0u; mine = (j == x) ? c : mine; }
        if (sum == G) break;
        __builtin_amdgcn_s_sleep(1);
        if ((++sp & 255u) == 0u) { if (xb_ld(&bar[XB_TMO])) break; if (sp > XB_SPIN_CAP) { atomicAdd(&bar[XB_TMO], 1u); break; } }
    }
    nloc = mine > 0u ? mine : 1u; nx = cnt > 0u ? cnt : 1u;
}

__device__ __forceinline__ void xcd_barrier(const XcdBarrier& b) {
    asm volatile("s_waitcnt vmcnt(0)" ::: "memory");
    __syncthreads();
    if (threadIdx.x == 0) {
        unsigned* bar = b.bar;
        __builtin_amdgcn_s_waitcnt(0);
        unsigned nloc = b.st[0], nx = b.st[1];
        if (nloc == 0u) { xcd_barrier_complete(bar, b.x, nloc, nx); b.st[0] = nloc; b.st[1] = nx; }
        const unsigned old = xb_add(&bar[XB_XSUB(b.x)], 1u);
        const unsigned gen = old / nloc;
        if (old + 1u == (gen + 1u) * nloc) {
            __builtin_amdgcn_fence(__ATOMIC_RELEASE, "agent");
            asm volatile("s_waitcnt vmcnt(0)" ::: "memory");
            const unsigned og = xb_add(&bar[XB_TOP], 1u);
            const unsigned tg = og / nx;
            if (og + 1u == (tg + 1u) * nx) xb_add(&bar[XB_TOPGEN], 1u);
            else XB_SPIN(xb_ld(&bar[XB_TOPGEN]) == tg, bar);
            __builtin_amdgcn_fence(__ATOMIC_ACQUIRE, "agent");
            xb_add(&bar[XB_XGEN(b.x)], 1u);
            asm volatile("s_waitcnt vmcnt(0)" ::: "memory");
        } else {
            XB_SPIN(xb_ld(&bar[XB_XGEN(b.x)]) == gen, bar);
            __builtin_amdgcn_fence(__ATOMIC_ACQUIRE, "agent");
            asm volatile("s_waitcnt vmcnt(0)" ::: "memory");
        }
    }
    __syncthreads();
}
constexpr int NWAVES = 8, NTHR = NWAVES * 64;
constexpr int T_ = 16384, DM_ = 1024, SEQ_ = 4096, NBH = 48, NHEADS = 12;
constexpr int EV_LD = 2828, EV_N = 2816;
constexpr int NEXP = 16, EHID = 256, SLOTS = 36864;
constexpr float EPS_ = 1e-6f, LOG2E = 1.4426950408889634f;
constexpr int NPH = 17;
constexpr size_t MiB = 1u << 20;
constexpr size_t WS_CTL = 0, CTL_ZERO_BYTES = 1 * MiB;
constexpr size_t WS_WIN0 = 1 * MiB, WS_WOUT0 = 7 * MiB, WS_WIN1 = 9 * MiB, WS_WOUT1 = 13 * MiB, WS_WST = 15 * MiB, WS_WGU = 16 * MiB, WS_WD = 48 * MiB;
constexpr size_t WS_XN = 64 * MiB;
constexpr size_t WS_A = 96 * MiB;
constexpr size_t WS_U = WS_A, WS_V = WS_A + 8 * MiB, WS_Q = WS_A + 16 * MiB, WS_K = WS_A + 40 * MiB, WS_VAL = WS_A + 64 * MiB;
constexpr size_t WS_Y = WS_A, WS_H1 = WS_A;
constexpr size_t WS_MIX = 184 * MiB;
constexpr size_t WS_HID = 216 * MiB;
constexpr size_t WS_F2 = 234 * MiB, WS_LIST = 235 * MiB, WS_LISTW = 236 * MiB, WS_TOKE = 237 * MiB, WS_TOKP = 237 * MiB + 512 * 1024, WS_END = 240 * MiB;
static_assert(WS_Y + (size_t)SLOTS * 1024 * 2 <= WS_MIX && WS_HID + (size_t)SLOTS * 256 * 2 <= WS_F2 && WS_VAL + (size_t)T_ * 768 * 2 <= WS_MIX, "ws map");
constexpr int CW_TMO = 0, CW_BAR = 4096, CW_Q = 8192, CW_CNT0 = 16384, CW_CNT1 = 16384 + 1024, CW_CNTD = 16384 + 2048, CNT_STRIDE = 64;
constexpr int RING_BYTES = 131072, LDSCTL_OFF = RING_BYTES, MISC_OFF = LDSCTL_OFF + 320, LDS_BYTES = 147456;

__device__ __forceinline__ float wave_sum(float v) {
#pragma unroll
    for (int o = 1; o < 64; o <<= 1) v += __shfl_xor(v, o);
    return v;
}
__device__ __forceinline__ float fast_sigmoid(float z) { return __builtin_amdgcn_rcpf(1.f + __builtin_amdgcn_exp2f(-z * LOG2E)); }
__device__ __forceinline__ float gelu_tanh(float x) { const float z = 1.5957691216057308f * x * (1.f + 0.044715f * x * x); return x * fast_sigmoid(z); }
__device__ __forceinline__ float bf2f(unsigned short h) { return __builtin_bit_cast(float, (unsigned)h << 16); }


constexpr int TP = 1028;
template <int NC>
__device__ __forceinline__ void skinny_core(const float* X, int row0, const LAS float* wt, LAS float* part, LAS float* ssq, int wave, int lane) {
    const int rg = wave & 3, kh = wave >> 2, r = lane & 15, kq = lane >> 4, col = lane & 15;
    const GAS float* xp = (const GAS float*)X + (size_t)(row0 + 16 * rg + r) * DM_ + 512 * kh + 4 * kq;
    const LAS float* b0p = wt + (col < NC ? col : NC - 1) * TP + 512 * kh + 4 * kq;
    const LAS float* b1p = wt + ((NC > 16) ? (16 + (col & 3)) : 0) * TP + 512 * kh + 4 * kq;
    f32x4 acc0 = (f32x4){0.f, 0.f, 0.f, 0.f}, acc1 = (f32x4){0.f, 0.f, 0.f, 0.f}; float ss = 0.f;
#pragma unroll 1
    for (int jb = 0; jb < 2; ++jb) {
        f32x4 xv[16];
#pragma unroll
        for (int jj = 0; jj < 16; ++jj) xv[jj] = *(const GAS f32x4*)(xp + 16 * (16 * jb + jj));
#pragma unroll
        for (int jj = 0; jj < 16; ++jj) { const f32x4 b0 = *(const LAS f32x4*)(b0p + 16 * (16 * jb + jj)); const f32x4 x4 = xv[jj];
            ss += (x4.x * x4.x + x4.y * x4.y) + (x4.z * x4.z + x4.w * x4.w);
            acc0 = __builtin_amdgcn_mfma_f32_16x16x4f32(x4.x, b0.x, acc0, 0, 0, 0); acc0 = __builtin_amdgcn_mfma_f32_16x16x4f32(x4.y, b0.y, acc0, 0, 0, 0);
            acc0 = __builtin_amdgcn_mfma_f32_16x16x4f32(x4.z, b0.z, acc0, 0, 0, 0); acc0 = __builtin_amdgcn_mfma_f32_16x16x4f32(x4.w, b0.w, acc0, 0, 0, 0);
            if (NC > 16) { const f32x4 b1 = *(const LAS f32x4*)(b1p + 16 * (16 * jb + jj));
                acc1 = __builtin_amdgcn_mfma_f32_16x16x4f32(x4.x, b1.x, acc1, 0, 0, 0); acc1 = __builtin_amdgcn_mfma_f32_16x16x4f32(x4.y, b1.y, acc1, 0, 0, 0);
                acc1 = __builtin_amdgcn_mfma_f32_16x16x4f32(x4.z, b1.z, acc1, 0, 0, 0); acc1 = __builtin_amdgcn_mfma_f32_16x16x4f32(x4.w, b1.w, acc1, 0, 0, 0); } }
    }
    ss += __shfl_xor(ss, 16); ss += __shfl_xor(ss, 32);
    if (lane < 16) ssq[kh * 64 + 16 * rg + r] = ss;
#pragma unroll
    for (int i = 0; i < 4; ++i) { LAS float* pr = part + (kh * 64 + 16 * rg + 4 * kq + i) * 32; pr[col] = acc0[i]; if (NC > 16 && col < 4) pr[16 + col] = acc1[i]; }
    __syncthreads();
}
__device__ __forceinline__ void xn_tile(const float* X, const float* gn, unsigned char* ws, int row0, const LAS float* rstd_l, int wave, int lane) {
    f32x4 g4[4];
#pragma unroll
    for (int j = 0; j < 4; ++j) g4[j] = *((const GAS f32x4*)gn + 64 * j + lane);
#pragma unroll 4
    for (int i = 0; i < 8; ++i) { const int m = row0 + 8 * wave + i; const float rstd = rstd_l[8 * wave + i];
        const GAS f32x4* xr = (const GAS f32x4*)(X + (size_t)m * DM_) + lane; GAS unsigned long long* o8 = (GAS unsigned long long*)(ws + WS_XN + (size_t)m * DM_ * 2) + lane;
        f32x4 v[4];
#pragma unroll
        for (int j = 0; j < 4; ++j) v[j] = xr[64 * j];
#pragma unroll
        for (int j = 0; j < 4; ++j) o8[64 * j] = (unsigned long long)pk2(v[j].x * rstd * g4[j].x, v[j].y * rstd * g4[j].y) | ((unsigned long long)pk2(v[j].z * rstd * g4[j].z, v[j].w * rstd * g4[j].w) << 32); }
}
struct TrItem { const float* src; bf16* dst; int ldw2, kp8; };
struct TrSrc { const float *w_in0, *w_out0, *w_in1, *w_out1, *w_gate, *w_up, *w_down; };
constexpr int TR_P1_END = 16 * 88 + 3584;
constexpr int TR_I0 = 16 * 88, TR_I1 = 16 * 32, TR_IE = 16 * 128, TR_I2 = 16 * 64, TR_I3 = 8 * 32, TR_A_END = TR_I0 + TR_I1 + 3 * TR_IE, TR_NITEMS = TR_A_END + TR_I2 + TR_I3 + 3 * TR_IE;
__device__ __forceinline__ TrItem tr_decode(int it, const TrSrc& S, unsigned char* ws, int lane) {
    const float* W; int ldw, Kp, k0, n0, drow0; bf16* WT; int r = it; int layer = 0;
    int seg;
    if (r < TR_I0) seg = 0; else if ((r -= TR_I0) < TR_I1) seg = 1; else if ((r -= TR_I1) < TR_IE) seg = 2; else if ((r -= TR_IE) < TR_IE) seg = 3; else if ((r -= TR_IE) < TR_IE) seg = 4;
    else if ((r -= TR_IE) < TR_I2) seg = 5; else if ((r -= TR_I2) < TR_I3) seg = 6; else { layer = 1; if ((r -= TR_I3) < TR_IE) seg = 2; else if ((r -= TR_IE) < TR_IE) seg = 3; else { r -= TR_IE; seg = 4; } }
    if (seg == 0) { const int kb = r / 88, nb = r % 88, c = (32 * nb) & 255; W = S.w_in0; ldw = EV_LD; WT = (bf16*)(ws + WS_WIN0); Kp = 1024; k0 = 64 * kb; n0 = 32 * nb; drow0 = (n0 & ~255) + 128 * ((c >> 5) & 1) + 32 * (c >> 6); }
    else if (seg == 1) { const int kb = r / 32, nb = r % 32; W = S.w_out0; ldw = 1024; WT = (bf16*)(ws + WS_WOUT0); Kp = 1024; k0 = 64 * kb; n0 = 32 * nb; drow0 = n0; }
    else if (seg == 5) { const int kb = r / 64, nb = r % 64; W = S.w_in1; ldw = 2048; WT = (bf16*)(ws + WS_WIN1); Kp = 1024; k0 = 64 * kb; n0 = 32 * nb; drow0 = n0; }
    else if (seg == 6) { const int kb = r / 32, nb = r % 32; W = S.w_out1; ldw = 1024; WT = (bf16*)(ws + WS_WOUT1); Kp = 1024; k0 = 64 * kb; n0 = 32 * nb; drow0 = n0; }
    else { const int le = layer * NEXP + r / 128, rr = r % 128;
        if (seg == 2) { W = S.w_gate + (size_t)le * 1024 * 256; ldw = 256; WT = (bf16*)(ws + WS_WGU) + (size_t)le * 512 * 1024; Kp = 1024; k0 = 64 * (rr / 8); n0 = 32 * (rr % 8); drow0 = (n0 >> 7) * 256 + (n0 & 127); }
        else if (seg == 3) { W = S.w_up + (size_t)le * 1024 * 256; ldw = 256; WT = (bf16*)(ws + WS_WGU) + (size_t)le * 512 * 1024; Kp = 1024; k0 = 64 * (rr / 8); n0 = 32 * (rr % 8); drow0 = (n0 >> 7) * 256 + 128 + (n0 & 127); }
        else { W = S.w_down + (size_t)le * 256 * 1024; ldw = 1024; WT = (bf16*)(ws + WS_WD) + (size_t)le * 1024 * 256; Kp = 256; k0 = 64 * (rr / 32); n0 = 32 * (rr % 32); drow0 = n0; } }
    TrItem t; t.src = W + (size_t)(k0 + (lane >> 5)) * ldw + n0 + (lane & 31); t.ldw2 = 2 * ldw; t.dst = WT + (size_t)(drow0 + (lane >> 3)) * Kp + k0 + 8 * (lane & 7); t.kp8 = 8 * Kp; return t;
}
template <class IN_T> __device__ __forceinline__ void convert_items(const IN_T in, unsigned char* ws, LAS float* scr, int lo, int hi, int widx, int nw, int lane) {
    TrSrc S{in[2], in[9], in[11], in[15], in[21], in[22], in[23]};
    float tv[32], tn[32]; TrItem cur{nullptr, nullptr, 0, 0};
    if (lo + widx < hi) { cur = tr_decode(lo + widx, S, ws, lane);
#pragma unroll
        for (int i = 0; i < 32; ++i) tv[i] = cur.src[(size_t)i * cur.ldw2]; }
    for (int it = lo + widx; it < hi; it += nw) {
        TrItem nx = cur; const bool more = it + nw < hi;
        if (more) { nx = tr_decode(it + nw, S, ws, lane);
#pragma unroll
            for (int i = 0; i < 32; ++i) tn[i] = nx.src[(size_t)i * nx.ldw2]; }
#pragma unroll
        for (int i = 0; i < 32; ++i) scr[(2 * i + (lane >> 5)) * 33 + (lane & 31)] = tv[i];
        LDS_WAIT(); asm volatile("" ::: "memory");
        const int c = lane & 7;
#pragma unroll
        for (int j = 0; j < 4; ++j) { const LAS float* s = scr + (8 * c) * 33 + (lane >> 3) + 8 * j;
            v4u o; o.x = pk2(s[0 * 33], s[1 * 33]); o.y = pk2(s[2 * 33], s[3 * 33]); o.z = pk2(s[4 * 33], s[5 * 33]); o.w = pk2(s[6 * 33], s[7 * 33]);
            *(GAS v4u*)(cur.dst + (size_t)j * cur.kp8) = o; }
        LDS_WAIT(); asm volatile("" ::: "memory");
        cur = nx;
#pragma unroll
        for (int i = 0; i < 32; ++i) tv[i] = tn[i];
    }
}
template <class IN_T> __device__ __forceinline__ void fold_items(const IN_T in, unsigned char* ws, int widx, int nw, int lane) {
    const float* const w_pool = in[13]; const float* const p_scale = in[14]; const float* const w_out1 = in[15];
    for (int it = widx; it < 4 * 32 * 16; it += nw) {
        const int itu = __builtin_amdgcn_readfirstlane(it), g = itu >> 9, c0 = ((itu >> 4) & 31) * 4, n = (itu & 15) * 64 + lane;
        const float* wp = w_pool + (size_t)(g * 128 + c0) * 128; const float* sc = p_scale + g * 128; const float* wo = w_out1 + (size_t)(512 + g * 128) * 1024 + n;
        float a[4];
#pragma unroll
        for (int c = 0; c < 4; ++c) a[c] = 0.f;
#pragma unroll 32
        for (int d = 0; d < 128; ++d) { const float t = sc[d] * wo[(size_t)d * 1024];
#pragma unroll
            for (int c = 0; c < 4; ++c) a[c] += wp[c * 128 + d] * t; }
        *(GAS unsigned long long*)((bf16*)(ws + WS_WOUT1) + (size_t)n * 1024 + 512 + g * 128 + c0) = (unsigned long long)pk2(a[0], a[1]) | ((unsigned long long)pk2(a[2], a[3]) << 32); }
}
template <class IN_T> __device__ __forceinline__ void p0_prologue(const IN_T in, unsigned char* ws, LAS unsigned char* lds, int G, int vcu) {
    int tid_ = threadIdx.x; asm volatile("" : "+v"(tid_)); const int tid = tid_, lane = tid & 63, wave = __builtin_amdgcn_readfirstlane(tid >> 6);
    const int gw = vcu * NWAVES + wave, NGW = G * NWAVES;
    convert_items(in, ws, (LAS float*)(lds + wave * 16384), 0, TR_I0, gw, NGW, lane); convert_items(in, ws, (LAS float*)(lds + wave * 16384), TR_P1_END, TR_A_END, gw, NGW, lane);
    const int gt = vcu * NTHR + tid, NGT = G * NTHR;
    { const float* const w_s = in[4]; for (int i = gt; i < 4 * 128 * 128; i += NGT) { const int s = i & 127, t = (i >> 7) & 127; ((GAS bf16*)(ws + WS_WST))[i] = (s <= t) ? (bf16)f2bf(w_s[i]) : (bf16)0; } }
    __syncthreads();
    LAS float* wf = (LAS float*)lds; LAS float* part = (LAS float*)(lds + 98304); LAS float* ssq = part + 2 * 64 * 32; LAS float* rstd_l = ssq + 128;
    const float* const x = in[0]; const float* const gn = in[1]; const float* const b_forget = in[3];
    { const float* const w_in0 = in[2];
#pragma unroll
      for (int kk = 0; kk < 2; ++kk) { const int k = tid + NTHR * kk; const GAS f32x4* src = (const GAS f32x4*)(w_in0 + (size_t)k * EV_LD + EV_N); const f32x4 q0 = src[0], q1 = src[1], q2 = src[2]; const float g = gn[k];
          wf[0 * TP + k] = q0.x * g; wf[1 * TP + k] = q0.y * g; wf[2 * TP + k] = q0.z * g; wf[3 * TP + k] = q0.w * g; wf[4 * TP + k] = q1.x * g; wf[5 * TP + k] = q1.y * g; wf[6 * TP + k] = q1.z * g; wf[7 * TP + k] = q1.w * g;
          wf[8 * TP + k] = q2.x * g; wf[9 * TP + k] = q2.y * g; wf[10 * TP + k] = q2.z * g; wf[11 * TP + k] = q2.w * g; } }
    __syncthreads();
    for (int tile = vcu; tile < T_ / 64; tile += G) { const int row0 = tile * 64;
        skinny_core<12>(x, row0, wf, part, ssq, wave, lane);
        if (tid < 64) { const int m = row0 + tid; const float rstd = __builtin_amdgcn_rsqf((ssq[tid] + ssq[64 + tid]) * (1.f / DM_) + EPS_); rstd_l[tid] = rstd;
            GAS float* f2 = (GAS float*)(ws + WS_F2) + (size_t)((m >> 12) * NHEADS) * SEQ_ + (m & (SEQ_ - 1));
#pragma unroll
            for (int h = 0; h < 12; ++h) { const float z = (part[tid * 32 + h] + part[(64 + tid) * 32 + h]) * rstd + b_forget[h];
                const float ls = (z >= 0.f) ? -log1pf(__expf(-z)) : (z - log1pf(__expf(z)));
                f2[(size_t)h * SEQ_] = ls * LOG2E; } }
        __syncthreads();
        xn_tile(x, gn, ws, row0, rstd_l, wave, lane);
        __syncthreads();
    }
}

__device__ __forceinline__ void scan_seq(float* f, LAS float* tot) {
    int tid_ = threadIdx.x; asm volatile("" : "+v"(tid_)); const int tid = tid_, lane = tid & 63, wave = tid >> 6;
    GAS f32x4* p = (GAS f32x4*)f + 2 * tid; f32x4 a = p[0], b = p[1];
    a.y += a.x; a.z += a.y; a.w += a.z; b.x += a.w; b.y += b.x; b.z += b.y; b.w += b.z;
    float run = b.w;
#pragma unroll
    for (int o = 1; o < 64; o <<= 1) { const float t = __shfl_up(run, o); if (lane >= o) run += t; }
    if (lane == 63) tot[wave] = run;
    __syncthreads();
    float base = run - b.w;
    for (int w = 0; w < wave; ++w) base += tot[w];
    a = a + base; b = b + base; p[0] = a; p[1] = b;
    __syncthreads();
}

struct EpiInproj0 {
    static constexpr bool PERM = true;
    bf16 *U, *V, *Q, *Kb, *VAL; const float *g_v, *g_q, *g_k;
    __device__ __forceinline__ void operator()(const pg8::f32x4 (&acc)[2][2][4][2], const pg8::Unit& u, int wr, int wc, int fr, int fq) const {
        const int pn = u.pn; const bool act = pn <= 1, nrm = (pn >= 1 && pn <= 7);
        bf16* dst; int pitch, cb; const float* gp = nullptr; float gs = 1.f;
        if (pn == 0) { dst = U; pitch = 256; cb = 0; }
        else if (pn == 1) { dst = V; pitch = 256; cb = 0; gp = g_v + wc * 64; }
        else if (pn <= 4) { dst = Q; pitch = 768; cb = (pn - 2) * 256; gp = g_q; gs = 0.125f * LOG2E; }
        else if (pn <= 7) { dst = Kb; pitch = 768; cb = (pn - 5) * 256; gp = g_k; }
        else { dst = VAL; pitch = 768; cb = (pn - 8) * 256; }
        f32x4 gn[2][2];
#pragma unroll
        for (int bj = 0; bj < 2; ++bj)
#pragma unroll
            for (int n = 0; n < 2; ++n) { gn[bj][n] = (f32x4){1.f, 1.f, 1.f, 1.f}; if (nrm) gn[bj][n] = *(const f32x4*)(gp + 32 * bj + 8 * fq + 4 * n) * gs; }
        const int row0 = u.pm * 256 + wr * 64 + fr, col0 = cb + 64 * wc + 8 * fq;
#pragma unroll
        for (int ai = 0; ai < 2; ++ai)
#pragma unroll
            for (int m = 0; m < 4; ++m) {
                f32x4 x[2][2]; float ss = 0.f;
#pragma unroll
                for (int bj = 0; bj < 2; ++bj)
#pragma unroll
                    for (int n = 0; n < 2; ++n) { f32x4 t = acc[ai][bj][m][n];
                        if (act) { t.x = gelu_tanh(t.x); t.y = gelu_tanh(t.y); t.z = gelu_tanh(t.z); t.w = gelu_tanh(t.w); }
                        ss += (t.x * t.x + t.y * t.y) + (t.z * t.z + t.w * t.w); x[bj][n] = t; }
                float r = 1.f;
                if (nrm) { ss += __shfl_xor(ss, 16); ss += __shfl_xor(ss, 32); r = __builtin_amdgcn_rsqf(ss * (1.f / 64.f) + EPS_); }
                bf16* rowp = dst + (size_t)(row0 + ai * 128 + m * 16) * pitch + col0;
#pragma unroll
                for (int bj = 0; bj < 2; ++bj) { const f32x4 v0 = x[bj][0] * gn[bj][0] * r, v1 = x[bj][1] * gn[bj][1] * r;
                    v4u w; w.x = pg8::cvt_pk_bf16(v0.x, v0.y); w.y = pg8::cvt_pk_bf16(v0.z, v0.w); w.z = pg8::cvt_pk_bf16(v1.x, v1.y); w.w = pg8::cvt_pk_bf16(v1.z, v1.w);
                    *(v4u*)(rowp + 32 * bj) = w; }
            }
    }
};
struct EpiResF32 {
    static constexpr bool PERM = true;
    const float* base; float* out;
    __device__ __forceinline__ void operator()(const pg8::f32x4 (&acc)[2][2][4][2], const pg8::Unit& u, int wr, int wc, int fr, int fq) const {
        const int row0 = u.pm * 256 + wr * 64 + fr, col0 = u.pn * 256 + wc * 32 + 8 * fq;
#pragma unroll
        for (int ai = 0; ai < 2; ++ai)
#pragma unroll
            for (int m = 0; m < 4; ++m) { const size_t off = (size_t)(row0 + ai * 128 + m * 16) * DM_ + col0;
#pragma unroll
                for (int bj = 0; bj < 2; ++bj)
#pragma unroll
                    for (int n = 0; n < 2; ++n) { const f32x4 b = *(const f32x4*)(base + off + bj * 128 + n * 4); *(f32x4*)(out + off + bj * 128 + n * 4) = b + acc[ai][bj][m][n]; }
                if (m & 1) asm volatile("" ::: "memory"); }
    }
};
struct EpiBf16 {
    static constexpr bool PERM = true;
    bf16* O; int ldc;
    __device__ __forceinline__ void operator()(const pg8::f32x4 (&acc)[2][2][4][2], const pg8::Unit& u, int wr, int wc, int fr, int fq) const {
        const int row0 = u.pm * 256 + wr * 64 + fr, col0 = u.pn * 256 + wc * 32 + 8 * fq;
#pragma unroll
        for (int ai = 0; ai < 2; ++ai)
#pragma unroll
            for (int m = 0; m < 4; ++m) { bf16* rowp = O + (size_t)(row0 + ai * 128 + m * 16) * ldc + col0;
#pragma unroll
                for (int bj = 0; bj < 2; ++bj) { const f32x4 v0 = acc[ai][bj][m][0], v1 = acc[ai][bj][m][1];
                    v4u w; w.x = pg8::cvt_pk_bf16(v0.x, v0.y); w.y = pg8::cvt_pk_bf16(v0.z, v0.w); w.z = pg8::cvt_pk_bf16(v1.x, v1.y); w.w = pg8::cvt_pk_bf16(v1.z, v1.w);
                    *(v4u*)(rowp + bj * 128) = w; } }
    }
};
struct EpiGateUp {
    static constexpr bool PERM = true;
    bf16* HID; const float* listw;
    __device__ __forceinline__ void operator()(const pg8::f32x4 (&acc)[2][2][4][2], const pg8::Unit& u, int wr, int wc, int fr, int fq) const {
        const int col0 = u.pn * 128 + wc * 32 + 8 * fq;
#pragma unroll
        for (int ai = 0; ai < 2; ++ai)
#pragma unroll
            for (int m = 0; m < 4; ++m) { const int rt = ai * 128 + wr * 64 + m * 16 + fr, pos = u.j * 256 + rt;
                const float w = (pos < u.cnt) ? listw[(size_t)u.e * T_ + pos] : 0.f;
                f32x4 h[2];
#pragma unroll
                for (int n = 0; n < 2; ++n) { const f32x4 g = acc[ai][0][m][n], up = acc[ai][1][m][n];
                    h[n].x = g.x * fast_sigmoid(g.x) * up.x * w; h[n].y = g.y * fast_sigmoid(g.y) * up.y * w; h[n].z = g.z * fast_sigmoid(g.z) * up.z * w; h[n].w = g.w * fast_sigmoid(g.w) * up.w * w; }
                v4u o; o.x = pg8::cvt_pk_bf16(h[0].x, h[0].y); o.y = pg8::cvt_pk_bf16(h[0].z, h[0].w); o.z = pg8::cvt_pk_bf16(h[1].x, h[1].y); o.w = pg8::cvt_pk_bf16(h[1].z, h[1].w);
                *(v4u*)(HID + (size_t)(u.pm * 256 + rt) * EHID + col0) = o; }
    }
};
__device__ __forceinline__ int moe_mtiles(unsigned* cnt) { int pre = 0;
#pragma unroll
    for (int e = 0; e < NEXP; ++e) pre += ((int)__builtin_amdgcn_readfirstlane(__hip_atomic_load(cnt + CNT_STRIDE * e, __ATOMIC_RELAXED, __HIP_MEMORY_SCOPE_AGENT)) + 255) >> 8;
    return pre; }
struct ProbMoe {
    const char* A; const char* Bt; int K, nN; unsigned* cnt; const int* list; bool gather; size_t bstride;
    int ubase, ulim, Geff, ceff;
    __device__ __forceinline__ bool next(int i, pg8::Unit& u) const {
        if (ceff < 0) return false;
        const int L = ubase + i * Geff + ceff; if (L >= ulim) return false;
        const int mt = L / nN; int pre = 0; bool found = false;
#pragma unroll
        for (int e = 0; e < NEXP; ++e) { const int ce = (int)__builtin_amdgcn_readfirstlane(__hip_atomic_load(cnt + CNT_STRIDE * e, __ATOMIC_RELAXED, __HIP_MEMORY_SCOPE_AGENT)); const int tl = (ce + 255) >> 8;
            if (mt >= pre && mt < pre + tl) { u.e = e; u.j = mt - pre; u.cnt = ce; found = true; } pre += tl; }
        u.pm = mt; u.pn = L % nN; return found;
    }
    __device__ __forceinline__ unsigned a_off(const pg8::Unit& u, int row) const {
        if (gather) { int pos = u.j * 256 + row; pos = pos < u.cnt ? pos : u.cnt - 1; const int tok = list[(size_t)u.e * T_ + pos]; return (unsigned)tok * (unsigned)(K * 2); }
        return (unsigned)(u.pm * 256 + row) * (unsigned)(K * 2);
    }
    __device__ __forceinline__ const char* b_base(const pg8::Unit& u) const { return Bt + (size_t)u.e * bstride + (size_t)u.pn * 256 * K * 2; }
};

__device__ __forceinline__ void gmlp_unit(int idx, const bf16* U, const bf16* V, const bf16* WST, const float* b_s, bf16* MIX, LAS unsigned char* lds) {
    int tid_ = threadIdx.x; asm volatile("" : "+v"(tid_)); const int tid = tid_, lane = tid & 63, wave = __builtin_amdgcn_readfirstlane(tid >> 6), fr = lane & 15, fq = lane >> 4;
    const int c = idx >> 2, g = idx & 3, tok0 = c * 128;
    LAS bf16* Vt = (LAS bf16*)lds;
#pragma unroll
    for (int i = 0; i < 2; ++i) { const int p = tid + NTHR * i, s = p >> 3, dc = p & 7;
        const v4u q = *(const GAS v4u*)(V + (size_t)(tok0 + s) * 256 + g * 64 + dc * 8);
        const unsigned w[4] = {q.x, q.y, q.z, q.w};
#pragma unroll
        for (int e = 0; e < 4; ++e) { Vt[(dc * 8 + 2 * e) * 136 + s] = (bf16)(w[e] & 0xffffu); Vt[(dc * 8 + 2 * e + 1) * 136 + s] = (bf16)(w[e] >> 16); } }
    __syncthreads();
    const int t0 = 16 * wave;
    pg8::f32x4 acc[4];
#pragma unroll
    for (int n = 0; n < 4; ++n) acc[n] = (pg8::f32x4){0.f, 0.f, 0.f, 0.f};
#pragma unroll
    for (int ks = 0; ks < 4; ++ks) {
        const bf16x8 wfrag = *(const GAS bf16x8*)(WST + (size_t)(g * 128 + t0 + fr) * 128 + 32 * ks + 8 * fq);
#pragma unroll
        for (int n = 0; n < 4; ++n) { const bf16x8 vfrag = *(const LAS bf16x8*)(Vt + (16 * n + fr) * 136 + 32 * ks + 8 * fq);
            acc[n] = __builtin_amdgcn_mfma_f32_16x16x32_bf16(vfrag, wfrag, acc[n], 0, 0, 0); }
    }
    const int t = t0 + fr; const float bs = b_s[g * 128 + t];
#pragma unroll
    for (int n = 0; n < 4; ++n) { const size_t ucol = (size_t)(tok0 + t) * 256 + g * 64 + 16 * n + 4 * fq;
        const unsigned long long uu = *(const GAS unsigned long long*)(U + ucol);
        const float u0 = bf2f((unsigned short)(uu & 0xffff)), u1 = bf2f((unsigned short)((uu >> 16) & 0xffff)), u2 = bf2f((unsigned short)((uu >> 32) & 0xffff)), u3 = bf2f((unsigned short)(uu >> 48));
        const unsigned lo = pk2(u0 * (acc[n].x + bs), u1 * (acc[n].y + bs)), hi = pk2(u2 * (acc[n].z + bs), u3 * (acc[n].w + bs));
        *(GAS unsigned long long*)(MIX + (size_t)(tok0 + t) * 1024 + g * 64 + 16 * n + 4 * fq) = (unsigned long long)lo | ((unsigned long long)hi << 32); }
    __syncthreads();
}

#if MK_NAIVE_ATTN
__device__ __forceinline__ void naive_attn(const bf16* Q, const bf16* K, const bf16* V, const float* F2, bf16* MIXo, int gt, int NGT) {
    for (int r = gt; r < NBH * SEQ_; r += NGT) { const int bh = r / SEQ_, t = r % SEQ_, b = bh / NHEADS, h = bh % NHEADS; const size_t row = (size_t)b * SEQ_ + t;
        float q[64], o[64];
#pragma unroll
        for (int d = 0; d < 64; ++d) { q[d] = bf2f(Q[row * 768 + h * 64 + d]); o[d] = 0.f; }
        float m = -INFINITY, l = 0.f; const float ft = F2[(size_t)bh * SEQ_ + t];
        for (int s = 0; s <= t; ++s) { const size_t rs = (size_t)b * SEQ_ + s; float sc = 0.f;
#pragma unroll
            for (int d = 0; d < 64; ++d) sc += q[d] * bf2f(K[rs * 768 + h * 64 + d]);
            sc += ft - F2[(size_t)bh * SEQ_ + s];
            const float mn = fmaxf(m, sc), al = exp2f(m - mn), p = exp2f(sc - mn); l = l * al + p; m = mn;
#pragma unroll
            for (int d = 0; d < 64; ++d) o[d] = o[d] * al + p * bf2f(V[rs * 768 + h * 64 + d]); }
        const float il = 1.f / l;
#pragma unroll
        for (int d = 0; d < 64; ++d) MIXo[row * 1024 + 256 + h * 64 + d] = (bf16)f2bf(o[d] * il); }
}
#endif

template <class IN_T> __device__ __forceinline__ void phase_route(const IN_T in, int layer, const float* X, unsigned char* ws, unsigned* cnt, LAS unsigned char* lds, int G, int vcu, int rep) {
    int tid_ = threadIdx.x; asm volatile("" : "+v"(tid_)); const int tid = tid_, lane = tid & 63, wave = __builtin_amdgcn_readfirstlane(tid >> 6);
    LAS float* wt = (LAS float*)lds;
    LAS float* part = (LAS float*)(lds + 98304); LAS float* ssq = part + 2 * 64 * 32; LAS float* rstd_l = ssq + 128; LAS unsigned* lcnt = (LAS unsigned*)(rstd_l + 64); LAS unsigned* lbase = lcnt + 16;
    const float* wg = in[17] + (size_t)layer * 1024 * 4; const float* wrt = in[19] + (size_t)layer * 1024 * 16; const float* gn = in[16] + (size_t)layer * 1024;
#pragma unroll
    for (int kk = 0; kk < 2; ++kk) { const int k = tid + NTHR * kk; const f32x4 q0 = *(const GAS f32x4*)(wg + k * 4); const GAS f32x4* rs = (const GAS f32x4*)(wrt + k * 16); const f32x4 q1 = rs[0], q2 = rs[1], q3 = rs[2], q4 = rs[3]; const float g = gn[k];
        wt[0 * TP + k] = q0.x * g; wt[1 * TP + k] = q0.y * g; wt[2 * TP + k] = q0.z * g; wt[3 * TP + k] = q0.w * g;
        wt[4 * TP + k] = q1.x * g; wt[5 * TP + k] = q1.y * g; wt[6 * TP + k] = q1.z * g; wt[7 * TP + k] = q1.w * g; wt[8 * TP + k] = q2.x * g; wt[9 * TP + k] = q2.y * g; wt[10 * TP + k] = q2.z * g; wt[11 * TP + k] = q2.w * g;
        wt[12 * TP + k] = q3.x * g; wt[13 * TP + k] = q3.y * g; wt[14 * TP + k] = q3.z * g; wt[15 * TP + k] = q3.w * g; wt[16 * TP + k] = q4.x * g; wt[17 * TP + k] = q4.y * g; wt[18 * TP + k] = q4.z * g; wt[19 * TP + k] = q4.w * g; }
    const float* bg = in[18] + layer * 4; const float* br = in[20] + layer * 16;
    int* list = (int*)(ws + WS_LIST); float* listw = (float*)(ws + WS_LISTW); int* toke = (int*)(ws + WS_TOKE); int* tokp = (int*)(ws + WS_TOKP);
    for (int tile = vcu; tile < T_ / 64; tile += G) { const int row0 = tile * 64;
        if (tid < 16) lcnt[tid] = 0u;
        __syncthreads();
        skinny_core<20>(X, row0, wt, part, ssq, wave, lane);
        int e1 = 0, e2 = 0; float w1 = 0.f, w2 = 0.f; unsigned r1 = 0, r2 = 0;
        if (tid < 64) {
            const float rstd = __builtin_amdgcn_rsqf((ssq[tid] + ssq[64 + tid]) * (1.f / DM_) + EPS_); rstd_l[tid] = rstd;
            float a[20];
#pragma unroll
            for (int c = 0; c < 20; ++c) a[c] = (part[tid * 32 + c] + part[(64 + tid) * 32 + c]) * rstd;
            float lg[4]; int gi = 0; float gmax;
#pragma unroll
            for (int j = 0; j < 4; ++j) lg[j] = a[j] + bg[j];
            gmax = lg[0];
#pragma unroll
            for (int j = 1; j < 4; ++j) if (lg[j] > gmax) { gmax = lg[j]; gi = j; }
            float gsum = 0.f;
#pragma unroll
            for (int j = 0; j < 4; ++j) gsum += __expf(lg[j] - gmax);
            const float gtop = 1.f / gsum;
            float le[4];
#pragma unroll
            for (int e = 0; e < 4; ++e) { float s = 0.f;
#pragma unroll
                for (int j = 0; j < 4; ++j) s = (gi == j) ? (a[4 + 4 * j + e] + br[4 * j + e]) : s;
                le[e] = s; }
            int i1 = 0; float m1 = le[0];
#pragma unroll
            for (int e = 1; e < 4; ++e) if (le[e] > m1) { m1 = le[e]; i1 = e; }
            int i2 = -1; float m2 = -INFINITY;
#pragma unroll
            for (int e = 0; e < 4; ++e) if (e != i1 && le[e] > m2) { m2 = le[e]; i2 = e; }
            const float p2 = __expf(m2 - m1); w1 = gtop / (1.f + p2); w2 = gtop * p2 / (1.f + p2);
            e1 = gi * 4 + i1; e2 = gi * 4 + i2;
            r1 = __hip_atomic_fetch_add(lcnt + e1, 1u, __ATOMIC_RELAXED, __HIP_MEMORY_SCOPE_WORKGROUP); r2 = __hip_atomic_fetch_add(lcnt + e2, 1u, __ATOMIC_RELAXED, __HIP_MEMORY_SCOPE_WORKGROUP);
        }
        __syncthreads();
        if (tid < 16) lbase[tid] = __hip_atomic_fetch_add(cnt + CNT_STRIDE * tid, lcnt[tid], __ATOMIC_RELAXED, __HIP_MEMORY_SCOPE_AGENT);
        __syncthreads();
        if (tid < 64 && rep == 0) { const int m = row0 + tid; const int p1 = (int)(lbase[e1] + r1), q2 = (int)(lbase[e2] + r2);
            list[(size_t)e1 * T_ + p1] = m; listw[(size_t)e1 * T_ + p1] = w1; list[(size_t)e2 * T_ + q2] = m; listw[(size_t)e2 * T_ + q2] = w2;
            toke[2 * m] = e1; toke[2 * m + 1] = e2; tokp[2 * m] = p1; tokp[2 * m + 1] = q2; }
        xn_tile(X, gn, ws, row0, rstd_l, wave, lane);
        __syncthreads();
    }
}

template <bool NORM>
__device__ __forceinline__ void phase_combine(float* X, const float* gn, unsigned char* ws, unsigned* cnt, int G, int vcu, int rep) {
    int tid_ = threadIdx.x; asm volatile("" : "+v"(tid_)); const int tid = tid_, lane = tid & 63, wave = __builtin_amdgcn_readfirstlane(tid >> 6);
    const int gw = vcu * NWAVES + wave, NGW = G * NWAVES;
    int sb[NEXP]; { int pre = 0;
#pragma unroll
        for (int e = 0; e < NEXP; ++e) { sb[e] = pre * 256; pre += ((int)__builtin_amdgcn_readfirstlane(__hip_atomic_load(cnt + CNT_STRIDE * e, __ATOMIC_RELAXED, __HIP_MEMORY_SCOPE_AGENT)) + 255) >> 8; } }
    const int* toke = (const int*)(ws + WS_TOKE); const int* tokp = (const int*)(ws + WS_TOKP); const bf16* Y = (const bf16*)(ws + WS_Y);
    const GAS unsigned long long* te8 = (const GAS unsigned long long*)toke; const GAS unsigned long long* tp8 = (const GAS unsigned long long*)tokp;
    for (int m0 = gw; m0 < T_; m0 += 2 * NGW) {
        unsigned long long ee[2], pp[2]; int mm[2]; bool ok[2];
#pragma unroll
        for (int r = 0; r < 2; ++r) { mm[r] = m0 + r * NGW; ok[r] = mm[r] < T_; if (!ok[r]) mm[r] = m0; ee[r] = te8[mm[r]]; pp[r] = tp8[mm[r]]; }
        f32x4 v[2][4]; unsigned long long ya[2][4], yb[2][4];
#pragma unroll
        for (int r = 0; r < 2; ++r) { const int e1 = (int)(ee[r] & 0xffffffffu), e2 = (int)(ee[r] >> 32), p1 = (int)(pp[r] & 0xffffffffu), p2 = (int)(pp[r] >> 32); int s1 = 0, s2 = 0;
#pragma unroll
            for (int e = 0; e < NEXP; ++e) { s1 = (e == e1) ? sb[e] + p1 : s1; s2 = (e == e2) ? sb[e] + p2 : s2; }
            const GAS f32x4* xr = (const GAS f32x4*)(X + (size_t)mm[r] * DM_) + lane;
            const GAS unsigned long long* y1 = (const GAS unsigned long long*)(Y + (size_t)s1 * 1024) + lane; const GAS unsigned long long* y2 = (const GAS unsigned long long*)(Y + (size_t)s2 * 1024) + lane;
#pragma unroll
            for (int j = 0; j < 4; ++j) { v[r][j] = xr[64 * j]; ya[r][j] = y1[64 * j]; yb[r][j] = y2[64 * j]; } }
#pragma unroll
        for (int r = 0; r < 2; ++r) { if (!ok[r]) continue;
            GAS f32x4* xw = (GAS f32x4*)(X + (size_t)mm[r] * DM_) + lane; float ss = 0.f;
#pragma unroll
            for (int j = 0; j < 4; ++j) { const unsigned long long a = ya[r][j], b = yb[r][j]; f32x4 t = v[r][j];
                t.x += bf2f((unsigned short)(a & 0xffff)) + bf2f((unsigned short)(b & 0xffff)); t.y += bf2f((unsigned short)((a >> 16) & 0xffff)) + bf2f((unsigned short)((b >> 16) & 0xffff));
                t.z += bf2f((unsigned short)((a >> 32) & 0xffff)) + bf2f((unsigned short)((b >> 32) & 0xffff)); t.w += bf2f((unsigned short)(a >> 48)) + bf2f((unsigned short)(b >> 48));
                if (rep == 0) xw[64 * j] = t; v[r][j] = t; ss += (t.x * t.x + t.y * t.y) + (t.z * t.z + t.w * t.w); }
            if (NORM && rep == 0) {
                const float rstd = __builtin_amdgcn_rsqf(wave_sum(ss) * (1.f / DM_) + EPS_);
                GAS unsigned long long* o8 = (GAS unsigned long long*)(ws + WS_XN + (size_t)mm[r] * DM_ * 2) + lane;
#pragma unroll
                for (int j = 0; j < 4; ++j) { const f32x4 g4 = *((const GAS f32x4*)gn + 64 * j + lane); const f32x4 t = v[r][j];
                    o8[64 * j] = (unsigned long long)pk2(t.x * rstd * g4.x, t.y * rstd * g4.y) | ((unsigned long long)pk2(t.z * rstd * g4.z, t.w * rstd * g4.w) << 32); }
            }
        }
    }
}

__device__ __forceinline__ void unpack8(const v4u q, float (&f)[8]) { f[0] = bf2f((unsigned short)(q.x & 0xffff)); f[1] = bf2f((unsigned short)(q.x >> 16)); f[2] = bf2f((unsigned short)(q.y & 0xffff)); f[3] = bf2f((unsigned short)(q.y >> 16));
    f[4] = bf2f((unsigned short)(q.z & 0xffff)); f[5] = bf2f((unsigned short)(q.z >> 16)); f[6] = bf2f((unsigned short)(q.w & 0xffff)); f[7] = bf2f((unsigned short)(q.w >> 16)); }
__device__ __forceinline__ void phase_mix1(const bf16* H1, const float* conv_w, bf16* MIX, int G, int vcu) {
    int tid_ = threadIdx.x; asm volatile("" : "+v"(tid_)); const int gt = vcu * NTHR + tid_, NGT = G * NTHR;
    for (int idx = gt; idx < (T_ / 16) * 128; idx += NGT) {
        const int cgp = idx & 127, m0 = (idx >> 7) * 16, t0 = m0 & (SEQ_ - 1); const bf16* hr = H1 + (size_t)m0 * 2048;
        if (cgp < 64) { const int ch = cgp * 8; float z1[8], z2[8], w[3][8];
#pragma unroll
            for (int tap = 0; tap < 3; ++tap) { const f32x4 w0 = *(const GAS f32x4*)(conv_w + tap * 512 + ch), w1 = *(const GAS f32x4*)(conv_w + tap * 512 + ch + 4);
                w[tap][0] = w0.x; w[tap][1] = w0.y; w[tap][2] = w0.z; w[tap][3] = w0.w; w[tap][4] = w1.x; w[tap][5] = w1.y; w[tap][6] = w1.z; w[tap][7] = w1.w; }
#pragma unroll
            for (int e = 0; e < 8; ++e) { z1[e] = 0.f; z2[e] = 0.f; }
            if (t0 >= 2) { float a[8], b[8]; unpack8(*(const GAS v4u*)(hr - 2048 + 512 + ch), a); unpack8(*(const GAS v4u*)(hr - 2048 + 1024 + ch), b);
#pragma unroll
                for (int e = 0; e < 8; ++e) z1[e] = a[e] * b[e];
                unpack8(*(const GAS v4u*)(hr - 4096 + 512 + ch), a); unpack8(*(const GAS v4u*)(hr - 4096 + 1024 + ch), b);
#pragma unroll
                for (int e = 0; e < 8; ++e) z2[e] = a[e] * b[e]; }
#pragma unroll 4
            for (int i = 0; i < 16; ++i) { const bf16* r = hr + (size_t)i * 2048; float bgv[8], cgv[8], hcv[8], o[8];
                unpack8(*(const GAS v4u*)(r + ch), bgv); unpack8(*(const GAS v4u*)(r + 512 + ch), cgv); unpack8(*(const GAS v4u*)(r + 1024 + ch), hcv);
#pragma unroll
                for (int e = 0; e < 8; ++e) { const float z0 = cgv[e] * hcv[e]; o[e] = bgv[e] * (w[0][e] * z2[e] + w[1][e] * z1[e] + w[2][e] * z0); z2[e] = z1[e]; z1[e] = z0; }
                v4u q; q.x = pk2(o[0], o[1]); q.y = pk2(o[2], o[3]); q.z = pk2(o[4], o[5]); q.w = pk2(o[6], o[7]);
                *(GAS v4u*)(MIX + (size_t)(m0 + i) * 1024 + ch) = q; }
        } else { const int pc = (cgp - 64) * 8, gi = pc >> 7, win = 2 << gi; float s[8];
#pragma unroll
            for (int e = 0; e < 8; ++e) s[e] = 0.f;
            const int nb = (t0 < win - 1) ? t0 : win - 1;
            for (int d = 1; d <= nb; ++d) { float pv[8]; unpack8(*(const GAS v4u*)(hr - (size_t)d * 2048 + 1536 + pc), pv);
#pragma unroll
                for (int e = 0; e < 8; ++e) s[e] += pv[e]; }
#pragma unroll 4
            for (int i = 0; i < 16; ++i) { const int t = t0 + i; const bf16* r = hr + (size_t)i * 2048; float cur[8], o[8];
                unpack8(*(const GAS v4u*)(r + 1536 + pc), cur);
                const int n = (t + 1 < win) ? t + 1 : win; const float inv = 1.f / (float)n;
#pragma unroll
                for (int e = 0; e < 8; ++e) { s[e] += cur[e]; o[e] = s[e] * inv - cur[e]; }
                if (t + 1 >= win) { float old[8]; unpack8(*(const GAS v4u*)(r - (size_t)(win - 1) * 2048 + 1536 + pc), old);
#pragma unroll
                    for (int e = 0; e < 8; ++e) s[e] -= old[e]; }
                v4u q; q.x = pk2(o[0], o[1]); q.y = pk2(o[2], o[3]); q.z = pk2(o[4], o[5]); q.w = pk2(o[6], o[7]);
                *(GAS v4u*)(MIX + (size_t)(m0 + i) * 1024 + 512 + pc) = q; }
        }
    }
}
struct Args { const float* in[24]; float* out; unsigned char* ws; int ph_lo, ph_hi, rep, pad; };
__global__ void __launch_bounds__(NTHR, 2) hybrid_fwd(Args args) {
    extern __shared__ __attribute__((aligned(16))) unsigned char lds_raw[];
    LAS unsigned char* lds = (LAS unsigned char*)lds_raw;
    volatile LAS unsigned* MISC = (volatile LAS unsigned*)(lds + MISC_OFF);
    const int tid = threadIdx.x;
    const int G = gridDim.x; const int bx = blockIdx.x; const int vcu = (G % 8 == 0) ? (bx % 8) * (G / 8) + bx / 8 : bx;
    struct KIn { __device__ __forceinline__ const float* operator[](int k) const { const volatile __attribute__((address_space(4))) unsigned long long* ka = (const volatile __attribute__((address_space(4))) unsigned long long*)__builtin_amdgcn_kernarg_segment_ptr(); return (const float*)(const GAS float*)ka[k]; } };
    const KIn in;
#define out ((float*)in[24])
#define ws ((unsigned char*)in[25])
#define XN ((bf16*)(ws + WS_XN))
#define MIX ((bf16*)(ws + WS_MIX))
#define HID ((bf16*)(ws + WS_HID))
#define Y ((bf16*)(ws + WS_Y))
#define F2 ((float*)(ws + WS_F2))
#define ctl ((gu32*)(ws + WS_CTL))
    for (int u = tid; u < (LDS_BYTES - LDSCTL_OFF) / 4; u += NTHR) ((LAS unsigned*)(lds + LDSCTL_OFF))[u] = 0u;
    __syncthreads();
#if MK_USE_CG
    cooperative_groups::grid_group grid = cooperative_groups::this_grid();
#define GRID_BAR() grid.sync()
#else
    XcdBarrier bar; bar.bar = (unsigned*)(ctl + CW_BAR); bar.x = 0; bar.st = nullptr;
    if (MK_N_LAUNCHES == 1) bar = xcd_barrier_post((unsigned*)(ctl + CW_BAR), MISC + 8);
#define GRID_BAR() xcd_barrier(bar)
#endif
    const int lo = args.ph_lo, hi = args.ph_hi;
#ifndef PH_MASK
#define PH_MASK 0x1ffff
#endif
#define IN(k) (((PH_MASK >> (k)) & 1) && lo <= (k) && (k) < hi)
#define SEAM(k) do { if (IN(k) && IN((k) + 1)) GRID_BAR(); } while (0)

    if (IN(0)) { p0_prologue(in, ws, lds, G, vcu); }
    SEAM(0);
    if (IN(1)) {
        if (bx >= G - NBH && G > NBH && args.rep == 0) { scan_seq(F2 + (size_t)(bx - (G - NBH)) * SEQ_, (LAS float*)(lds + MISC_OFF + 64)); }
        pg8::ProbPlain S; S.init(XN, ws + WS_WIN0, T_, EV_N, 1024, G, bx);
        EpiInproj0 E{(bf16*)(ws + WS_U), (bf16*)(ws + WS_V), (bf16*)(ws + WS_Q), (bf16*)(ws + WS_K), (bf16*)(ws + WS_VAL), in[6], in[7], in[8]};
        pg8::gemm_phase<EpiInproj0, pg8::ProbPlain, true>(lds, S, E);
        { const int nfull = S.nwg % G, nidle = G - nfull;
          if (nfull > 0 && bx >= nfull) { const int wv_ = __builtin_amdgcn_readfirstlane(tid >> 6);
              convert_items(in, ws, (LAS float*)(lds + wv_ * 16384), TR_I0, TR_P1_END, (bx - nfull) * NWAVES + wv_, nidle * NWAVES, tid & 63); }
          else if (nfull == 0) { const int wv_ = __builtin_amdgcn_readfirstlane(tid >> 6); convert_items(in, ws, (LAS float*)(lds + wv_ * 16384), TR_I0, TR_P1_END, bx * NWAVES + wv_, G * NWAVES, tid & 63); } }
    }
    SEAM(1);
    if (IN(2)) {
#if MK_NAIVE_ATTN
        naive_attn((const bf16*)(ws + WS_Q), (const bf16*)(ws + WS_K), (const bf16*)(ws + WS_VAL), F2, MIX, vcu * NTHR + tid, G * NTHR);
        for (int u = bx; u < 512; u += G) gmlp_unit(u, (const bf16*)(ws + WS_U), (const bf16*)(ws + WS_V), (const bf16*)(ws + WS_WST), in[5], MIX, lds);
#else
        float skipthr, bmax; { const float gq = fabsf(in[7][tid & 63]), gk = fabsf(in[8][tid & 63]); float mq = gq, mk = gk;
#pragma unroll
            for (int o = 1; o < 64; o <<= 1) { mq = fmaxf(mq, __shfl_xor(mq, o)); mk = fmaxf(mk, __shfl_xor(mk, o)); }
            bmax = 1.02f * (0.125f * LOG2E * 64.f) * mq * mk; skipthr = 40.f + 2.f * bmax; }
        for (;;) {
            if (tid == 0) MISC[0] = __hip_atomic_fetch_add((unsigned*)(ctl + CW_Q + 16 * args.rep), 1u, __ATOMIC_RELAXED, __HIP_MEMORY_SCOPE_AGENT);
            __syncthreads();
            const int u = (int)MISC[0];
            __syncthreads();
            if (u >= 768 + 512) break;
            if (u < 768) { const int qb = 15 - u / NBH, bh = u % NBH;
                attn_body::attn_unit<8>(bh / NHEADS, bh % NHEADS, qb, (const attn_body::bf16*)(ws + WS_Q), (const attn_body::bf16*)(ws + WS_K), (const attn_body::bf16*)(ws + WS_VAL),
                                        (attn_body::bf16*)(ws + WS_MIX) + 256, F2 + (size_t)bh * SEQ_, skipthr, bmax, (char*)lds_raw); }
            else gmlp_unit(u - 768, (const bf16*)(ws + WS_U), (const bf16*)(ws + WS_V), (const bf16*)(ws + WS_WST), in[5], MIX, lds);
        }
#endif
    }
    SEAM(2);
    if (IN(3)) {
        pg8::ProbPlain S; S.init(MIX, ws + WS_WOUT0, T_, 1024, 1024, G, bx);
        EpiResF32 E{in[0], out};
        pg8::gemm_phase<EpiResF32, pg8::ProbPlain, false>(lds, S, E);
    }
    SEAM(3);
#define MOE_LAYER(layer, pb, cntw) do { \
        unsigned* cnt = (unsigned*)(ctl + (cntw)); \
          \
        if (IN(pb)) phase_route(in, layer, out, ws, args.rep ? (unsigned*)(ctl + CW_CNTD) : cnt, lds, G, vcu, args.rep); \
        SEAM(pb); \
        const char* wgu_ = (const char*)(ws + WS_WGU) + (size_t)(layer) * NEXP * 512 * 1024 * 2; const char* wd_ = (const char*)(ws + WS_WD) + (size_t)(layer) * NEXP * 1024 * 256 * 2; \
          \
        if (IN((pb) + 1)) { const int MT = moe_mtiles(cnt), NG = 2 * MT; \
            ProbMoe S{(const char*)XN, wgu_, 1024, 2, cnt, (const int*)(ws + WS_LIST), true, (size_t)512 * 1024 * 2, 0, NG < G ? NG : G, G, bx}; \
            EpiGateUp E{HID, (const float*)(ws + WS_LISTW)}; \
            pg8::gemm_phase<EpiGateUp, ProbMoe, true>(lds, S, E); } \
        SEAM((pb) + 1); \
          \
        if (IN((pb) + 2)) { const int MT = moe_mtiles(cnt), NG = 2 * MT, n2 = NG > G ? NG - G : 0, MT1 = (NG < G ? NG : G) / 2, Ge = G - n2, dl = 4 * MT1 < 2 * Ge ? 4 * MT1 : 2 * Ge; \
            if (bx < n2) { ProbMoe S{(const char*)XN, wgu_, 1024, 2, cnt, (const int*)(ws + WS_LIST), true, (size_t)512 * 1024 * 2, G, NG, G, bx}; \
                EpiGateUp E{HID, (const float*)(ws + WS_LISTW)}; \
                pg8::gemm_phase<EpiGateUp, ProbMoe, true>(lds, S, E); } \
            else { ProbMoe S{(const char*)HID, wd_, 256, 4, cnt, nullptr, false, (size_t)1024 * 256 * 2, 0, dl, Ge, bx - n2}; \
                EpiBf16 E{Y, 1024}; \
                pg8::gemm_phase<EpiBf16, ProbMoe, true>(lds, S, E); } } \
        SEAM((pb) + 2); \
          \
        if (IN((pb) + 3)) { const int MT = moe_mtiles(cnt), NG = 2 * MT, n2 = NG > G ? NG - G : 0, MT1 = (NG < G ? NG : G) / 2, Ge = G - n2, dl = 4 * MT1 < 2 * Ge ? 4 * MT1 : 2 * Ge, nd2 = 4 * MT - dl; \
            ProbMoe S{(const char*)HID, wd_, 256, 4, cnt, nullptr, false, (size_t)1024 * 256 * 2, dl, 4 * MT, G, bx}; \
            EpiBf16 E{Y, 1024}; \
            pg8::gemm_phase<EpiBf16, ProbMoe, true>(lds, S, E); \
            if ((layer) == 0) { const int wv_ = __builtin_amdgcn_readfirstlane((int)threadIdx.x >> 6); const int nid_ = nd2 < G ? G - nd2 : 0; \
                if (nid_ > 0) { if (bx >= nd2) { convert_items(in, ws, (LAS float*)(lds + wv_ * 16384), TR_A_END, TR_NITEMS, (bx - nd2) * NWAVES + wv_, nid_ * NWAVES, (int)threadIdx.x & 63); fold_items(in, ws, (bx - nd2) * NWAVES + wv_, nid_ * NWAVES, (int)threadIdx.x & 63); } } \
                else { convert_items(in, ws, (LAS float*)(lds + wv_ * 16384), TR_A_END, TR_NITEMS, bx * NWAVES + wv_, G * NWAVES, (int)threadIdx.x & 63); fold_items(in, ws, bx * NWAVES + wv_, G * NWAVES, (int)threadIdx.x & 63); } } } \
        SEAM((pb) + 3); \
          \
        if (IN((pb) + 4)) { if ((layer) == 0) phase_combine<true>(out, in[10], ws, cnt, G, vcu, args.rep); else phase_combine<false>(out, nullptr, ws, cnt, G, vcu, args.rep); } \
    } while (0)
    MOE_LAYER(0, 4, CW_CNT0);
    SEAM(8);
    if (IN(9)) {
        pg8::ProbPlain S; S.init(XN, ws + WS_WIN1, T_, 2048, 1024, G, bx);
        EpiBf16 E{(bf16*)(ws + WS_H1), 2048};
        pg8::gemm_phase<EpiBf16, pg8::ProbPlain, true>(lds, S, E);
    }
    SEAM(9);
    if (IN(10)) phase_mix1((const bf16*)(ws + WS_H1), in[12], MIX, G, vcu);
    SEAM(10);
    if (IN(11)) {
        pg8::ProbPlain S; S.init(MIX, ws + WS_WOUT1, T_, 1024, 1024, G, bx);
        EpiResF32 E{out, out};
        pg8::gemm_phase<EpiResF32, pg8::ProbPlain, false>(lds, S, E);
    }
    SEAM(11);
    MOE_LAYER(1, 12, CW_CNT1);
#undef MOE_LAYER
#undef XN
#undef MIX
#undef HID
#undef Y
#undef F2
#undef ctl
#undef out
#undef ws
#undef IN
#undef SEAM
#undef GRID_BAR
}

extern "C" void kernel_launch(void* const* d_in, const int* in_sizes, int n_in, void* d_out, int out_size, void* d_ws, size_t ws_size, hipStream_t stream) {
    static int grid = 0;
    if (grid == 0) {
        if (n_in != 24 || in_sizes[0] != T_ * DM_ || out_size != T_ * DM_ || ws_size < WS_END) { fprintf(stderr, "kernel_launch: unexpected shapes (n_in %d, in0 %d, out %d, ws %zu); nothing launched\n", n_in, n_in > 0 ? in_sizes[0] : -1, out_size, ws_size); grid = -1; return; }
        int dev = 0, cus = 0, per_cu = 0;
        if (hipGetDevice(&dev) != hipSuccess || hipDeviceGetAttribute(&cus, hipDeviceAttributeMultiprocessorCount, dev) != hipSuccess) { fprintf(stderr, "kernel_launch: device query failed\n"); grid = -1; return; }
        if (hipFuncSetAttribute((const void*)hybrid_fwd, hipFuncAttributeMaxDynamicSharedMemorySize, LDS_BYTES) != hipSuccess) { fprintf(stderr, "kernel_launch: hipFuncSetAttribute failed\n"); grid = -1; return; }
        if (hipOccupancyMaxActiveBlocksPerMultiprocessor(&per_cu, (const void*)hybrid_fwd, NTHR, LDS_BYTES) != hipSuccess || per_cu < 1) { fprintf(stderr, "kernel_launch: occupancy query reports %d workgroups per CU\n", per_cu); per_cu = 1; }
        (void)hipGetLastError();
        grid = cus;
    }
    if (grid < 0) return;
    if (hipMemsetAsync((char*)d_ws + WS_CTL, 0, CTL_ZERO_BYTES, stream) != hipSuccess) { fprintf(stderr, "kernel_launch: memset failed\n"); return; }
    Args a{};
    for (int i = 0; i < 24; ++i) a.in[i] = (const float*)d_in[i];
    a.out = (float*)d_out; a.ws = (unsigned char*)d_ws;
#if MK_N_LAUNCHES == 1
    a.ph_lo = 0; a.ph_hi = NPH;
#if MK_USE_CG
    void* kargs[] = {&a};
    hipError_t e = hipLaunchCooperativeKernel((const void*)hybrid_fwd, dim3(grid), dim3(NTHR), kargs, LDS_BYTES, stream);
    if (e != hipSuccess) fprintf(stderr, "kernel_launch: cooperative launch failed: %s (grid %d)\n", hipGetErrorString(e), grid);
#else
    hipLaunchKernelGGL(hybrid_fwd, dim3(grid), dim3(NTHR), LDS_BYTES, stream, a);
#endif
#else
    for (int p = 0; p < NPH; ++p) { a.ph_lo = p; a.ph_hi = p + 1; a.rep = 0; hipLaunchKernelGGL(hybrid_fwd, dim3(grid), dim3(NTHR), LDS_BYTES, stream, a);
        if ((MK_REPEAT_MASK >> p) & 1) { a.rep = MK_REP_MODE; hipLaunchKernelGGL(hybrid_fwd, dim3(grid), dim3(NTHR), LDS_BYTES, stream, a); } }
#endif
}
```

```cpp
#include <hip/hip_runtime.h>
#include <hip/hip_cooperative_groups.h>
#include <hip/hip_bf16.h>
#include <cstdio>
#include <cstdint>
#include <cmath>

#ifndef MK_N_LAUNCHES
#define MK_N_LAUNCHES 1
#endif
#ifndef MK_USE_CG
#define MK_USE_CG 0
#endif
#ifndef MK_NAIVE_ATTN
#define MK_NAIVE_ATTN 0
#endif
#ifndef MK_REPEAT_MASK
#define MK_REPEAT_MASK 0
#endif
#ifndef MK_REP_MODE
#define MK_REP_MODE 1
#endif
namespace pg8 {
#define PG8_LAS __attribute__((address_space(3)))
typedef unsigned short bf16_t;
typedef short bf16x8 __attribute__((ext_vector_type(8)));
typedef float f32x4 __attribute__((ext_vector_type(4)));
typedef unsigned u32x4 __attribute__((ext_vector_type(4)));
constexpr int BM = 256, BK = 64, HALF = 128, HTB = HALF * BK * 2  , STAGE_BYTES = 8 * HTB, NXCD = 8, WGM = 8;

__host__ __device__ __forceinline__ int lds_byte(int r, int c) { const int st = (r >> 4) * 2 + (c >> 5), rr = r & 15, cc = c & 31, ob = rr * 64 + cc * 2; return st * 1024 + (ob ^ (((ob >> 9) & 1) << 5)); }
__host__ __device__ __forceinline__ void stage_rc(int b, int& R, int& C) { const int st = b / 1024, sb = b % 1024, swz = sb ^ (((sb >> 9) & 1) << 5); R = (st >> 1) * 16 + swz / 64; C = (st & 1) * 32 + (swz % 64) / 2; }
__host__ __device__ __forceinline__ int perm32(int rho) { const int n = rho >> 4, i = rho & 15; return 8 * (i >> 2) + 4 * n + (i & 3); }

struct Unit { int pm, pn, e, j, cnt; };

__device__ __forceinline__ unsigned cvt_pk_bf16(float lo, float hi) { unsigned r; asm volatile("v_cvt_pk_bf16_f32 %0, %1, %2" : "=v"(r) : "v"(lo), "v"(hi)); return r; }

struct ProbPlain {
    const char* A; const char* Bt; int K, nM, nN, nwg, G, c;
    __device__ __forceinline__ void init(const void* A_, const void* Bt_, int M, int N, int K_, int G_, int c_) { A = (const char*)A_; Bt = (const char*)Bt_; K = K_; nM = M / BM; nN = N / BM; nwg = nM * nN; G = G_; c = c_; }
    __device__ __forceinline__ bool next(int i, Unit& u) const {
        const long L = (long)i * G + c; if (L >= nwg) return false;
        int wgid = (int)L; { const int q = nwg / NXCD, r = nwg % NXCD, xcd = wgid % NXCD, off = wgid / NXCD; wgid = (xcd < r ? xcd * (q + 1) : r * (q + 1) + (xcd - r) * q) + off; }
        const int nig = WGM * nN, gid = wgid / nig, fm = gid * WGM, gsz = (nM - fm) < WGM ? (nM - fm) : WGM;
        u.pm = fm + ((wgid % nig) % gsz); u.pn = (wgid % nig) / gsz; u.e = 0; u.j = 0; u.cnt = 0; return true;
    }
    __device__ __forceinline__ unsigned a_off(const Unit& u, int row) const { return (unsigned)(u.pm * BM + row) * (unsigned)(K * 2); }
    __device__ __forceinline__ const char* b_base(const Unit& u) const { return Bt + (size_t)u.pn * BM * K * 2; }
};

template <class Epi, class Prob, bool ALIGN_EPI>
__device__ __forceinline__ void gemm_phase(PG8_LAS unsigned char* lds, const Prob& S, const Epi& E) {
    int tid_ = threadIdx.x; asm volatile("" : "+v"(tid_)); const int tid = tid_, wid = __builtin_amdgcn_readfirstlane(tid >> 6), lane = tid & 63, wr = wid >> 2, wc = wid & 3, fr = lane & 15, fq = lane >> 4;
    const int K = S.K, nt = K / BK;
    int Rr[2], Cb[2]; unsigned voffB[2];
#pragma unroll
    for (int i = 0; i < 2; ++i) { int R, C; stage_rc(tid * 16 + i * 8192, R, C); const int Rb = Epi::PERM ? ((R & ~31) + perm32(R & 31)) : R;
        Rr[i] = R; Cb[i] = C * 2; voffB[i] = (unsigned)(Rb * K + C) * 2u; }
    const size_t kstep = (size_t)(BK * 2);
    const size_t hstep = (size_t)HALF * K * 2;
    const unsigned ldsw = (unsigned)wid * 1024u;
    const int aoff = lds_byte(wr * 64 + fr, fq * 8), boff = lds_byte(wc * 32 + fr, fq * 8);
#define PG8_SA(b, h) (((b) * 2 + (h)) * HTB)
#define PG8_SB(b, h) ((4 + (b) * 2 + (h)) * HTB)
#define PG8_STAGE(bufoff, gbase, voff) do { _Pragma("unroll") for (int _i = 0; _i < 2; ++_i) \
        __builtin_amdgcn_global_load_lds((const unsigned*)((const char*)(gbase) + (voff)[_i]), (PG8_LAS unsigned*)(lds + (bufoff) + ldsw + _i * 8192), 16, 0, 0); } while (0)
#define PG8_LDA(dst, b, h) do { _Pragma("unroll") for (int m = 0; m < 4; ++m) _Pragma("unroll") for (int k = 0; k < 2; ++k) dst[m][k] = *(const PG8_LAS bf16x8*)(lds + PG8_SA(b, h) + aoff + m * 2048 + k * 1024); } while (0)
#define PG8_LDB(dst, b, h) do { _Pragma("unroll") for (int n = 0; n < 2; ++n) _Pragma("unroll") for (int k = 0; k < 2; ++k) dst[n][k] = *(const PG8_LAS bf16x8*)(lds + PG8_SB(b, h) + boff + n * 2048 + k * 1024); } while (0)
#define PG8_MMA(ai, bj, At, Bt) do { __builtin_amdgcn_s_setprio(1); _Pragma("unroll") for (int m = 0; m < 4; ++m) _Pragma("unroll") for (int n = 0; n < 2; ++n) _Pragma("unroll") for (int k = 0; k < 2; ++k) \
        acc[ai][bj][m][n] = __builtin_amdgcn_mfma_f32_16x16x32_bf16(Bt[n][k], At[m][k], acc[ai][bj][m][n], 0, 0, 0); __builtin_amdgcn_s_setprio(0); } while (0)
#define PG8_WAIT_V(n) asm volatile("s_waitcnt vmcnt(" #n ")" ::: "memory")
#define PG8_WAIT_L(n) asm volatile("s_waitcnt lgkmcnt(" #n ")" ::: "memory")
#define PG8_BAR __builtin_amdgcn_s_barrier()
#define PG8_SCHED __builtin_amdgcn_sched_barrier(0)
    Unit cur, nxt; int ui = 0;
    if (!S.next(0, cur)) return;
    f32x4 acc[2][2][4][2];
#pragma unroll
    for (int a = 0; a < 2; ++a)
#pragma unroll
        for (int b = 0; b < 2; ++b)
#pragma unroll
            for (int m = 0; m < 4; ++m)
#pragma unroll
                for (int n = 0; n < 2; ++n) acc[a][b][m][n] = (f32x4){0.f, 0.f, 0.f, 0.f};
    bf16x8 At[4][2], B0[2][2], B1[2][2];
    const char* const Ab = S.A;
    unsigned cA0[2], cA1[2], nA0[2], nA1[2];
#pragma unroll
    for (int i = 0; i < 2; ++i) { cA0[i] = S.a_off(cur, Rr[i]) + (unsigned)Cb[i]; cA1[i] = S.a_off(cur, Rr[i] + HALF) + (unsigned)Cb[i]; }
    const char* cB = S.b_base(cur);
    PG8_STAGE(PG8_SB(0, 0), cB, voffB); PG8_STAGE(PG8_SB(0, 1), cB + hstep, voffB); PG8_STAGE(PG8_SA(0, 0), Ab, cA0); PG8_STAGE(PG8_SA(0, 1), Ab, cA1);
    if (wr == 1) PG8_BAR;
    PG8_WAIT_V(2); PG8_BAR;
    PG8_STAGE(PG8_SB(1, 0), cB + kstep, voffB); PG8_STAGE(PG8_SA(1, 0), Ab + kstep, cA0); PG8_STAGE(PG8_SB(1, 1), cB + hstep + kstep, voffB);
    PG8_WAIT_V(6); PG8_BAR;
    for (;;) {
        const bool has_next = S.next(ui + 1, nxt);
        const char* nB = cB;
#pragma unroll
        for (int i = 0; i < 2; ++i) { nA0[i] = cA0[i]; nA1[i] = cA1[i]; }
        if (has_next) { nB = S.b_base(nxt);
#pragma unroll
            for (int i = 0; i < 2; ++i) { nA0[i] = S.a_off(nxt, Rr[i]) + (unsigned)Cb[i]; nA1[i] = S.a_off(nxt, Rr[i] + HALF) + (unsigned)Cb[i]; } }
        for (int t = 0; t < nt; t += 2) {
            const bool last = (t == nt - 2);
            const char* a1 = Ab + (size_t)(t + 1) * kstep;
            const char* a2 = last ? Ab : Ab + (size_t)(t + 2) * kstep; const char* b2 = last ? nB : cB + (size_t)(t + 2) * kstep;
            const char* a3 = a2 + kstep; const char* b3 = b2 + kstep;
            unsigned x0[2], x1[2];
#pragma unroll
            for (int i = 0; i < 2; ++i) { x0[i] = last ? nA0[i] : cA0[i]; x1[i] = last ? nA1[i] : cA1[i]; }
            PG8_LDB(B0, 0, 0); PG8_LDB(B1, 0, 1); PG8_SCHED; PG8_LDA(At, 0, 0); PG8_STAGE(PG8_SA(1, 1), a1, cA1);
            PG8_WAIT_V(8); PG8_WAIT_L(0); PG8_BAR; PG8_MMA(0, 0, At, B0); PG8_MMA(0, 1, At, B1); PG8_BAR; PG8_SCHED;
            PG8_LDA(At, 0, 1); PG8_STAGE(PG8_SB(0, 0), b2, voffB); PG8_STAGE(PG8_SB(0, 1), b2 + hstep, voffB); PG8_STAGE(PG8_SA(0, 0), a2, x0);
            PG8_WAIT_V(8); PG8_WAIT_L(0); PG8_BAR; PG8_MMA(1, 0, At, B0); PG8_MMA(1, 1, At, B1); PG8_BAR; PG8_SCHED;
            PG8_LDB(B0, 1, 0); PG8_LDB(B1, 1, 1); PG8_SCHED; PG8_LDA(At, 1, 0); PG8_STAGE(PG8_SA(0, 1), a2, x1);
            PG8_WAIT_V(8); PG8_WAIT_L(0); PG8_BAR; PG8_MMA(0, 0, At, B0); PG8_MMA(0, 1, At, B1); PG8_BAR; PG8_SCHED;
            PG8_LDA(At, 1, 1); PG8_STAGE(PG8_SB(1, 0), b3, voffB); PG8_STAGE(PG8_SB(1, 1), b3 + hstep, voffB); PG8_STAGE(PG8_SA(1, 0), a3, x0);
            PG8_WAIT_V(8); PG8_WAIT_L(0); PG8_BAR; PG8_MMA(1, 0, At, B0); PG8_MMA(1, 1, At, B1); PG8_BAR; PG8_SCHED;
        }
        if constexpr (ALIGN_EPI) { if (wr == 0) PG8_BAR; }
        E(acc, cur, wr, wc, fr, fq);
        if (!has_next) break;
#pragma unroll
        for (int a = 0; a < 2; ++a)
#pragma unroll
            for (int b = 0; b < 2; ++b)
#pragma unroll
                for (int m = 0; m < 4; ++m)
#pragma unroll
                    for (int n = 0; n < 2; ++n) acc[a][b][m][n] = (f32x4){0.f, 0.f, 0.f, 0.f};
        cur = nxt; cB = nB; ++ui;
#pragma unroll
        for (int i = 0; i < 2; ++i) { cA0[i] = nA0[i]; cA1[i] = nA1[i]; }
        if constexpr (ALIGN_EPI) { if (wr == 1) PG8_BAR; }
    }
    PG8_WAIT_V(0);
    if constexpr (!ALIGN_EPI) { if (wr == 0) PG8_BAR; }
    PG8_BAR;
#undef PG8_SA
#undef PG8_SB
#undef PG8_STAGE
#undef PG8_LDA
#undef PG8_LDB
#undef PG8_MMA
#undef PG8_WAIT_V
#undef PG8_WAIT_L
#undef PG8_BAR
#undef PG8_SCHED
}
}
namespace attn_body {
using bf16=__hip_bfloat16;
using bf16x8=__attribute__((ext_vector_type(8)))short;
using s16x4=__attribute__((ext_vector_type(4)))short;
using f32x16=__attribute__((ext_vector_type(16)))float;
using u32x4=__attribute__((ext_vector_type(4)))unsigned;
using f32x4v=__attribute__((ext_vector_type(4)))float;
constexpr int BATCH=4,NHEAD=12,SEQ=4096,D=64;
constexpr int QP=768,KP=768,VP=768,OP=1024;
constexpr int NW=8,QBLK=32,QB=QBLK*NW,KVBLK=64,NQB=SEQ/QB;
constexpr int ATTN_UNIT_ROWS=QB;
__device__ __forceinline__ int crow(int r,int hi){return (r&3)+8*(r>>2)+4*hi;}
#define SBAR() __builtin_amdgcn_sched_barrier(0)
__device__ __forceinline__ void cmask(f32x16&p0,f32x16&p1,int jb,int qrel,int hi){
  const float NEG=-INFINITY; int kb=64*jb+4*hi;
  #pragma unroll
  for(int r=0;r<16;++r){int kv=kb+(r&3)+8*(r>>2); if(kv>qrel)p0[r]=NEG; if(kv+32>qrel)p1[r]=NEG;}
}

constexpr int NSLOT=3, SLOTB=8192;
constexpr int LDS_K=0, LDS_V=NSLOT*SLOTB, LDS_WS=2*NSLOT*SLOTB, LDS_OST=LDS_WS+NW*64*4, LDS_BYTES=LDS_OST+NW*4096, LDS_F=86016, LDS_F_BYTES=16384;
constexpr float C2=0.125f*1.4426950408889634f;
__device__ __forceinline__ void glds16(const void*gsrc,unsigned lds_dst){unsigned keep;
  asm volatile("s_mov_b32 %0, m0\n\ts_mov_b32 m0, %2\n\ts_nop 0\n\tglobal_load_lds_dwordx4 %1, off\n\ts_mov_b32 m0, %0":"=&s"(keep):"v"(gsrc),"s"(lds_dst):"memory");}
__device__ __forceinline__ float max3f(float a,float b,float c){float r;asm("v_max3_f32 %0, %1, %2, %3":"=v"(r):"v"(a),"v"(b),"v"(c));return r;}
__device__ __forceinline__ float max2f(float a,float b){float r;asm("v_max_f32_e32 %0, %1, %2":"=v"(r):"v"(a),"v"(b));return r;}
__device__ __forceinline__ float fadd_s(float a,float b){float r;asm("v_add_f32_e32 %0, %1, %2":"=v"(r):"v"(a),"v"(b));return r;}
__device__ __forceinline__ float fsub_s(float a,float b){float r;asm("v_sub_f32_e32 %0, %1, %2":"=v"(r):"v"(a),"v"(b));return r;}
typedef float f32x2_t __attribute__((ext_vector_type(2))); typedef __bf16 bf16x2_t __attribute__((ext_vector_type(2)));
__device__ __forceinline__ unsigned cvtpk_s(float lo,float hi){f32x2_t v={lo,hi};bf16x2_t b=__builtin_convertvector(v,bf16x2_t);return __builtin_bit_cast(unsigned,b);}
#define WAIT_BAR(N) asm volatile("s_waitcnt vmcnt(" #N ") lgkmcnt(0)\n\ts_barrier":::"memory")

__device__ __forceinline__ void qkt(f32x16&p0,f32x16&p1,const char*Kslot,const bf16x8*qr,int r32,int hi){
  const char*kb=Kslot+hi*1024+r32*16;
  #pragma unroll
  for(int d0=0;d0<4;++d0){
    const bf16x8 b0=*reinterpret_cast<const bf16x8*>(kb+d0*2048);
    const bf16x8 b1=*reinterpret_cast<const bf16x8*>(kb+d0*2048+512);
    p0=__builtin_amdgcn_mfma_f32_32x32x16_bf16(b0,qr[d0],p0,0,0,0);p1=__builtin_amdgcn_mfma_f32_32x32x16_bf16(b1,qr[d0],p1,0,0,0);}
}
typedef __attribute__((address_space(3))) const char* lds_cptr;
typedef short v4i16_t __attribute__((ext_vector_type(4)));
__device__ __forceinline__ void kload8(bf16x8*kf,lds_cptr kp){
  kf[0]=*(const __attribute__((address_space(3))) bf16x8*)(kp);      kf[1]=*(const __attribute__((address_space(3))) bf16x8*)(kp+512);
  kf[2]=*(const __attribute__((address_space(3))) bf16x8*)(kp+2048); kf[3]=*(const __attribute__((address_space(3))) bf16x8*)(kp+2560);
  kf[4]=*(const __attribute__((address_space(3))) bf16x8*)(kp+4096); kf[5]=*(const __attribute__((address_space(3))) bf16x8*)(kp+4608);
  kf[6]=*(const __attribute__((address_space(3))) bf16x8*)(kp+6144); kf[7]=*(const __attribute__((address_space(3))) bf16x8*)(kp+6656);
}
__device__ __forceinline__ void kload2(bf16x8*kf,lds_cptr kp,int j){ kf[2*j]=*(const __attribute__((address_space(3))) bf16x8*)(kp+j*2048); kf[2*j+1]=*(const __attribute__((address_space(3))) bf16x8*)(kp+j*2048+512); }
__device__ __forceinline__ s16x4 vtr(lds_cptr p){ return __builtin_bit_cast(s16x4,__builtin_amdgcn_ds_read_tr16_b64_v4i16((__attribute__((address_space(3))) v4i16_t*)p)); }
__device__ __forceinline__ float rowmax(const f32x16&p0,const f32x16&p1){
  float a=max3f(p0[0],p0[1],p1[0]),b=max3f(p0[2],p0[3],p1[1]);a=max3f(a,p1[2],p1[3]);
  #pragma unroll
  for(int r=4;r<16;r+=4){a=max3f(a,p0[r],p0[r+1]);b=max3f(b,p0[r+2],p0[r+3]);a=max3f(a,p1[r],p1[r+1]);b=max3f(b,p1[r+2],p1[r+3]);}
  const float m=max2f(a,b);
  auto rr=__builtin_amdgcn_permlane32_swap(__float_as_uint(m),__float_as_uint(m),false,false);
  return max2f(__uint_as_float(rr[0]),__uint_as_float(rr[1]));
}
__device__ __forceinline__ void pv(f32x16*o,int vb,bf16x8 pa0,bf16x8 pa1,bf16x8 pa2,bf16x8 pa3){
  #pragma unroll
  for(int d0=0;d0<2;++d0){s16x4 lo[4],hi[4];
    #pragma unroll
    for(int ks=0;ks<4;++ks){
      asm volatile("ds_read_b64_tr_b16 %0,%1 offset:%c2":"=&v"(lo[ks]):"v"(vb),"i"(d0*4096+ks*1024):"memory");
      asm volatile("ds_read_b64_tr_b16 %0,%1 offset:%c2":"=&v"(hi[ks]):"v"(vb),"i"(d0*4096+ks*1024+512):"memory");}
    asm volatile("s_waitcnt lgkmcnt(0)":::"memory");SBAR();
    #define PK(k) (bf16x8){lo[k][0],lo[k][1],lo[k][2],lo[k][3],hi[k][0],hi[k][1],hi[k][2],hi[k][3]}
    o[d0]=__builtin_amdgcn_mfma_f32_32x32x16_bf16(pa0,PK(0),o[d0],0,0,0);
    o[d0]=__builtin_amdgcn_mfma_f32_32x32x16_bf16(pa1,PK(1),o[d0],0,0,0);
    o[d0]=__builtin_amdgcn_mfma_f32_32x32x16_bf16(pa2,PK(2),o[d0],0,0,0);
    o[d0]=__builtin_amdgcn_mfma_f32_32x32x16_bf16(pa3,PK(3),o[d0],0,0,0);
    #undef PK
  }
}

#ifndef ATTN_STORE16
#define ATTN_STORE16(p,v) (*(u32x4*)(p)=(v))
#endif
template<int THRL> __device__ __forceinline__ void attn_unit(int b,int h,int qb,const bf16*Q,const bf16*__restrict__ K,const bf16*__restrict__ V,bf16*O,const float*F2seq,float skipthr,float bmax,char*shm){
  int tid_ = threadIdx.x; asm volatile("" : "+v"(tid_)); const int tid = tid_,lane=tid&63,r32=lane&31,hi=lane>>5; const int wid=__builtin_amdgcn_readfirstlane(tid>>6);
  const long rowbase=(long)b*SEQ; const int q0=qb*QB;
  int ts=0; { const int nb=q0>>6; bool c_=false; if(lane<nb) c_=(F2seq[q0]-F2seq[64*(lane+1)-1])<-skipthr; ts=__builtin_amdgcn_readfirstlane((int)__popcll(__ballot(c_))&~1); }
  typedef __attribute__((address_space(3))) float* lds_fptr; typedef __attribute__((address_space(3))) f32x4v* lds_f4ptr;
  const lds_fptr Fl=(lds_fptr)(shm+LDS_F);
  { const f32x4v*Fg=(const f32x4v*)(F2seq+64*ts); const int nF=(q0+QB-64*ts)>>2; for(int i=tid;i<nF;i+=NW*64)((lds_f4ptr)Fl)[i]=Fg[i]; }
  const float fq2=F2seq[q0+wid*QBLK+r32];
  const bf16*Qw=Q+(rowbase+q0+wid*QBLK)*QP+h*D;
  const bf16*Kh=K+(rowbase+64*ts)*KP+h*D,*Vh=V+(rowbase+64*ts)*VP+h*D;
  const unsigned lds0=(unsigned)(uintptr_t)shm;
  float*wsf=(float*)(shm+LDS_WS)+wid*64;
  const bf16*ksrc=Kh+(long)lane*KP+wid*8;
  const bf16*vsrc=Vh+(long)(16*(wid&3)+(lane>>2))*VP+(wid>>2)*32+(lane&3)*8;
  const unsigned kdst=lds0+LDS_K+wid*1024, vdst=lds0+LDS_V+wid*1024;
  #define DMA_K(t,slot) glds16(ksrc+(long)(t)*KVBLK*KP,(unsigned)__builtin_amdgcn_readfirstlane(kdst+(slot)))
  #define DMA_V(t,slot) glds16(vsrc+(long)(t)*KVBLK*VP,(unsigned)__builtin_amdgcn_readfirstlane(vdst+(slot)))
  const int vb0=(int)(lds0+LDS_V)+((lane>>4)&1)*32+(lane&3)*8+(4*hi+((lane&15)>>2))*64;
  const char*Kbase=shm+LDS_K; bf16x8 kf[8];
  const lds_cptr shm3=(lds_cptr)shm; const lds_cptr kp0=shm3+LDS_K+hi*1024+r32*16; const lds_cptr vp0=shm3+LDS_V+((lane>>4)&1)*32+(lane&3)*8+(4*hi+((lane&15)>>2))*64;
  const int NT=(q0+QB)/KVBLK-ts;
  DMA_K(0,0);DMA_V(0,0);DMA_K(1,SLOTB);
  bf16x8 qr[4];
  #pragma unroll
  for(int d0=0;d0<4;++d0)qr[d0]=*reinterpret_cast<const bf16x8*>(&Qw[(long)r32*QP+d0*16+hi*8]);
  float mhat=bmax,l_reg=0.f;
  f32x16 o[2];o[0]=f32x16{};o[1]=f32x16{};
  #define BIAS(C0,C1,t) do{ const float nb_=fq2-mhat; const lds_fptr fk_=Fl+64*(t)+4*hi; \
    _Pragma("unroll") for(int j_=0;j_<4;++j_){ const f32x4v a_=*(const lds_f4ptr)(fk_+8*j_); const f32x4v c_=*(const lds_f4ptr)(fk_+32+8*j_); \
      C0[4*j_]=nb_-a_.x; C0[4*j_+1]=nb_-a_.y; C0[4*j_+2]=nb_-a_.z; C0[4*j_+3]=nb_-a_.w; C1[4*j_]=nb_-c_.x; C1[4*j_+1]=nb_-c_.y; C1[4*j_+2]=nb_-c_.z; C1[4*j_+3]=nb_-c_.w; } }while(0)
  const int qrel=wid*QBLK+r32;
  #define CMASK(P0,P1,t) do{int jb_=(t)-(NT-4); if(jb_>=0)cmask(P0,P1,jb_,qrel,hi);}while(0)
  bool resc=false;
  #define START(P0,P1) do{ const float rm=rowmax(P0,P1); resc=false; \
    { const float dl=max2f(rm,0.f); mhat=fadd_s(mhat,dl); \
      _Pragma("unroll") for(int r=0;r<16;++r){P0[r]=fsub_s(P0[r],dl);P1[r]=fsub_s(P1[r],dl);} } \
    _Pragma("unroll") for(int r=0;r<16;++r)P0[r]=__builtin_amdgcn_exp2f(P0[r]); }while(0)
  #define RESC() do{ if(resc){ asm volatile("s_waitcnt lgkmcnt(0)":::"memory"); \
      _Pragma("unroll") for(int d_=0;d_<2;++d_) _Pragma("unroll") for(int r=0;r<16;++r)o[d_][r]*=wsf[crow(r,hi)]; } }while(0)
  f32x16 pA0,pA1,pB0,pB1;
  int sl_prev=0,sl_cur=0,sl_next=SLOTB;
  #define ROT() do{sl_prev=sl_cur;sl_cur=sl_next;sl_next=(sl_next==(NSLOT-1)*SLOTB)?0:sl_next+SLOTB;}while(0)
  DMA_K(2,2*SLOTB);
  WAIT_BAR(3);
  BIAS(pA0,pA1,0); qkt(pA0,pA1,Kbase,qr,r32,hi);asm volatile("s_nop 15\n\ts_nop 7":"+v"(pA0),"+v"(pA1));CMASK(pA0,pA1,0);
  START(pA0,pA1);
  _Pragma("unroll") for(int r=0;r<16;++r)pA1[r]=__builtin_amdgcn_exp2f(pA1[r]);
  WAIT_BAR(0);
  DMA_K(3,0);DMA_V(1,SLOTB);
  ROT();
  kload8(kf,kp0+sl_cur);
  WAIT_BAR(2);
  s16x4 vlo[8],vhi[8]; u32x4 pw0,pw1,pw2,pw3;
  #define PKW(P,B) cvtpk_s(P[B],P[B+1])
  #define PAF(k) __builtin_bit_cast(bf16x8,pw##k)
  #define VFR(i) (bf16x8){vlo[i][0],vlo[i][1],vlo[i][2],vlo[i][3],vhi[i][0],vhi[i][1],vhi[i][2],vhi[i][3]}
  #define PIN(x) asm volatile("":"+v"(x))
  #define MX3(a,b,c) __builtin_fmaxf(__builtin_fmaxf((a),(b)),(c))
  #define GAPA(MF,A0,A1,A2,A3,W0,W1,PW) do{ MF; sacc+=A0; sacc+=A1; sacc+=A2; sacc+=A3; PIN(sacc); W0; W1; PIN(PW); SBAR(); }while(0)
  #define EX(v) __builtin_amdgcn_exp2f(v)
  #define GAPB(MF,X,B) do{ MF; X[B]=EX(X[B]); X[B+1]=EX(X[B+1]); X[B+2]=EX(X[B+2]); X[B+3]=EX(X[B+3]); PIN(X); SBAR(); }while(0)
  #define VRD(i) do{ vlo[i]=vtr(vp_+(((i)>>2)*4096+((i)&3)*1024)); vhi[i]=vtr(vp_+(((i)>>2)*4096+((i)&3)*1024+512)); }while(0)
  #define KRD(G,j) do{ if(G){ kload2(kf,kp0+sl_next,j); SBAR(); } }while(0)
  #define STEP(C0,C1,P0,P1,t,GK,GV,GL) do{ BIAS(C0,C1,t); SBAR(); \
    const lds_cptr vp_=vp0+sl_prev; \
    VRD(0); SBAR(); float sacc=(P0[0]+P0[1]); \
    GAPA(C0=__builtin_amdgcn_mfma_f32_32x32x16_bf16(kf[0],qr[0],C0,0,0,0), P0[2],P0[3],P0[4],P0[5],     pw0[0]=PKW(P0,0), pw0[1]=PKW(P0,2), pw0); \
    VRD(4); SBAR(); GAPA(C1=__builtin_amdgcn_mfma_f32_32x32x16_bf16(kf[1],qr[0],C1,0,0,0), P0[6],P0[7],P0[8],P0[9],     pw0[2]=PKW(P0,4), pw0[3]=PKW(P0,6), pw0); \
    VRD(1); SBAR(); GAPA(C0=__builtin_amdgcn_mfma_f32_32x32x16_bf16(kf[2],qr[1],C0,0,0,0),   P0[10],P0[11],P0[12],P0[13], pw1[0]=PKW(P0,8), pw1[1]=PKW(P0,10), pw1); \
    VRD(5); SBAR(); GAPA(C1=__builtin_amdgcn_mfma_f32_32x32x16_bf16(kf[3],qr[1],C1,0,0,0),   P0[14],P0[15],P1[0],P1[1],   pw1[2]=PKW(P0,12),pw1[3]=PKW(P0,14), pw1); \
    VRD(2); SBAR(); GAPA(C0=__builtin_amdgcn_mfma_f32_32x32x16_bf16(kf[4],qr[2],C0,0,0,0),   P1[2],P1[3],P1[4],P1[5],     pw2[0]=PKW(P1,0), pw2[1]=PKW(P1,2), pw2); \
    VRD(6); SBAR(); GAPA(C1=__builtin_amdgcn_mfma_f32_32x32x16_bf16(kf[5],qr[2],C1,0,0,0),   P1[6],P1[7],P1[8],P1[9],     pw2[2]=PKW(P1,4), pw2[3]=PKW(P1,6), pw2); \
    VRD(3); SBAR(); GAPA(C0=__builtin_amdgcn_mfma_f32_32x32x16_bf16(kf[6],qr[3],C0,0,0,0),   P1[10],P1[11],P1[12],P1[13], pw3[0]=PKW(P1,8), pw3[1]=PKW(P1,10), pw3); \
    VRD(7); SBAR(); GAPA(C1=__builtin_amdgcn_mfma_f32_32x32x16_bf16(kf[7],qr[3],C1,0,0,0),   P1[14],P1[15],0.f,0.f,       pw3[2]=PKW(P1,12),pw3[3]=PKW(P1,14), pw3); \
    l_reg+=sacc; \
    if(GK){DMA_K((t)+3,sl_cur);} if(GV){DMA_V((t)+1,sl_next);} \
    CMASK(C0,C1,t); \
    { float a=MX3(C0[0],C0[1],C1[0]),b=MX3(C0[2],C0[3],C1[1]); a=MX3(a,C1[2],C1[3]); \
      _Pragma("unroll") for(int r=4;r<16;r+=4){a=MX3(a,C0[r],C0[r+1]);b=MX3(b,C0[r+2],C0[r+3]);a=MX3(a,C1[r],C1[r+1]);b=MX3(b,C1[r+2],C1[r+3]);} \
      float rm=__builtin_fmaxf(a,b); { auto rr=__builtin_amdgcn_permlane32_swap(__float_as_uint(rm),__float_as_uint(rm),false,false); rm=__builtin_fmaxf(__uint_as_float(rr[0]),__uint_as_float(rr[1])); } \
      resc=false; \
      if(__builtin_expect(__any(rm>(float)THRL),0)){ const float dl=__builtin_fmaxf(rm,0.f); mhat+=dl; \
        _Pragma("unroll") for(int r=0;r<16;++r){C0[r]-=dl;C1[r]-=dl;} \
        const float f=__builtin_amdgcn_exp2f(-dl); l_reg*=f; if(hi==0)wsf[r32]=f; resc=true; } } \
    SBAR(); \
    GAPB(o[0]=__builtin_amdgcn_mfma_f32_32x32x16_bf16(PAF(0),VFR(0),o[0],0,0,0), C0,0); \
    GAPB(o[1]=__builtin_amdgcn_mfma_f32_32x32x16_bf16(PAF(0),VFR(4),o[1],0,0,0), C0,4); \
    KRD(GL,0); GAPB(o[0]=__builtin_amdgcn_mfma_f32_32x32x16_bf16(PAF(1),VFR(1),o[0],0,0,0), C0,8); \
    KRD(GL,1); GAPB(o[1]=__builtin_amdgcn_mfma_f32_32x32x16_bf16(PAF(1),VFR(5),o[1],0,0,0), C0,12); \
    KRD(GL,2); GAPB(o[0]=__builtin_amdgcn_mfma_f32_32x32x16_bf16(PAF(2),VFR(2),o[0],0,0,0), C1,0); \
    KRD(GL,3); GAPB(o[1]=__builtin_amdgcn_mfma_f32_32x32x16_bf16(PAF(2),VFR(6),o[1],0,0,0), C1,4); \
    GAPB(o[0]=__builtin_amdgcn_mfma_f32_32x32x16_bf16(PAF(3),VFR(3),o[0],0,0,0), C1,8); \
    GAPB(o[1]=__builtin_amdgcn_mfma_f32_32x32x16_bf16(PAF(3),VFR(7),o[1],0,0,0), C1,12); \
    }while(0)
  int t=1;
  #undef CMASK
  #define CMASK(P0,P1,t) do{}while(0)
  for(;t+5<NT;t+=2){
    STEP(pB0,pB1,pA0,pA1,t,true,true,true);     WAIT_BAR(2); RESC(); ROT();
    STEP(pA0,pA1,pB0,pB1,t+1,true,true,true);   WAIT_BAR(2); RESC(); ROT();
  }
  #undef CMASK
  #define CMASK(P0,P1,t) do{int jb_=(t)-(NT-4); if(jb_>=0)cmask(P0,P1,jb_,qrel,hi);}while(0)
  #define ENDW(tt) do{ if((tt)+3<NT){WAIT_BAR(2);} else if((tt)+2<NT){WAIT_BAR(1);} else {WAIT_BAR(0);} }while(0)
  for(;t+1<NT;t+=2){
    STEP(pB0,pB1,pA0,pA1,t,(t+3<NT),(t+1<NT),(t+1<NT));       ENDW(t);   RESC(); ROT();
    STEP(pA0,pA1,pB0,pB1,t+1,(t+4<NT),(t+2<NT),(t+2<NT));     ENDW(t+1); RESC(); ROT();
  }
  STEP(pB0,pB1,pA0,pA1,NT-1,false,false,false); RESC();
  { float sacc=pB0[0]+pB0[1]; _Pragma("unroll") for(int r=2;r<16;++r)sacc+=pB0[r]; _Pragma("unroll") for(int r=0;r<16;++r)sacc+=pB1[r]; l_reg+=sacc;
    pw0=(u32x4){PKW(pB0,0),PKW(pB0,2),PKW(pB0,4),PKW(pB0,6)};pw1=(u32x4){PKW(pB0,8),PKW(pB0,10),PKW(pB0,12),PKW(pB0,14)};pw2=(u32x4){PKW(pB1,0),PKW(pB1,2),PKW(pB1,4),PKW(pB1,6)};pw3=(u32x4){PKW(pB1,8),PKW(pB1,10),PKW(pB1,12),PKW(pB1,14)};
    SBAR(); pv(o,vb0+sl_cur,PAF(0),PAF(1),PAF(2),PAF(3)); }
  #undef PKW
  #undef PAF
  #undef VFR
  #undef PIN
  #undef MX3
  #undef GAPA
  #undef GAPB
  #undef EX
  #undef VRD
  #undef KRD
  #undef STEP
  #undef ENDW
  {auto rr=__builtin_amdgcn_permlane32_swap(__float_as_uint(l_reg),__float_as_uint(l_reg),false,false);l_reg=__uint_as_float(rr[0])+__uint_as_float(rr[1]);}
  if(hi==0)wsf[32+r32]=l_reg;asm volatile("s_waitcnt lgkmcnt(0)":::"memory");
  float rli[16];
  #pragma unroll
  for(int r=0;r<16;++r)rli[r]=__builtin_amdgcn_rcpf(wsf[32+crow(r,hi)]);
  bf16*Ow=O+(rowbase+q0+wid*QBLK)*OP+h*D;
  { bf16*stg=(bf16*)(shm+LDS_OST)+wid*2048;
    #pragma unroll
    for(int r=0;r<16;++r){const int orow=crow(r,hi);
      #pragma unroll
      for(int d0=0;d0<2;++d0)stg[orow*64+d0*32+r32]=__float2bfloat16(o[d0][r]*rli[r]);}
    asm volatile("s_waitcnt lgkmcnt(0)":::"memory");
    #pragma unroll
    for(int i=0;i<4;++i){const int row=i*8+(lane>>3),ch=lane&7; const u32x4 v=*(const u32x4*)(stg+row*64+ch*8); ATTN_STORE16(Ow+(long)row*OP+ch*8,v);} }
  asm volatile("s_waitcnt lgkmcnt(0)\n\ts_barrier":::"memory");
  #undef DMA_K
  #undef DMA_V
  #undef CMASK
  #undef START
  #undef RESC
  #undef BIAS
  #undef ROT
}
constexpr int ATTN_LDS_BYTES=LDS_F+LDS_F_BYTES;
#undef SBAR
#undef WAIT_BAR
}
#define GAS __attribute__((address_space(1)))
#define LAS __attribute__((address_space(3)))
typedef unsigned short bf16;
typedef unsigned v4u __attribute__((ext_vector_type(4)));
typedef float f32x4 __attribute__((ext_vector_type(4)));
typedef short bf16x8 __attribute__((ext_vector_type(8)));
typedef GAS unsigned gu32;
typedef GAS unsigned long long gu64;
#define RLX_AGENT __ATOMIC_RELAXED, __HIP_MEMORY_SCOPE_AGENT
#define LDS_WAIT() asm volatile("s_waitcnt lgkmcnt(0)" ::: "memory")
#define VM_WAIT() asm volatile("s_waitcnt vmcnt(0)" ::: "memory")
__device__ __forceinline__ unsigned long long rt() { return __builtin_amdgcn_s_memrealtime(); }
__device__ __forceinline__ unsigned f2bf(float f) { unsigned u = __builtin_bit_cast(unsigned, f); return (u + 0x7fffu + ((u >> 16) & 1u)) >> 16; }
__device__ __forceinline__ unsigned pk2(float lo, float hi) { return f2bf(lo) | (f2bf(hi) << 16); }

#define XB_TMO      128
#define XB_XCNT(j)  (256  + 64 * (j))
#define XB_XSUB(j)  (1280 + 64 * (j))
#define XB_XGEN(j)  (2304 + 64 * (j))
#define XB_TOP      3328
#define XB_TOPGEN   3392
#define XCD_BAR_WORDS 3456
#define XB_SPIN_CAP (1u << 18)

__device__ __forceinline__ unsigned xb_ld(unsigned* p)              { return __hip_atomic_load(p, __ATOMIC_RELAXED, __HIP_MEMORY_SCOPE_AGENT); }
__device__ __forceinline__ unsigned xb_add(unsigned* p, unsigned v) { return __hip_atomic_fetch_add(p, v, __ATOMIC_RELAXED, __HIP_MEMORY_SCOPE_AGENT); }
__device__ __forceinline__ unsigned xb_xcc_id() { return (unsigned)__builtin_amdgcn_s_getreg((3 << 11) | 20) & 0xFu; }
#define XB_SPIN(cond, bar) do { unsigned _sp = 0; while (cond) { __builtin_amdgcn_s_sleep(1); \
    if ((++_sp & 255u) == 0u) { if (xb_ld(&(bar)[XB_TMO])) break; if (_sp > XB_SPIN_CAP) { atomicAdd(&(bar)[XB_TMO], 1u); break; } } } } while (0)

struct XcdBarrier {
    unsigned* bar; unsigned x;
    volatile LAS unsigned* st;
};

__device__ __forceinline__ XcdBarrier xcd_barrier_post(unsigned* bar, volatile LAS unsigned* st) {
    XcdBarrier b; b.bar = bar; b.x = xb_xcc_id(); b.st = st;
    if (threadIdx.x == 0) (void)xb_add(&bar[XB_XCNT(b.x)], 1u);
    return b;
}
__device__ __forceinline__ void xcd_barrier_complete(unsigned* bar, unsigned x, unsigned& nloc, unsigned& nx) {
    const unsigned G = gridDim.x * gridDim.y * gridDim.z;
    unsigned sum, cnt, mine, sp = 0u;
    for (;;) {
        sum = 0u; cnt = 0u; mine = 0u;
#pragma unroll
        for (unsigned j = 0; j < 16; ++j) { const unsigned c = xb_ld(&bar[XB_XCNT(j)]); sum += c; cnt += (c > 0u) ? 1u : 0u; mine = (j == x) ? c : mine; }
        if (sum == G) break;
        __builtin_amdgcn_s_sleep(1);
        if ((++sp & 255u) == 0u) { if (xb_ld(&bar[XB_TMO])) break; if (sp > XB_SPIN_CAP) { atomicAdd(&bar[XB_TMO], 1u); break; } }
    }
    nloc = mine > 0u ? mine : 1u; nx = cnt > 0u ? cnt : 1u;
}

__device__ __forceinline__ void xcd_barrier(const XcdBarrier& b) {
    asm volatile("s_waitcnt vmcnt(0)" ::: "memory");
    __syncthreads();
    if (threadIdx.x == 0) {
        unsigned* bar = b.bar;
        __builtin_amdgcn_s_waitcnt(0);
        unsigned nloc = b.st[0], nx = b.st[1];
        if (nloc == 0u) { xcd_barrier_complete(bar, b.x, nloc, nx); b.st[0] = nloc; b.st[1] = nx; }
        const unsigned old = xb_add(&bar[XB_XSUB(b.x)], 1u);
        const unsigned gen = old / nloc;
        if (old + 1u == (gen + 1u) * nloc) {
            __builtin_amdgcn_fence(__ATOMIC_RELEASE, "agent");
            asm volatile("s_waitcnt vmcnt(0)" ::: "memory");
            const unsigned og = xb_add(&bar[XB_TOP], 1u);
            const unsigned tg = og / nx;
            if (og + 1u == (tg + 1u) * nx) xb_add(&bar[XB_TOPGEN], 1u);
            else XB_SPIN(xb_ld(&bar[XB_TOPGEN]) == tg, bar);
            __builtin_amdgcn_fence(__ATOMIC_ACQUIRE, "agent");
            xb_add(&bar[XB_XGEN(b.x)], 1u);
            asm volatile("s_waitcnt vmcnt(0)" ::: "memory");
        } else {
            XB_SPIN(xb_ld(&bar[XB_XGEN(b.x)]) == gen, bar);
            __builtin_amdgcn_fence(__ATOMIC_ACQUIRE, "agent");
            asm volatile("s_waitcnt vmcnt(0)" ::: "memory");
        }
    }
    __syncthreads();
}
constexpr int NWAVES = 8, NTHR = NWAVES * 64;
constexpr int T_ = 16384, DM_ = 1024, SEQ_ = 4096, NBH = 48, NHEADS = 12;
constexpr int EV_LD = 2828, EV_N = 2816;
constexpr int NEXP = 16, EHID = 256, SLOTS = 36864;
constexpr float EPS_ = 1e-6f, LOG2E = 1.4426950408889634f;
constexpr int NPH = 17;
constexpr size_t MiB = 1u << 20;
constexpr size_t WS_CTL = 0, CTL_ZERO_BYTES = 1 * MiB;
constexpr size_t WS_WIN0 = 1 * MiB, WS_WOUT0 = 7 * MiB, WS_WIN1 = 9 * MiB, WS_WOUT1 = 13 * MiB, WS_WST = 15 * MiB, WS_WGU = 16 * MiB, WS_WD = 48 * MiB;
constexpr size_t WS_XN = 64 * MiB;
constexpr size_t WS_A = 96 * MiB;
constexpr size_t WS_U = WS_A, WS_V = WS_A + 8 * MiB, WS_Q = WS_A + 16 * MiB, WS_K = WS_A + 40 * MiB, WS_VAL = WS_A + 64 * MiB;
constexpr size_t WS_Y = WS_A, WS_H1 = WS_A;
constexpr size_t WS_MIX = 184 * MiB;
constexpr size_t WS_HID = 216 * MiB;
constexpr size_t WS_F2 = 234 * MiB, WS_LIST = 235 * MiB, WS_LISTW = 236 * MiB, WS_TOKE = 237 * MiB, WS_TOKP = 237 * MiB + 512 * 1024, WS_LISTR = 238 * MiB, WS_END = 240 * MiB;
static_assert(WS_Y + (size_t)SLOTS * 1024 * 2 <= WS_MIX && WS_HID + (size_t)SLOTS * 256 * 2 <= WS_F2 && WS_VAL + (size_t)T_ * 768 * 2 <= WS_MIX, "ws map");
constexpr int CW_TMO = 0, CW_BAR = 4096, CW_Q = 8192, CW_CNT0 = 16384, CW_CNT1 = 16384 + 1024, CW_CNTD = 16384 + 2048, CNT_STRIDE = 64;
constexpr int RING_BYTES = 131072, LDSCTL_OFF = RING_BYTES, MISC_OFF = LDSCTL_OFF + 320, LDS_BYTES = 147456;

__device__ __forceinline__ float wave_sum(float v) {
#pragma unroll
    for (int o = 1; o < 64; o <<= 1) v += __shfl_xor(v, o);
    return v;
}
__device__ __forceinline__ float fast_sigmoid(float z) { return __builtin_amdgcn_rcpf(1.f + __builtin_amdgcn_exp2f(-z * LOG2E)); }
__device__ __forceinline__ float gelu_tanh(float x) { const float z = 1.5957691216057308f * x * (1.f + 0.044715f * x * x); return x * fast_sigmoid(z); }
__device__ __forceinline__ float bf2f(unsigned short h) { return __builtin_bit_cast(float, (unsigned)h << 16); }


constexpr int TP = 1028;
template <int NC>
__device__ __forceinline__ void skinny_core(const float* X, int row0, const LAS float* wt, LAS float* part, LAS float* ssq, int wave, int lane) {
    const int rg = wave & 3, kh = wave >> 2, r = lane & 15, kq = lane >> 4, col = lane & 15;
    const GAS float* xp = (const GAS float*)X + (size_t)(row0 + 16 * rg + r) * DM_ + 512 * kh + 4 * kq;
    const LAS float* b0p = wt + (col < NC ? col : NC - 1) * TP + 512 * kh + 4 * kq;
    const LAS float* b1p = wt + ((NC > 16) ? (16 + (col & 3)) : 0) * TP + 512 * kh + 4 * kq;
    f32x4 acc0 = (f32x4){0.f, 0.f, 0.f, 0.f}, acc1 = (f32x4){0.f, 0.f, 0.f, 0.f}; float ss = 0.f;
#pragma unroll 1
    for (int jb = 0; jb < 2; ++jb) {
        f32x4 xv[16];
#pragma unroll
        for (int jj = 0; jj < 16; ++jj) xv[jj] = *(const GAS f32x4*)(xp + 16 * (16 * jb + jj));
#pragma unroll
        for (int jj = 0; jj < 16; ++jj) { const f32x4 b0 = *(const LAS f32x4*)(b0p + 16 * (16 * jb + jj)); const f32x4 x4 = xv[jj];
            ss += (x4.x * x4.x + x4.y * x4.y) + (x4.z * x4.z + x4.w * x4.w);
            acc0 = __builtin_amdgcn_mfma_f32_16x16x4f32(x4.x, b0.x, acc0, 0, 0, 0); acc0 = __builtin_amdgcn_mfma_f32_16x16x4f32(x4.y, b0.y, acc0, 0, 0, 0);
            acc0 = __builtin_amdgcn_mfma_f32_16x16x4f32(x4.z, b0.z, acc0, 0, 0, 0); acc0 = __builtin_amdgcn_mfma_f32_16x16x4f32(x4.w, b0.w, acc0, 0, 0, 0);
            if (NC > 16) { const f32x4 b1 = *(const LAS f32x4*)(b1p + 16 * (16 * jb + jj));
                acc1 = __builtin_amdgcn_mfma_f32_16x16x4f32(x4.x, b1.x, acc1, 0, 0, 0); acc1 = __builtin_amdgcn_mfma_f32_16x16x4f32(x4.y, b1.y, acc1, 0, 0, 0);
                acc1 = __builtin_amdgcn_mfma_f32_16x16x4f32(x4.z, b1.z, acc1, 0, 0, 0); acc1 = __builtin_amdgcn_mfma_f32_16x16x4f32(x4.w, b1.w, acc1, 0, 0, 0); } }
    }
    ss += __shfl_xor(ss, 16); ss += __shfl_xor(ss, 32);
    if (lane < 16) ssq[kh * 64 + 16 * rg + r] = ss;
#pragma unroll
    for (int i = 0; i < 4; ++i) { LAS float* pr = part + (kh * 64 + 16 * rg + 4 * kq + i) * 32; pr[col] = acc0[i]; if (NC > 16 && col < 4) pr[16 + col] = acc1[i]; }
    __syncthreads();
}
__device__ __forceinline__ void xn_tile(const float* X, const float* gn, unsigned char* ws, int row0, const LAS float* rstd_l, int wave, int lane) {
    f32x4 g4[4];
#pragma unroll
    for (int j = 0; j < 4; ++j) g4[j] = *((const GAS f32x4*)gn + 64 * j + lane);
#pragma unroll 4
    for (int i = 0; i < 8; ++i) { const int m = row0 + 8 * wave + i; const float rstd = rstd_l[8 * wave + i];
        const GAS f32x4* xr = (const GAS f32x4*)(X + (size_t)m * DM_) + lane; GAS unsigned long long* o8 = (GAS unsigned long long*)(ws + WS_XN + (size_t)m * DM_ * 2) + lane;
        f32x4 v[4];
#pragma unroll
        for (int j = 0; j < 4; ++j) v[j] = xr[64 * j];
#pragma unroll
        for (int j = 0; j < 4; ++j) o8[64 * j] = (unsigned long long)pk2(v[j].x * rstd * g4[j].x, v[j].y * rstd * g4[j].y) | ((unsigned long long)pk2(v[j].z * rstd * g4[j].z, v[j].w * rstd * g4[j].w) << 32); }
}
struct TrItem { const float* src; bf16* dst; int ldw2, kp8; };
struct TrSrc { const float *w_in0, *w_out0, *w_in1, *w_out1, *w_gate, *w_up, *w_down; };
constexpr int TR_P1_END = 16 * 88 + 3584;
constexpr int TR_I0 = 16 * 88, TR_I1 = 16 * 32, TR_IE = 16 * 128, TR_I2 = 16 * 64, TR_I3 = 8 * 32, TR_A_END = TR_I0 + TR_I1 + 3 * TR_IE, TR_NITEMS = TR_A_END + TR_I2 + TR_I3 + 3 * TR_IE;
__device__ __forceinline__ TrItem tr_decode(int it, const TrSrc& S, unsigned char* ws, int lane) {
    const float* W; int ldw, Kp, k0, n0, drow0; bf16* WT; int r = it; int layer = 0;
    int seg;
    if (r < TR_I0) seg = 0; else if ((r -= TR_I0) < TR_I1) seg = 1; else if ((r -= TR_I1) < TR_IE) seg = 2; else if ((r -= TR_IE) < TR_IE) seg = 3; else if ((r -= TR_IE) < TR_IE) seg = 4;
    else if ((r -= TR_IE) < TR_I2) seg = 5; else if ((r -= TR_I2) < TR_I3) seg = 6; else { layer = 1; if ((r -= TR_I3) < TR_IE) seg = 2; else if ((r -= TR_IE) < TR_IE) seg = 3; else { r -= TR_IE; seg = 4; } }
    if (seg == 0) { const int kb = r / 88, nb = r % 88, c = (32 * nb) & 255; W = S.w_in0; ldw = EV_LD; WT = (bf16*)(ws + WS_WIN0); Kp = 1024; k0 = 64 * kb; n0 = 32 * nb; drow0 = (n0 & ~255) + 128 * ((c >> 5) & 1) + 32 * (c >> 6); }
    else if (seg == 1) { const int kb = r / 32, nb = r % 32; W = S.w_out0; ldw = 1024; WT = (bf16*)(ws + WS_WOUT0); Kp = 1024; k0 = 64 * kb; n0 = 32 * nb; drow0 = n0; }
    else if (seg == 5) { const int kb = r / 64, nb = r % 64; W = S.w_in1; ldw = 2048; WT = (bf16*)(ws + WS_WIN1); Kp = 1024; k0 = 64 * kb; n0 = 32 * nb; drow0 = n0; }
    else if (seg == 6) { const int kb = r / 32, nb = r % 32; W = S.w_out1; ldw = 1024; WT = (bf16*)(ws + WS_WOUT1); Kp = 1024; k0 = 64 * kb; n0 = 32 * nb; drow0 = n0; }
    else { const int le = layer * NEXP + r / 128, rr = r % 128;
        if (seg == 2) { W = S.w_gate + (size_t)le * 1024 * 256; ldw = 256; WT = (bf16*)(ws + WS_WGU) + (size_t)le * 512 * 1024; Kp = 1024; k0 = 64 * (rr / 8); n0 = 32 * (rr % 8); drow0 = (n0 >> 7) * 256 + (n0 & 127); }
        else if (seg == 3) { W = S.w_up + (size_t)le * 1024 * 256; ldw = 256; WT = (bf16*)(ws + WS_WGU) + (size_t)le * 512 * 1024; Kp = 1024; k0 = 64 * (rr / 8); n0 = 32 * (rr % 8); drow0 = (n0 >> 7) * 256 + 128 + (n0 & 127); }
        else { W = S.w_down + (size_t)le * 256 * 1024; ldw = 1024; WT = (bf16*)(ws + WS_WD) + (size_t)le * 1024 * 256; Kp = 256; k0 = 64 * (rr / 32); n0 = 32 * (rr % 32); drow0 = n0; } }
    TrItem t; t.src = W + (size_t)(k0 + (lane >> 5)) * ldw + n0 + (lane & 31); t.ldw2 = 2 * ldw; t.dst = WT + (size_t)(drow0 + (lane >> 3)) * Kp + k0 + 8 * (lane & 7); t.kp8 = 8 * Kp; return t;
}
template <class IN_T> __device__ __forceinline__ void convert_items(const IN_T in, unsigned char* ws, LAS float* scr, int lo, int hi, int widx, int nw, int lane) {
    TrSrc S{in[2], in[9], in[11], in[15], in[21], in[22], in[23]};
    float tv[32], tn[32]; TrItem cur{nullptr, nullptr, 0, 0};
    if (lo + widx < hi) { cur = tr_decode(lo + widx, S, ws, lane);
#pragma unroll
        for (int i = 0; i < 32; ++i) tv[i] = cur.src[(size_t)i * cur.ldw2]; }
    for (int it = lo + widx; it < hi; it += nw) {
        TrItem nx = cur; const bool more = it + nw < hi;
        if (more) { nx = tr_decode(it + nw, S, ws, lane);
#pragma unroll
            for (int i = 0; i < 32; ++i) tn[i] = nx.src[(size_t)i * nx.ldw2]; }
#pragma unroll
        for (int i = 0; i < 32; ++i) scr[(2 * i + (lane >> 5)) * 33 + (lane & 31)] = tv[i];
        LDS_WAIT(); asm volatile("" ::: "memory");
        const int c = lane & 7;
#pragma unroll
        for (int j = 0; j < 4; ++j) { const LAS float* s = scr + (8 * c) * 33 + (lane >> 3) + 8 * j;
            v4u o; o.x = pk2(s[0 * 33], s[1 * 33]); o.y = pk2(s[2 * 33], s[3 * 33]); o.z = pk2(s[4 * 33], s[5 * 33]); o.w = pk2(s[6 * 33], s[7 * 33]);
            *(GAS v4u*)(cur.dst + (size_t)j * cur.kp8) = o; }
        LDS_WAIT(); asm volatile("" ::: "memory");
        cur = nx;
#pragma unroll
        for (int i = 0; i < 32; ++i) tv[i] = tn[i];
    }
}
template <class IN_T> __device__ __forceinline__ void fold_items(const IN_T in, unsigned char* ws, int widx, int nw, int lane) {
    const float* const w_pool = in[13]; const float* const p_scale = in[14]; const float* const w_out1 = in[15];
    for (int it = widx; it < 4 * 32 * 16; it += nw) {
        const int itu = __builtin_amdgcn_readfirstlane(it), g = itu >> 9, c0 = ((itu >> 4) & 31) * 4, n = (itu & 15) * 64 + lane;
        const float* wp = w_pool + (size_t)(g * 128 + c0) * 128; const float* sc = p_scale + g * 128; const float* wo = w_out1 + (size_t)(512 + g * 128) * 1024 + n;
        float a[4];
#pragma unroll
        for (int c = 0; c < 4; ++c) a[c] = 0.f;
#pragma unroll 32
        for (int d = 0; d < 128; ++d) { const float t = sc[d] * wo[(size_t)d * 1024];
#pragma unroll
            for (int c = 0; c < 4; ++c) a[c] += wp[c * 128 + d] * t; }
        *(GAS unsigned long long*)((bf16*)(ws + WS_WOUT1) + (size_t)n * 1024 + 512 + g * 128 + c0) = (unsigned long long)pk2(a[0], a[1]) | ((unsigned long long)pk2(a[2], a[3]) << 32); }
}
template <class IN_T> __device__ __forceinline__ void p0_prologue(const IN_T in, unsigned char* ws, LAS unsigned char* lds, int G, int vcu) {
    int tid_ = threadIdx.x; asm volatile("" : "+v"(tid_)); const int tid = tid_, lane = tid & 63, wave = __builtin_amdgcn_readfirstlane(tid >> 6);
    const int gw = vcu * NWAVES + wave, NGW = G * NWAVES;
    convert_items(in, ws, (LAS float*)(lds + wave * 16384), 0, TR_I0, gw, NGW, lane); convert_items(in, ws, (LAS float*)(lds + wave * 16384), TR_P1_END, TR_A_END, gw, NGW, lane);
    const int gt = vcu * NTHR + tid, NGT = G * NTHR;
    { const float* const w_s = in[4]; for (int i = gt; i < 4 * 128 * 128; i += NGT) { const int s = i & 127, t = (i >> 7) & 127; ((GAS bf16*)(ws + WS_WST))[i] = (s <= t) ? (bf16)f2bf(w_s[i]) : (bf16)0; } }
    __syncthreads();
    LAS float* wf = (LAS float*)lds; LAS float* part = (LAS float*)(lds + 98304); LAS float* ssq = part + 2 * 64 * 32; LAS float* rstd_l = ssq + 128;
    const float* const x = in[0]; const float* const gn = in[1]; const float* const b_forget = in[3];
    { const float* const w_in0 = in[2];
#pragma unroll
      for (int kk = 0; kk < 2; ++kk) { const int k = tid + NTHR * kk; const GAS f32x4* src = (const GAS f32x4*)(w_in0 + (size_t)k * EV_LD + EV_N); const f32x4 q0 = src[0], q1 = src[1], q2 = src[2]; const float g = gn[k];
          wf[0 * TP + k] = q0.x * g; wf[1 * TP + k] = q0.y * g; wf[2 * TP + k] = q0.z * g; wf[3 * TP + k] = q0.w * g; wf[4 * TP + k] = q1.x * g; wf[5 * TP + k] = q1.y * g; wf[6 * TP + k] = q1.z * g; wf[7 * TP + k] = q1.w * g;
          wf[8 * TP + k] = q2.x * g; wf[9 * TP + k] = q2.y * g; wf[10 * TP + k] = q2.z * g; wf[11 * TP + k] = q2.w * g; } }
    __syncthreads();
    for (int tile = vcu; tile < T_ / 64; tile += G) { const int row0 = tile * 64;
        skinny_core<12>(x, row0, wf, part, ssq, wave, lane);
        if (tid < 64) { const int m = row0 + tid; const float rstd = __builtin_amdgcn_rsqf((ssq[tid] + ssq[64 + tid]) * (1.f / DM_) + EPS_); rstd_l[tid] = rstd;
            GAS float* f2 = (GAS float*)(ws + WS_F2) + (size_t)((m >> 12) * NHEADS) * SEQ_ + (m & (SEQ_ - 1));
#pragma unroll
            for (int h = 0; h < 12; ++h) { const float z = (part[tid * 32 + h] + part[(64 + tid) * 32 + h]) * rstd + b_forget[h];
                const float ls = (z >= 0.f) ? -log1pf(__expf(-z)) : (z - log1pf(__expf(z)));
                f2[(size_t)h * SEQ_] = ls * LOG2E; } }
        __syncthreads();
        xn_tile(x, gn, ws, row0, rstd_l, wave, lane);
        __syncthreads();
    }
}

__device__ __forceinline__ void scan_seq(float* f, LAS float* tot) {
    int tid_ = threadIdx.x; asm volatile("" : "+v"(tid_)); const int tid = tid_, lane = tid & 63, wave = tid >> 6;
    GAS f32x4* p = (GAS f32x4*)f + 2 * tid; f32x4 a = p[0], b = p[1];
    a.y += a.x; a.z += a.y; a.w += a.z; b.x += a.w; b.y += b.x; b.z += b.y; b.w += b.z;
    float run = b.w;
#pragma unroll
    for (int o = 1; o < 64; o <<= 1) { const float t = __shfl_up(run, o); if (lane >= o) run += t; }
    if (lane == 63) tot[wave] = run;
    __syncthreads();
    float base = run - b.w;
    for (int w = 0; w < wave; ++w) base += tot[w];
    a = a + base; b = b + base; p[0] = a; p[1] = b;
    __syncthreads();
}

struct EpiInproj0 {
    static constexpr bool PERM = true;
    bf16 *U, *V, *Q, *Kb, *VAL; const float *g_v, *g_q, *g_k;
    __device__ __forceinline__ void operator()(const pg8::f32x4 (&acc)[2][2][4][2], const pg8::Unit& u, int wr, int wc, int fr, int fq) const {
        const int pn = u.pn; const bool act = pn <= 1, nrm = (pn >= 1 && pn <= 7);
        bf16* dst; int pitch, cb; const float* gp = nullptr; float gs = 1.f;
        if (pn == 0) { dst = U; pitch = 256; cb = 0; }
        else if (pn == 1) { dst = V; pitch = 256; cb = 0; gp = g_v + wc * 64; }
        else if (pn <= 4) { dst = Q; pitch = 768; cb = (pn - 2) * 256; gp = g_q; gs = 0.125f * LOG2E; }
        else if (pn <= 7) { dst = Kb; pitch = 768; cb = (pn - 5) * 256; gp = g_k; }
        else { dst = VAL; pitch = 768; cb = (pn - 8) * 256; }
        f32x4 gn[2][2];
#pragma unroll
        for (int bj = 0; bj < 2; ++bj)
#pragma unroll
            for (int n = 0; n < 2; ++n) { gn[bj][n] = (f32x4){1.f, 1.f, 1.f, 1.f}; if (nrm) gn[bj][n] = *(const f32x4*)(gp + 32 * bj + 8 * fq + 4 * n) * gs; }
        const int row0 = u.pm * 256 + wr * 64 + fr, col0 = cb + 64 * wc + 8 * fq;
#pragma unroll
        for (int ai = 0; ai < 2; ++ai)
#pragma unroll
            for (int m = 0; m < 4; ++m) {
                f32x4 x[2][2]; float ss = 0.f;
#pragma unroll
                for (int bj = 0; bj < 2; ++bj)
#pragma unroll
                    for (int n = 0; n < 2; ++n) { f32x4 t = acc[ai][bj][m][n];
                        if (act) { t.x = gelu_tanh(t.x); t.y = gelu_tanh(t.y); t.z = gelu_tanh(t.z); t.w = gelu_tanh(t.w); }
                        ss += (t.x * t.x + t.y * t.y) + (t.z * t.z + t.w * t.w); x[bj][n] = t; }
                float r = 1.f;
                if (nrm) { ss += __shfl_xor(ss, 16); ss += __shfl_xor(ss, 32); r = __builtin_amdgcn_rsqf(ss * (1.f / 64.f) + EPS_); }
                bf16* rowp = dst + (size_t)(row0 + ai * 128 + m * 16) * pitch + col0;
#pragma unroll
                for (int bj = 0; bj < 2; ++bj) { const f32x4 v0 = x[bj][0] * gn[bj][0] * r, v1 = x[bj][1] * gn[bj][1] * r;
                    v4u w; w.x = pg8::cvt_pk_bf16(v0.x, v0.y); w.y = pg8::cvt_pk_bf16(v0.z, v0.w); w.z = pg8::cvt_pk_bf16(v1.x, v1.y); w.w = pg8::cvt_pk_bf16(v1.z, v1.w);
                    *(v4u*)(rowp + 32 * bj) = w; }
            }
    }
};
struct EpiResF32 {
    static constexpr bool PERM = true;
    const float* base; float* out; bf16* XG; const float* gn;
    __device__ __forceinline__ void operator()(const pg8::f32x4 (&acc)[2][2][4][2], const pg8::Unit& u, int wr, int wc, int fr, int fq) const {
        const int row0 = u.pm * 256 + wr * 64 + fr, col0 = u.pn * 256 + wc * 32 + 8 * fq;
        f32x4 g4[2][2];
#pragma unroll
        for (int bj = 0; bj < 2; ++bj)
#pragma unroll
            for (int n = 0; n < 2; ++n) g4[bj][n] = *(const f32x4*)(gn + col0 + bj * 128 + n * 4);
#pragma unroll
        for (int ai = 0; ai < 2; ++ai) {
            f32x4 b[4][2][2];
#pragma unroll
            for (int m = 0; m < 4; ++m)
#pragma unroll
                for (int bj = 0; bj < 2; ++bj)
#pragma unroll
                    for (int n = 0; n < 2; ++n) b[m][bj][n] = *(const f32x4*)(base + (size_t)(row0 + ai * 128 + m * 16) * DM_ + col0 + bj * 128 + n * 4);
#pragma unroll
            for (int m = 0; m < 4; ++m) { const size_t off = (size_t)(row0 + ai * 128 + m * 16) * DM_ + col0;
#pragma unroll
                for (int bj = 0; bj < 2; ++bj) { const f32x4 x0 = b[m][bj][0] + acc[ai][bj][m][0], x1 = b[m][bj][1] + acc[ai][bj][m][1];
                    *(f32x4*)(out + off + bj * 128) = x0; *(f32x4*)(out + off + bj * 128 + 4) = x1;
                    const f32x4 y0 = x0 * g4[bj][0], y1 = x1 * g4[bj][1];
                    v4u w; w.x = pg8::cvt_pk_bf16(y0.x, y0.y); w.y = pg8::cvt_pk_bf16(y0.z, y0.w); w.z = pg8::cvt_pk_bf16(y1.x, y1.y); w.w = pg8::cvt_pk_bf16(y1.z, y1.w);
                    *(v4u*)(XG + off + bj * 128) = w; } }
            asm volatile("" ::: "memory"); }
    }
};
struct EpiBf16 {
    static constexpr bool PERM = true;
    bf16* O; int ldc;
    __device__ __forceinline__ void operator()(const pg8::f32x4 (&acc)[2][2][4][2], const pg8::Unit& u, int wr, int wc, int fr, int fq) const {
        const int row0 = u.pm * 256 + wr * 64 + fr, col0 = u.pn * 256 + wc * 32 + 8 * fq;
#pragma unroll
        for (int ai = 0; ai < 2; ++ai)
#pragma unroll
            for (int m = 0; m < 4; ++m) { bf16* rowp = O + (size_t)(row0 + ai * 128 + m * 16) * ldc + col0;
#pragma unroll
                for (int bj = 0; bj < 2; ++bj) { const f32x4 v0 = acc[ai][bj][m][0], v1 = acc[ai][bj][m][1];
                    v4u w; w.x = pg8::cvt_pk_bf16(v0.x, v0.y); w.y = pg8::cvt_pk_bf16(v0.z, v0.w); w.z = pg8::cvt_pk_bf16(v1.x, v1.y); w.w = pg8::cvt_pk_bf16(v1.z, v1.w);
                    *(v4u*)(rowp + bj * 128) = w; } }
    }
};
struct EpiGateUp {
    static constexpr bool PERM = true;
    bf16* HID; const float* listw; const float* listr;
    __device__ __forceinline__ void operator()(const pg8::f32x4 (&acc)[2][2][4][2], const pg8::Unit& u, int wr, int wc, int fr, int fq) const {
        const int col0 = u.pn * 128 + wc * 32 + 8 * fq;
#pragma unroll
        for (int ai = 0; ai < 2; ++ai)
#pragma unroll
            for (int m = 0; m < 4; ++m) { const int rt = ai * 128 + wr * 64 + m * 16 + fr, pos = u.j * 256 + rt;
                const bool ok = pos < u.cnt; const float w = ok ? listw[(size_t)u.e * T_ + pos] : 0.f, rs = ok ? listr[(size_t)u.e * T_ + pos] : 0.f;
                f32x4 h[2];
#pragma unroll
                for (int n = 0; n < 2; ++n) { const f32x4 g = acc[ai][0][m][n] * rs, up = acc[ai][1][m][n] * rs;
                    h[n].x = g.x * fast_sigmoid(g.x) * up.x * w; h[n].y = g.y * fast_sigmoid(g.y) * up.y * w; h[n].z = g.z * fast_sigmoid(g.z) * up.z * w; h[n].w = g.w * fast_sigmoid(g.w) * up.w * w; }
                v4u o; o.x = pg8::cvt_pk_bf16(h[0].x, h[0].y); o.y = pg8::cvt_pk_bf16(h[0].z, h[0].w); o.z = pg8::cvt_pk_bf16(h[1].x, h[1].y); o.w = pg8::cvt_pk_bf16(h[1].z, h[1].w);
                *(v4u*)(HID + (size_t)(u.pm * 256 + rt) * EHID + col0) = o; }
    }
};
__device__ __forceinline__ int moe_mtiles(unsigned* cnt) { int pre = 0;
#pragma unroll
    for (int e = 0; e < NEXP; ++e) pre += ((int)__builtin_amdgcn_readfirstlane(__hip_atomic_load(cnt + CNT_STRIDE * e, __ATOMIC_RELAXED, __HIP_MEMORY_SCOPE_AGENT)) + 255) >> 8;
    return pre; }
struct ProbMoe {
    const char* A; const char* Bt; int K, nN; unsigned* cnt; const int* list; bool gather; size_t bstride;
    int ubase, ulim, Geff, ceff;
    __device__ __forceinline__ bool next(int i, pg8::Unit& u) const {
        if (ceff < 0) return false;
        const int L = ubase + i * Geff + ceff; if (L >= ulim) return false;
        const int mt = L / nN; int pre = 0; bool found = false;
#pragma unroll
        for (int e = 0; e < NEXP; ++e) { const int ce = (int)__builtin_amdgcn_readfirstlane(__hip_atomic_load(cnt + CNT_STRIDE * e, __ATOMIC_RELAXED, __HIP_MEMORY_SCOPE_AGENT)); const int tl = (ce + 255) >> 8;
            if (mt >= pre && mt < pre + tl) { u.e = e; u.j = mt - pre; u.cnt = ce; found = true; } pre += tl; }
        u.pm = mt; u.pn = L % nN; return found;
    }
    __device__ __forceinline__ unsigned a_off(const pg8::Unit& u, int row) const {
        if (gather) { int pos = u.j * 256 + row; pos = pos < u.cnt ? pos : u.cnt - 1; const int tok = list[(size_t)u.e * T_ + pos]; return (unsigned)tok * (unsigned)(K * 2); }
        return (unsigned)(u.pm * 256 + row) * (unsigned)(K * 2);
    }
    __device__ __forceinline__ const char* b_base(const pg8::Unit& u) const { return Bt + (size_t)u.e * bstride + (size_t)u.pn * 256 * K * 2; }
};

__device__ __forceinline__ void gmlp_unit(int idx, const bf16* U, const bf16* V, const bf16* WST, const float* b_s, bf16* MIX, LAS unsigned char* lds) {
    int tid_ = threadIdx.x; asm volatile("" : "+v"(tid_)); const int tid = tid_, lane = tid & 63, wave = __builtin_amdgcn_readfirstlane(tid >> 6), fr = lane & 15, fq = lane >> 4;
    const int c = idx >> 2, g = idx & 3, tok0 = c * 128;
    LAS bf16* Vt = (LAS bf16*)lds;
#pragma unroll
    for (int i = 0; i < 2; ++i) { const int p = tid + NTHR * i, s = p >> 3, dc = p & 7;
        const v4u q = *(const GAS v4u*)(V + (size_t)(tok0 + s) * 256 + g * 64 + dc * 8);
        const unsigned w[4] = {q.x, q.y, q.z, q.w};
#pragma unroll
        for (int e = 0; e < 4; ++e) { Vt[(dc * 8 + 2 * e) * 136 + s] = (bf16)(w[e] & 0xffffu); Vt[(dc * 8 + 2 * e + 1) * 136 + s] = (bf16)(w[e] >> 16); } }
    __syncthreads();
    const int t0 = 16 * wave;
    pg8::f32x4 acc[4];
#pragma unroll
    for (int n = 0; n < 4; ++n) acc[n] = (pg8::f32x4){0.f, 0.f, 0.f, 0.f};
#pragma unroll
    for (int ks = 0; ks < 4; ++ks) {
        const bf16x8 wfrag = *(const GAS bf16x8*)(WST + (size_t)(g * 128 + t0 + fr) * 128 + 32 * ks + 8 * fq);
#pragma unroll
        for (int n = 0; n < 4; ++n) { const bf16x8 vfrag = *(const LAS bf16x8*)(Vt + (16 * n + fr) * 136 + 32 * ks + 8 * fq);
            acc[n] = __builtin_amdgcn_mfma_f32_16x16x32_bf16(vfrag, wfrag, acc[n], 0, 0, 0); }
    }
    const int t = t0 + fr; const float bs = b_s[g * 128 + t];
#pragma unroll
    for (int n = 0; n < 4; ++n) { const size_t ucol = (size_t)(tok0 + t) * 256 + g * 64 + 16 * n + 4 * fq;
        const unsigned long long uu = *(const GAS unsigned long long*)(U + ucol);
        const float u0 = bf2f((unsigned short)(uu & 0xffff)), u1 = bf2f((unsigned short)((uu >> 16) & 0xffff)), u2 = bf2f((unsigned short)((uu >> 32) & 0xffff)), u3 = bf2f((unsigned short)(uu >> 48));
        const unsigned lo = pk2(u0 * (acc[n].x + bs), u1 * (acc[n].y + bs)), hi = pk2(u2 * (acc[n].z + bs), u3 * (acc[n].w + bs));
        *(GAS unsigned long long*)(MIX + (size_t)(tok0 + t) * 1024 + g * 64 + 16 * n + 4 * fq) = (unsigned long long)lo | ((unsigned long long)hi << 32); }
    __syncthreads();
}

#if MK_NAIVE_ATTN
__device__ __forceinline__ void naive_attn(const bf16* Q, const bf16* K, const bf16* V, const float* F2, bf16* MIXo, int gt, int NGT) {
    for (int r = gt; r < NBH * SEQ_; r += NGT) { const int bh = r / SEQ_, t = r % SEQ_, b = bh / NHEADS, h = bh % NHEADS; const size_t row = (size_t)b * SEQ_ + t;
        float q[64], o[64];
#pragma unroll
        for (int d = 0; d < 64; ++d) { q[d] = bf2f(Q[row * 768 + h * 64 + d]); o[d] = 0.f; }
        float m = -INFINITY, l = 0.f; const float ft = F2[(size_t)bh * SEQ_ + t];
        for (int s = 0; s <= t; ++s) { const size_t rs = (size_t)b * SEQ_ + s; float sc = 0.f;
#pragma unroll
            for (int d = 0; d < 64; ++d) sc += q[d] * bf2f(K[rs * 768 + h * 64 + d]);
            sc += ft - F2[(size_t)bh * SEQ_ + s];
            const float mn = fmaxf(m, sc), al = exp2f(m - mn), p = exp2f(sc - mn); l = l * al + p; m = mn;
#pragma unroll
            for (int d = 0; d < 64; ++d) o[d] = o[d] * al + p * bf2f(V[rs * 768 + h * 64 + d]); }
        const float il = 1.f / l;
#pragma unroll
        for (int d = 0; d < 64; ++d) MIXo[row * 1024 + 256 + h * 64 + d] = (bf16)f2bf(o[d] * il); }
}
#endif

template <class IN_T> __device__ __forceinline__ void phase_route(const IN_T in, int layer, const float* X, unsigned char* ws, unsigned* cnt, LAS unsigned char* lds, int G, int vcu, int rep) {
    int tid_ = threadIdx.x; asm volatile("" : "+v"(tid_)); const int tid = tid_, lane = tid & 63, wave = __builtin_amdgcn_readfirstlane(tid >> 6);
    LAS float* wt = (LAS float*)lds;
    LAS float* part = (LAS float*)(lds + 98304); LAS float* ssq = part + 2 * 64 * 32; LAS float* rstd_l = ssq + 128; LAS unsigned* lcnt = (LAS unsigned*)(rstd_l + 64); LAS unsigned* lbase = lcnt + 16;
    const float* wg = in[17] + (size_t)layer * 1024 * 4; const float* wrt = in[19] + (size_t)layer * 1024 * 16; const float* gn = in[16] + (size_t)layer * 1024;
#pragma unroll
    for (int kk = 0; kk < 2; ++kk) { const int k = tid + NTHR * kk; const f32x4 q0 = *(const GAS f32x4*)(wg + k * 4); const GAS f32x4* rs = (const GAS f32x4*)(wrt + k * 16); const f32x4 q1 = rs[0], q2 = rs[1], q3 = rs[2], q4 = rs[3]; const float g = gn[k];
        wt[0 * TP + k] = q0.x * g; wt[1 * TP + k] = q0.y * g; wt[2 * TP + k] = q0.z * g; wt[3 * TP + k] = q0.w * g;
        wt[4 * TP + k] = q1.x * g; wt[5 * TP + k] = q1.y * g; wt[6 * TP + k] = q1.z * g; wt[7 * TP + k] = q1.w * g; wt[8 * TP + k] = q2.x * g; wt[9 * TP + k] = q2.y * g; wt[10 * TP + k] = q2.z * g; wt[11 * TP + k] = q2.w * g;
        wt[12 * TP + k] = q3.x * g; wt[13 * TP + k] = q3.y * g; wt[14 * TP + k] = q3.z * g; wt[15 * TP + k] = q3.w * g; wt[16 * TP + k] = q4.x * g; wt[17 * TP + k] = q4.y * g; wt[18 * TP + k] = q4.z * g; wt[19 * TP + k] = q4.w * g; }
    const float* bg = in[18] + layer * 4; const float* br = in[20] + layer * 16;
    int* list = (int*)(ws + WS_LIST); float* listw = (float*)(ws + WS_LISTW); float* listr = (float*)(ws + WS_LISTR); int* toke = (int*)(ws + WS_TOKE); int* tokp = (int*)(ws + WS_TOKP);
    for (int tile = vcu; tile < T_ / 64; tile += G) { const int row0 = tile * 64;
        if (tid < 16) lcnt[tid] = 0u;
        __syncthreads();
        skinny_core<20>(X, row0, wt, part, ssq, wave, lane);
        int e1 = 0, e2 = 0; float w1 = 0.f, w2 = 0.f; unsigned r1 = 0, r2 = 0;
        if (tid < 64) {
            const float rstd = __builtin_amdgcn_rsqf((ssq[tid] + ssq[64 + tid]) * (1.f / DM_) + EPS_); rstd_l[tid] = rstd;
            float a[20];
#pragma unroll
            for (int c = 0; c < 20; ++c) a[c] = (part[tid * 32 + c] + part[(64 + tid) * 32 + c]) * rstd;
            float lg[4]; int gi = 0; float gmax;
#pragma unroll
            for (int j = 0; j < 4; ++j) lg[j] = a[j] + bg[j];
            gmax = lg[0];
#pragma unroll
            for (int j = 1; j < 4; ++j) if (lg[j] > gmax) { gmax = lg[j]; gi = j; }
            float gsum = 0.f;
#pragma unroll
            for (int j = 0; j < 4; ++j) gsum += __expf(lg[j] - gmax);
            const float gtop = 1.f / gsum;
            float le[4];
#pragma unroll
            for (int e = 0; e < 4; ++e) { float s = 0.f;
#pragma unroll
                for (int j = 0; j < 4; ++j) s = (gi == j) ? (a[4 + 4 * j + e] + br[4 * j + e]) : s;
                le[e] = s; }
            int i1 = 0; float m1 = le[0];
#pragma unroll
            for (int e = 1; e < 4; ++e) if (le[e] > m1) { m1 = le[e]; i1 = e; }
            int i2 = -1; float m2 = -INFINITY;
#pragma unroll
            for (int e = 0; e < 4; ++e) if (e != i1 && le[e] > m2) { m2 = le[e]; i2 = e; }
            const float p2 = __expf(m2 - m1); w1 = gtop / (1.f + p2); w2 = gtop * p2 / (1.f + p2);
            e1 = gi * 4 + i1; e2 = gi * 4 + i2;
            r1 = __hip_atomic_fetch_add(lcnt + e1, 1u, __ATOMIC_RELAXED, __HIP_MEMORY_SCOPE_WORKGROUP); r2 = __hip_atomic_fetch_add(lcnt + e2, 1u, __ATOMIC_RELAXED, __HIP_MEMORY_SCOPE_WORKGROUP);
        }
        __syncthreads();
        if (tid < 16) lbase[tid] = __hip_atomic_fetch_add(cnt + CNT_STRIDE * tid, lcnt[tid], __ATOMIC_RELAXED, __HIP_MEMORY_SCOPE_AGENT);
        __syncthreads();
        if (tid < 64 && rep == 0) { const int m = row0 + tid; const int p1 = (int)(lbase[e1] + r1), q2 = (int)(lbase[e2] + r2); const float rs = rstd_l[tid];
            list[(size_t)e1 * T_ + p1] = m; listw[(size_t)e1 * T_ + p1] = w1; listr[(size_t)e1 * T_ + p1] = rs; list[(size_t)e2 * T_ + q2] = m; listw[(size_t)e2 * T_ + q2] = w2; listr[(size_t)e2 * T_ + q2] = rs;
            toke[2 * m] = e1; toke[2 * m + 1] = e2; tokp[2 * m] = p1; tokp[2 * m + 1] = q2; }
        __syncthreads();
    }
}

template <bool NORM>
__device__ __forceinline__ void phase_combine(float* X, const float* gn, unsigned char* ws, unsigned* cnt, int G, int vcu, int rep) {
    int tid_ = threadIdx.x; asm volatile("" : "+v"(tid_)); const int tid = tid_, lane = tid & 63, wave = __builtin_amdgcn_readfirstlane(tid >> 6);
    const int gw = vcu * NWAVES + wave, NGW = G * NWAVES;
    int sb[NEXP]; { int pre = 0;
#pragma unroll
        for (int e = 0; e < NEXP; ++e) { sb[e] = pre * 256; pre += ((int)__builtin_amdgcn_readfirstlane(__hip_atomic_load(cnt + CNT_STRIDE * e, __ATOMIC_RELAXED, __HIP_MEMORY_SCOPE_AGENT)) + 255) >> 8; } }
    const int* toke = (const int*)(ws + WS_TOKE); const int* tokp = (const int*)(ws + WS_TOKP); const bf16* Y = (const bf16*)(ws + WS_Y);
    const GAS unsigned long long* te8 = (const GAS unsigned long long*)toke; const GAS unsigned long long* tp8 = (const GAS unsigned long long*)tokp;
    for (int m0 = gw; m0 < T_; m0 += 2 * NGW) {
        unsigned long long ee[2], pp[2]; int mm[2]; bool ok[2];
#pragma unroll
        for (int r = 0; r < 2; ++r) { mm[r] = m0 + r * NGW; ok[r] = mm[r] < T_; if (!ok[r]) mm[r] = m0; ee[r] = te8[mm[r]]; pp[r] = tp8[mm[r]]; }
        f32x4 v[2][4]; unsigned long long ya[2][4], yb[2][4];
#pragma unroll
        for (int r = 0; r < 2; ++r) { const int e1 = (int)(ee[r] & 0xffffffffu), e2 = (int)(ee[r] >> 32), p1 = (int)(pp[r] & 0xffffffffu), p2 = (int)(pp[r] >> 32); int s1 = 0, s2 = 0;
#pragma unroll
            for (int e = 0; e < NEXP; ++e) { s1 = (e == e1) ? sb[e] + p1 : s1; s2 = (e == e2) ? sb[e] + p2 : s2; }
            const GAS f32x4* xr = (const GAS f32x4*)(X + (size_t)mm[r] * DM_) + lane;
            const GAS unsigned long long* y1 = (const GAS unsigned long long*)(Y + (size_t)s1 * 1024) + lane; const GAS unsigned long long* y2 = (const GAS unsigned long long*)(Y + (size_t)s2 * 1024) + lane;
#pragma unroll
            for (int j = 0; j < 4; ++j) { v[r][j] = xr[64 * j]; ya[r][j] = y1[64 * j]; yb[r][j] = y2[64 * j]; } }
#pragma unroll
        for (int r = 0; r < 2; ++r) { if (!ok[r]) continue;
            GAS f32x4* xw = (GAS f32x4*)(X + (size_t)mm[r] * DM_) + lane; float ss = 0.f;
#pragma unroll
            for (int j = 0; j < 4; ++j) { const unsigned long long a = ya[r][j], b = yb[r][j]; f32x4 t = v[r][j];
                t.x += bf2f((unsigned short)(a & 0xffff)) + bf2f((unsigned short)(b & 0xffff)); t.y += bf2f((unsigned short)((a >> 16) & 0xffff)) + bf2f((unsigned short)((b >> 16) & 0xffff));
                t.z += bf2f((unsigned short)((a >> 32) & 0xffff)) + bf2f((unsigned short)((b >> 32) & 0xffff)); t.w += bf2f((unsigned short)(a >> 48)) + bf2f((unsigned short)(b >> 48));
                if (rep == 0) xw[64 * j] = t; v[r][j] = t; ss += (t.x * t.x + t.y * t.y) + (t.z * t.z + t.w * t.w); }
            if (NORM && rep == 0) {
                const float rstd = __builtin_amdgcn_rsqf(wave_sum(ss) * (1.f / DM_) + EPS_);
                GAS unsigned long long* o8 = (GAS unsigned long long*)(ws + WS_XN + (size_t)mm[r] * DM_ * 2) + lane;
#pragma unroll
                for (int j = 0; j < 4; ++j) { const f32x4 g4 = *((const GAS f32x4*)gn + 64 * j + lane); const f32x4 t = v[r][j];
                    o8[64 * j] = (unsigned long long)pk2(t.x * rstd * g4.x, t.y * rstd * g4.y) | ((unsigned long long)pk2(t.z * rstd * g4.z, t.w * rstd * g4.w) << 32); }
            }
        }
    }
}

__device__ __forceinline__ void unpack8(const v4u q, float (&f)[8]) { f[0] = bf2f((unsigned short)(q.x & 0xffff)); f[1] = bf2f((unsigned short)(q.x >> 16)); f[2] = bf2f((unsigned short)(q.y & 0xffff)); f[3] = bf2f((unsigned short)(q.y >> 16));
    f[4] = bf2f((unsigned short)(q.z & 0xffff)); f[5] = bf2f((unsigned short)(q.z >> 16)); f[6] = bf2f((unsigned short)(q.w & 0xffff)); f[7] = bf2f((unsigned short)(q.w >> 16)); }
__device__ __forceinline__ void phase_mix1(const bf16* H1, const float* conv_w, bf16* MIX, int G, int vcu) {
    int tid_ = threadIdx.x; asm volatile("" : "+v"(tid_)); const int gt = vcu * NTHR + tid_, NGT = G * NTHR;
    for (int idx = gt; idx < (T_ / 16) * 128; idx += NGT) {
        const int cgp = idx & 127, m0 = (idx >> 7) * 16, t0 = m0 & (SEQ_ - 1); const bf16* hr = H1 + (size_t)m0 * 2048;
        if (cgp < 64) { const int ch = cgp * 8; float z1[8], z2[8], w[3][8];
#pragma unroll
            for (int tap = 0; tap < 3; ++tap) { const f32x4 w0 = *(const GAS f32x4*)(conv_w + tap * 512 + ch), w1 = *(const GAS f32x4*)(conv_w + tap * 512 + ch + 4);
                w[tap][0] = w0.x; w[tap][1] = w0.y; w[tap][2] = w0.z; w[tap][3] = w0.w; w[tap][4] = w1.x; w[tap][5] = w1.y; w[tap][6] = w1.z; w[tap][7] = w1.w; }
#pragma unroll
            for (int e = 0; e < 8; ++e) { z1[e] = 0.f; z2[e] = 0.f; }
            if (t0 >= 2) { float a[8], b[8]; unpack8(*(const GAS v4u*)(hr - 2048 + 512 + ch), a); unpack8(*(const GAS v4u*)(hr - 2048 + 1024 + ch), b);
#pragma unroll
                for (int e = 0; e < 8; ++e) z1[e] = a[e] * b[e];
                unpack8(*(const GAS v4u*)(hr - 4096 + 512 + ch), a); unpack8(*(const GAS v4u*)(hr - 4096 + 1024 + ch), b);
#pragma unroll
                for (int e = 0; e < 8; ++e) z2[e] = a[e] * b[e]; }
#pragma unroll 4
            for (int i = 0; i < 16; ++i) { const bf16* r = hr + (size_t)i * 2048; float bgv[8], cgv[8], hcv[8], o[8];
                unpack8(*(const GAS v4u*)(r + ch), bgv); unpack8(*(const GAS v4u*)(r + 512 + ch), cgv); unpack8(*(const GAS v4u*)(r + 1024 + ch), hcv);
#pragma unroll
                for (int e = 0; e < 8; ++e) { const float z0 = cgv[e] * hcv[e]; o[e] = bgv[e] * (w[0][e] * z2[e] + w[1][e] * z1[e] + w[2][e] * z0); z2[e] = z1[e]; z1[e] = z0; }
                v4u q; q.x = pk2(o[0], o[1]); q.y = pk2(o[2], o[3]); q.z = pk2(o[4], o[5]); q.w = pk2(o[6], o[7]);
                *(GAS v4u*)(MIX + (size_t)(m0 + i) * 1024 + ch) = q; }
        } else { const int pc = (cgp - 64) * 8, gi = pc >> 7, win = 2 << gi; float s[8];
#pragma unroll
            for (int e = 0; e < 8; ++e) s[e] = 0.f;
            const int nb = (t0 < win - 1) ? t0 : win - 1;
            for (int d = 1; d <= nb; ++d) { float pv[8]; unpack8(*(const GAS v4u*)(hr - (size_t)d * 2048 + 1536 + pc), pv);
#pragma unroll
                for (int e = 0; e < 8; ++e) s[e] += pv[e]; }
#pragma unroll 4
            for (int i = 0; i < 16; ++i) { const int t = t0 + i; const bf16* r = hr + (size_t)i * 2048; float cur[8], o[8];
                unpack8(*(const GAS v4u*)(r + 1536 + pc), cur);
                const int n = (t + 1 < win) ? t + 1 : win; const float inv = 1.f / (float)n;
#pragma unroll
                for (int e = 0; e < 8; ++e) { s[e] += cur[e]; o[e] = s[e] * inv - cur[e]; }
                if (t + 1 >= win) { float old[8]; unpack8(*(const GAS v4u*)(r - (size_t)(win - 1) * 2048 + 1536 + pc), old);
#pragma unroll
                    for (int e = 0; e < 8; ++e) s[e] -= old[e]; }
                v4u q; q.x = pk2(o[0], o[1]); q.y = pk2(o[2], o[3]); q.z = pk2(o[4], o[5]); q.w = pk2(o[6], o[7]);
                *(GAS v4u*)(MIX + (size_t)(m0 + i) * 1024 + 512 + pc) = q; }
        }
    }
}
struct Args { const float* in[24]; float* out; unsigned char* ws; int ph_lo, ph_hi, rep, pad; };
__global__ void __launch_bounds__(NTHR, 2) hybrid_fwd(Args args) {
    extern __shared__ __attribute__((aligned(16))) unsigned char lds_raw[];
    LAS unsigned char* lds = (LAS unsigned char*)lds_raw;
    volatile LAS unsigned* MISC = (volatile LAS unsigned*)(lds + MISC_OFF);
    const int tid = threadIdx.x;
    const int G = gridDim.x; const int bx = blockIdx.x; const int vcu = (G % 8 == 0) ? (bx % 8) * (G / 8) + bx / 8 : bx;
    struct KIn { __device__ __forceinline__ const float* operator[](int k) const { const volatile __attribute__((address_space(4))) unsigned long long* ka = (const volatile __attribute__((address_space(4))) unsigned long long*)__builtin_amdgcn_kernarg_segment_ptr(); return (const float*)(const GAS float*)ka[k]; } };
    const KIn in;
#define out ((float*)in[24])
#define ws ((unsigned char*)in[25])
#define XN ((bf16*)(ws + WS_XN))
#define MIX ((bf16*)(ws + WS_MIX))
#define HID ((bf16*)(ws + WS_HID))
#define Y ((bf16*)(ws + WS_Y))
#define F2 ((float*)(ws + WS_F2))
#define ctl ((gu32*)(ws + WS_CTL))
    for (int u = tid; u < (LDS_BYTES - LDSCTL_OFF) / 4; u += NTHR) ((LAS unsigned*)(lds + LDSCTL_OFF))[u] = 0u;
    __syncthreads();
#if MK_USE_CG
    cooperative_groups::grid_group grid = cooperative_groups::this_grid();
#define GRID_BAR() grid.sync()
#else
    XcdBarrier bar; bar.bar = (unsigned*)(ctl + CW_BAR); bar.x = 0; bar.st = nullptr;
    if (MK_N_LAUNCHES == 1) bar = xcd_barrier_post((unsigned*)(ctl + CW_BAR), MISC + 8);
#define GRID_BAR() xcd_barrier(bar)
#endif
    const int lo = args.ph_lo, hi = args.ph_hi;
#ifndef PH_MASK
#define PH_MASK 0x1ffff
#endif
#define IN(k) (((PH_MASK >> (k)) & 1) && lo <= (k) && (k) < hi)
#define SEAM(k) do { if (IN(k) && IN((k) + 1)) GRID_BAR(); } while (0)

    if (IN(0)) { p0_prologue(in, ws, lds, G, vcu); }
    SEAM(0);
    if (IN(1)) {
        if (bx >= G - NBH && G > NBH && args.rep == 0) { scan_seq(F2 + (size_t)(bx - (G - NBH)) * SEQ_, (LAS float*)(lds + MISC_OFF + 64)); }
        pg8::ProbPlain S; S.init(XN, ws + WS_WIN0, T_, EV_N, 1024, G, bx);
        EpiInproj0 E{(bf16*)(ws + WS_U), (bf16*)(ws + WS_V), (bf16*)(ws + WS_Q), (bf16*)(ws + WS_K), (bf16*)(ws + WS_VAL), in[6], in[7], in[8]};
        pg8::gemm_phase<EpiInproj0, pg8::ProbPlain, true>(lds, S, E);
        { const int nfull = S.nwg % G, nidle = G - nfull;
          if (nfull > 0 && bx >= nfull) { const int wv_ = __builtin_amdgcn_readfirstlane(tid >> 6);
              convert_items(in, ws, (LAS float*)(lds + wv_ * 16384), TR_I0, TR_P1_END, (bx - nfull) * NWAVES + wv_, nidle * NWAVES, tid & 63); }
          else if (nfull == 0) { const int wv_ = __builtin_amdgcn_readfirstlane(tid >> 6); convert_items(in, ws, (LAS float*)(lds + wv_ * 16384), TR_I0, TR_P1_END, bx * NWAVES + wv_, G * NWAVES, tid & 63); } }
    }
    SEAM(1);
    if (IN(2)) {
#if MK_NAIVE_ATTN
        naive_attn((const bf16*)(ws + WS_Q), (const bf16*)(ws + WS_K), (const bf16*)(ws + WS_VAL), F2, MIX, vcu * NTHR + tid, G * NTHR);
        for (int u = bx; u < 512; u += G) gmlp_unit(u, (const bf16*)(ws + WS_U), (const bf16*)(ws + WS_V), (const bf16*)(ws + WS_WST), in[5], MIX, lds);
#else
        float skipthr, bmax; { const float gq = fabsf(in[7][tid & 63]), gk = fabsf(in[8][tid & 63]); float mq = gq, mk = gk;
#pragma unroll
            for (int o = 1; o < 64; o <<= 1) { mq = fmaxf(mq, __shfl_xor(mq, o)); mk = fmaxf(mk, __shfl_xor(mk, o)); }
            bmax = 1.02f * (0.125f * LOG2E * 64.f) * mq * mk; skipthr = 40.f + 2.f * bmax; }
        for (;;) {
            if (tid == 0) MISC[0] = __hip_atomic_fetch_add((unsigned*)(ctl + CW_Q + 16 * args.rep), 1u, __ATOMIC_RELAXED, __HIP_MEMORY_SCOPE_AGENT);
            __syncthreads();
            const int u = (int)MISC[0];
            __syncthreads();
            if (u >= 768 + 512) break;
            if (u < 768) { const int qb = 15 - u / NBH, bh = u % NBH;
                attn_body::attn_unit<8>(bh / NHEADS, bh % NHEADS, qb, (const attn_body::bf16*)(ws + WS_Q), (const attn_body::bf16*)(ws + WS_K), (const attn_body::bf16*)(ws + WS_VAL),
                                        (attn_body::bf16*)(ws + WS_MIX) + 256, F2 + (size_t)bh * SEQ_, skipthr, bmax, (char*)lds_raw); }
            else gmlp_unit(u - 768, (const bf16*)(ws + WS_U), (const bf16*)(ws + WS_V), (const bf16*)(ws + WS_WST), in[5], MIX, lds);
        }
#endif
    }
    SEAM(2);
    if (IN(3)) {
        pg8::ProbPlain S; S.init(MIX, ws + WS_WOUT0, T_, 1024, 1024, G, bx);
        EpiResF32 E{in[0], out, XN, in[16]};
        pg8::gemm_phase<EpiResF32, pg8::ProbPlain, false>(lds, S, E);
    }
    SEAM(3);
#define MOE_LAYER(layer, pb, cntw) do { \
        unsigned* cnt = (unsigned*)(ctl + (cntw)); \
          \
        if (IN(pb)) phase_route(in, layer, out, ws, args.rep ? (unsigned*)(ctl + CW_CNTD) : cnt, lds, G, vcu, args.rep); \
        SEAM(pb); \
        const char* wgu_ = (const char*)(ws + WS_WGU) + (size_t)(layer) * NEXP * 512 * 1024 * 2; const char* wd_ = (const char*)(ws + WS_WD) + (size_t)(layer) * NEXP * 1024 * 256 * 2; \
          \
        if (IN((pb) + 1)) { const int MT = moe_mtiles(cnt), NG = 2 * MT; \
            ProbMoe S{(const char*)XN, wgu_, 1024, 2, cnt, (const int*)(ws + WS_LIST), true, (size_t)512 * 1024 * 2, 0, NG < G ? NG : G, G, bx}; \
            EpiGateUp E{HID, (const float*)(ws + WS_LISTW), (const float*)(ws + WS_LISTR)}; \
            pg8::gemm_phase<EpiGateUp, ProbMoe, true>(lds, S, E); } \
        SEAM((pb) + 1); \
          \
        if (IN((pb) + 2)) { const int MT = moe_mtiles(cnt), NG = 2 * MT, n2 = NG > G ? NG - G : 0, MT1 = (NG < G ? NG : G) / 2, Ge = G - n2, dl = 4 * MT1 < 2 * Ge ? 4 * MT1 : 2 * Ge; \
            if (bx < n2) { ProbMoe S{(const char*)XN, wgu_, 1024, 2, cnt, (const int*)(ws + WS_LIST), true, (size_t)512 * 1024 * 2, G, NG, G, bx}; \
                EpiGateUp E{HID, (const float*)(ws + WS_LISTW), (const float*)(ws + WS_LISTR)}; \
                pg8::gemm_phase<EpiGateUp, ProbMoe, true>(lds, S, E); } \
            else { ProbMoe S{(const char*)HID, wd_, 256, 4, cnt, nullptr, false, (size_t)1024 * 256 * 2, 0, dl, Ge, bx - n2}; \
                EpiBf16 E{Y, 1024}; \
                pg8::gemm_phase<EpiBf16, ProbMoe, true>(lds, S, E); } } \
        SEAM((pb) + 2); \
          \
        if (IN((pb) + 3)) { const int MT = moe_mtiles(cnt), NG = 2 * MT, n2 = NG > G ? NG - G : 0, MT1 = (NG < G ? NG : G) / 2, Ge = G - n2, dl = 4 * MT1 < 2 * Ge ? 4 * MT1 : 2 * Ge, nd2 = 4 * MT - dl; \
            ProbMoe S{(const char*)HID, wd_, 256, 4, cnt, nullptr, false, (size_t)1024 * 256 * 2, dl, 4 * MT, G, bx}; \
            EpiBf16 E{Y, 1024}; \
            pg8::gemm_phase<EpiBf16, ProbMoe, true>(lds, S, E); \
            if ((layer) == 0) { const int wv_ = __builtin_amdgcn_readfirstlane((int)threadIdx.x >> 6); const int nid_ = nd2 < G ? G - nd2 : 0; \
                if (nid_ > 0) { if (bx >= nd2) { convert_items(in, ws, (LAS float*)(lds + wv_ * 16384), TR_A_END, TR_NITEMS, (bx - nd2) * NWAVES + wv_, nid_ * NWAVES, (int)threadIdx.x & 63); fold_items(in, ws, (bx - nd2) * NWAVES + wv_, nid_ * NWAVES, (int)threadIdx.x & 63); } } \
                else { convert_items(in, ws, (LAS float*)(lds + wv_ * 16384), TR_A_END, TR_NITEMS, bx * NWAVES + wv_, G * NWAVES, (int)threadIdx.x & 63); fold_items(in, ws, bx * NWAVES + wv_, G * NWAVES, (int)threadIdx.x & 63); } } } \
        SEAM((pb) + 3); \
          \
        if (IN((pb) + 4)) { if ((layer) == 0) phase_combine<true>(out, in[10], ws, cnt, G, vcu, args.rep); else phase_combine<false>(out, nullptr, ws, cnt, G, vcu, args.rep); } \
    } while (0)
    MOE_LAYER(0, 4, CW_CNT0);
    SEAM(8);
    if (IN(9)) {
        pg8::ProbPlain S; S.init(XN, ws + WS_WIN1, T_, 2048, 1024, G, bx);
        EpiBf16 E{(bf16*)(ws + WS_H1), 2048};
        pg8::gemm_phase<EpiBf16, pg8::ProbPlain, true>(lds, S, E);
    }
    SEAM(9);
    if (IN(10)) phase_mix1((const bf16*)(ws + WS_H1), in[12], MIX, G, vcu);
    SEAM(10);
    if (IN(11)) {
        pg8::ProbPlain S; S.init(MIX, ws + WS_WOUT1, T_, 1024, 1024, G, bx);
        EpiResF32 E{out, out, XN, in[16] + 1024};
        pg8::gemm_phase<EpiResF32, pg8::ProbPlain, false>(lds, S, E);
    }
    SEAM(11);
    MOE_LAYER(1, 12, CW_CNT1);
#undef MOE_LAYER
#undef XN
#undef MIX
#undef HID
#undef Y
#undef F2
#undef ctl
#undef out
#undef ws
#undef IN
#undef SEAM
#undef GRID_BAR
}

extern "C" void kernel_launch(void* const* d_in, const int* in_sizes, int n_in, void* d_out, int out_size, void* d_ws, size_t ws_size, hipStream_t stream) {
    static int grid = 0;
    if (grid == 0) {
        if (n_in != 24 || in_sizes[0] != T_ * DM_ || out_size != T_ * DM_ || ws_size < WS_END) { fprintf(stderr, "kernel_launch: unexpected shapes (n_in %d, in0 %d, out %d, ws %zu); nothing launched\n", n_in, n_in > 0 ? in_sizes[0] : -1, out_size, ws_size); grid = -1; return; }
        int dev = 0, cus = 0, per_cu = 0;
        if (hipGetDevice(&dev) != hipSuccess || hipDeviceGetAttribute(&cus, hipDeviceAttributeMultiprocessorCount, dev) != hipSuccess) { fprintf(stderr, "kernel_launch: device query failed\n"); grid = -1; return; }
        if (hipFuncSetAttribute((const void*)hybrid_fwd, hipFuncAttributeMaxDynamicSharedMemorySize, LDS_BYTES) != hipSuccess) { fprintf(stderr, "kernel_launch: hipFuncSetAttribute failed\n"); grid = -1; return; }
        if (hipOccupancyMaxActiveBlocksPerMultiprocessor(&per_cu, (const void*)hybrid_fwd, NTHR, LDS_BYTES) != hipSuccess || per_cu < 1) { fprintf(stderr, "kernel_launch: occupancy query reports %d workgroups per CU\n", per_cu); per_cu = 1; }
        (void)hipGetLastError();
        grid = cus;
    }
    if (grid < 0) return;
    if (hipMemsetAsync((char*)d_ws + WS_CTL, 0, CTL_ZERO_BYTES, stream) != hipSuccess) { fprintf(stderr, "kernel_launch: memset failed\n"); return; }
    Args a{};
    for (int i = 0; i < 24; ++i) a.in[i] = (const float*)d_in[i];
    a.out = (float*)d_out; a.ws = (unsigned char*)d_ws;
#if MK_N_LAUNCHES == 1
    a.ph_lo = 0; a.ph_hi = NPH;
#if MK_USE_CG
    void* kargs[] = {&a};
    hipError_t e = hipLaunchCooperativeKernel((const void*)hybrid_fwd, dim3(grid), dim3(NTHR), kargs, LDS_BYTES, stream);
    if (e != hipSuccess) fprintf(stderr, "kernel_launch: cooperative launch failed: %s (grid %d)\n", hipGetErrorString(e), grid);
#else
    hipLaunchKernelGGL(hybrid_fwd, dim3(grid), dim3(NTHR), LDS_BYTES, stream, a);
#endif
#else
    for (int p = 0; p < NPH; ++p) { a.ph_lo = p; a.ph_hi = p + 1; a.rep = 0; hipLaunchKernelGGL(hybrid_fwd, dim3(grid), dim3(NTHR), LDS_BYTES, stream, a);
        if ((MK_REPEAT_MASK >> p) & 1) { a.rep = MK_REP_MODE; hipLaunchKernelGGL(hybrid_fwd, dim3(grid), dim3(NTHR), LDS_BYTES, stream, a); } }
#endif
}
```

```cpp
#include <hip/hip_runtime.h>
#include <hip/hip_cooperative_groups.h>
#include <hip/hip_bf16.h>
#include <cstdio>
#include <cstdint>
#include <cmath>

#ifndef MK_N_LAUNCHES
#define MK_N_LAUNCHES 1
#endif
#ifndef MK_USE_CG
#define MK_USE_CG 0
#endif
#ifndef MK_NAIVE_ATTN
#define MK_NAIVE_ATTN 0
#endif
#ifndef MK_REPEAT_MASK
#define MK_REPEAT_MASK 0
#endif
#ifndef MK_REP_MODE
#define MK_REP_MODE 1
#endif
namespace pg8 {
#define PG8_LAS __attribute__((address_space(3)))
typedef unsigned short bf16_t;
typedef short bf16x8 __attribute__((ext_vector_type(8)));
typedef float f32x4 __attribute__((ext_vector_type(4)));
typedef unsigned u32x4 __attribute__((ext_vector_type(4)));
constexpr int BM = 256, BK = 64, HALF = 128, HTB = HALF * BK * 2  , STAGE_BYTES = 8 * HTB, NXCD = 8, WGM = 8;

__host__ __device__ __forceinline__ int lds_byte(int r, int c) { const int st = (r >> 4) * 2 + (c >> 5), rr = r & 15, cc = c & 31, ob = rr * 64 + cc * 2; return st * 1024 + (ob ^ (((ob >> 9) & 1) << 5)); }
__host__ __device__ __forceinline__ void stage_rc(int b, int& R, int& C) { const int st = b / 1024, sb = b % 1024, swz = sb ^ (((sb >> 9) & 1) << 5); R = (st >> 1) * 16 + swz / 64; C = (st & 1) * 32 + (swz % 64) / 2; }
__host__ __device__ __forceinline__ int perm32(int rho) { const int n = rho >> 4, i = rho & 15; return 8 * (i >> 2) + 4 * n + (i & 3); }

struct Unit { int pm, pn, e, j, cnt; };

__device__ __forceinline__ unsigned cvt_pk_bf16(float lo, float hi) { unsigned r; asm volatile("v_cvt_pk_bf16_f32 %0, %1, %2" : "=v"(r) : "v"(lo), "v"(hi)); return r; }

struct ProbPlain {
    const char* A; const char* Bt; int K, nM, nN, nwg, G, c;
    __device__ __forceinline__ void init(const void* A_, const void* Bt_, int M, int N, int K_, int G_, int c_) { A = (const char*)A_; Bt = (const char*)Bt_; K = K_; nM = M / BM; nN = N / BM; nwg = nM * nN; G = G_; c = c_; }
    __device__ __forceinline__ bool next(int i, Unit& u) const {
        const long L = (long)i * G + c; if (L >= nwg) return false;
        int wgid = (int)L; { const int q = nwg / NXCD, r = nwg % NXCD, xcd = wgid % NXCD, off = wgid / NXCD; wgid = (xcd < r ? xcd * (q + 1) : r * (q + 1) + (xcd - r) * q) + off; }
        const int nig = WGM * nN, gid = wgid / nig, fm = gid * WGM, gsz = (nM - fm) < WGM ? (nM - fm) : WGM;
        u.pm = fm + ((wgid % nig) % gsz); u.pn = (wgid % nig) / gsz; u.e = 0; u.j = 0; u.cnt = 0; return true;
    }
    __device__ __forceinline__ unsigned a_off(const Unit& u, int row) const { return (unsigned)(u.pm * BM + row) * (unsigned)(K * 2); }
    __device__ __forceinline__ const char* b_base(const Unit& u) const { return Bt + (size_t)u.pn * BM * K * 2; }
};

template <class Epi, class Prob, bool ALIGN_EPI>
__device__ __forceinline__ void gemm_phase(PG8_LAS unsigned char* lds, const Prob& S, const Epi& E) {
    int tid_ = threadIdx.x; asm volatile("" : "+v"(tid_)); const int tid = tid_, wid = __builtin_amdgcn_readfirstlane(tid >> 6), lane = tid & 63, wr = wid >> 2, wc = wid & 3, fr = lane & 15, fq = lane >> 4;
    const int K = S.K, nt = K / BK;
    int Rr[2], Cb[2]; unsigned voffB[2];
#pragma unroll
    for (int i = 0; i < 2; ++i) { int R, C; stage_rc(tid * 16 + i * 8192, R, C); const int Rb = Epi::PERM ? ((R & ~31) + perm32(R & 31)) : R;
        Rr[i] = R; Cb[i] = C * 2; voffB[i] = (unsigned)(Rb * K + C) * 2u; }
    const size_t kstep = (size_t)(BK * 2);
    const size_t hstep = (size_t)HALF * K * 2;
    const unsigned ldsw = (unsigned)wid * 1024u;
    const int aoff = lds_byte(wr * 64 + fr, fq * 8), boff = lds_byte(wc * 32 + fr, fq * 8);
#define PG8_SA(b, h) (((b) * 2 + (h)) * HTB)
#define PG8_SB(b, h) ((4 + (b) * 2 + (h)) * HTB)
#define PG8_STAGE(bufoff, gbase, voff) do { _Pragma("unroll") for (int _i = 0; _i < 2; ++_i) \
        __builtin_amdgcn_global_load_lds((const unsigned*)((const char*)(gbase) + (voff)[_i]), (PG8_LAS unsigned*)(lds + (bufoff) + ldsw + _i * 8192), 16, 0, 0); } while (0)
#define PG8_LDA(dst, b, h) do { _Pragma("unroll") for (int m = 0; m < 4; ++m) _Pragma("unroll") for (int k = 0; k < 2; ++k) dst[m][k] = *(const PG8_LAS bf16x8*)(lds + PG8_SA(b, h) + aoff + m * 2048 + k * 1024); } while (0)
#define PG8_LDB(dst, b, h) do { _Pragma("unroll") for (int n = 0; n < 2; ++n) _Pragma("unroll") for (int k = 0; k < 2; ++k) dst[n][k] = *(const PG8_LAS bf16x8*)(lds + PG8_SB(b, h) + boff + n * 2048 + k * 1024); } while (0)
#define PG8_MMA(ai, bj, At, Bt) do { __builtin_amdgcn_s_setprio(1); _Pragma("unroll") for (int m = 0; m < 4; ++m) _Pragma("unroll") for (int n = 0; n < 2; ++n) _Pragma("unroll") for (int k = 0; k < 2; ++k) \
        acc[ai][bj][m][n] = __builtin_amdgcn_mfma_f32_16x16x32_bf16(Bt[n][k], At[m][k], acc[ai][bj][m][n], 0, 0, 0); __builtin_amdgcn_s_setprio(0); } while (0)
#define PG8_WAIT_V(n) asm volatile("s_waitcnt vmcnt(" #n ")" ::: "memory")
#define PG8_WAIT_L(n) asm volatile("s_waitcnt lgkmcnt(" #n ")" ::: "memory")
#define PG8_BAR __builtin_amdgcn_s_barrier()
#define PG8_SCHED __builtin_amdgcn_sched_barrier(0)
    Unit cur, nxt; int ui = 0;
    if (!S.next(0, cur)) return;
    f32x4 acc[2][2][4][2];
#pragma unroll
    for (int a = 0; a < 2; ++a)
#pragma unroll
        for (int b = 0; b < 2; ++b)
#pragma unroll
            for (int m = 0; m < 4; ++m)
#pragma unroll
                for (int n = 0; n < 2; ++n) acc[a][b][m][n] = (f32x4){0.f, 0.f, 0.f, 0.f};
    bf16x8 At[4][2], B0[2][2], B1[2][2];
    const char* const Ab = S.A;
    unsigned cA0[2], cA1[2], nA0[2], nA1[2];
#pragma unroll
    for (int i = 0; i < 2; ++i) { cA0[i] = S.a_off(cur, Rr[i]) + (unsigned)Cb[i]; cA1[i] = S.a_off(cur, Rr[i] + HALF) + (unsigned)Cb[i]; }
    const char* cB = S.b_base(cur);
    PG8_STAGE(PG8_SB(0, 0), cB, voffB); PG8_STAGE(PG8_SB(0, 1), cB + hstep, voffB); PG8_STAGE(PG8_SA(0, 0), Ab, cA0); PG8_STAGE(PG8_SA(0, 1), Ab, cA1);
    if (wr == 1) PG8_BAR;
    PG8_WAIT_V(2); PG8_BAR;
    PG8_STAGE(PG8_SB(1, 0), cB + kstep, voffB); PG8_STAGE(PG8_SA(1, 0), Ab + kstep, cA0); PG8_STAGE(PG8_SB(1, 1), cB + hstep + kstep, voffB);
    PG8_WAIT_V(6); PG8_BAR;
    for (;;) {
        const bool has_next = S.next(ui + 1, nxt);
        const char* nB = cB;
#pragma unroll
        for (int i = 0; i < 2; ++i) { nA0[i] = cA0[i]; nA1[i] = cA1[i]; }
        if (has_next) { nB = S.b_base(nxt);
#pragma unroll
            for (int i = 0; i < 2; ++i) { nA0[i] = S.a_off(nxt, Rr[i]) + (unsigned)Cb[i]; nA1[i] = S.a_off(nxt, Rr[i] + HALF) + (unsigned)Cb[i]; } }
        for (int t = 0; t < nt; t += 2) {
            const bool last = (t == nt - 2);
            const char* a1 = Ab + (size_t)(t + 1) * kstep;
            const char* a2 = last ? Ab : Ab + (size_t)(t + 2) * kstep; const char* b2 = last ? nB : cB + (size_t)(t + 2) * kstep;
            const char* a3 = a2 + kstep; const char* b3 = b2 + kstep;
            unsigned x0[2], x1[2];
#pragma unroll
            for (int i = 0; i < 2; ++i) { x0[i] = last ? nA0[i] : cA0[i]; x1[i] = last ? nA1[i] : cA1[i]; }
            PG8_LDB(B0, 0, 0); PG8_LDB(B1, 0, 1); PG8_SCHED; PG8_LDA(At, 0, 0); PG8_STAGE(PG8_SA(1, 1), a1, cA1);
            PG8_WAIT_V(8); PG8_WAIT_L(0); PG8_BAR; PG8_MMA(0, 0, At, B0); PG8_MMA(0, 1, At, B1); PG8_BAR; PG8_SCHED;
            PG8_LDA(At, 0, 1); PG8_STAGE(PG8_SB(0, 0), b2, voffB); PG8_STAGE(PG8_SB(0, 1), b2 + hstep, voffB); PG8_STAGE(PG8_SA(0, 0), a2, x0);
            PG8_WAIT_V(8); PG8_WAIT_L(0); PG8_BAR; PG8_MMA(1, 0, At, B0); PG8_MMA(1, 1, At, B1); PG8_BAR; PG8_SCHED;
            PG8_LDB(B0, 1, 0); PG8_LDB(B1, 1, 1); PG8_SCHED; PG8_LDA(At, 1, 0); PG8_STAGE(PG8_SA(0, 1), a2, x1);
            PG8_WAIT_V(8); PG8_WAIT_L(0); PG8_BAR; PG8_MMA(0, 0, At, B0); PG8_MMA(0, 1, At, B1); PG8_BAR; PG8_SCHED;
            PG8_LDA(At, 1, 1); PG8_STAGE(PG8_SB(1, 0), b3, voffB); PG8_STAGE(PG8_SB(1, 1), b3 + hstep, voffB); PG8_STAGE(PG8_SA(1, 0), a3, x0);
            PG8_WAIT_V(8); PG8_WAIT_L(0); PG8_BAR; PG8_MMA(1, 0, At, B0); PG8_MMA(1, 1, At, B1); PG8_BAR; PG8_SCHED;
        }
        if constexpr (ALIGN_EPI) { if (wr == 0) PG8_BAR; }
        E(acc, cur, wr, wc, fr, fq);
        if (!has_next) break;
#pragma unroll
        for (int a = 0; a < 2; ++a)
#pragma unroll
            for (int b = 0; b < 2; ++b)
#pragma unroll
                for (int m = 0; m < 4; ++m)
#pragma unroll
                    for (int n = 0; n < 2; ++n) acc[a][b][m][n] = (f32x4){0.f, 0.f, 0.f, 0.f};
        cur = nxt; cB = nB; ++ui;
#pragma unroll
        for (int i = 0; i < 2; ++i) { cA0[i] = nA0[i]; cA1[i] = nA1[i]; }
        if constexpr (ALIGN_EPI) { if (wr == 1) PG8_BAR; }
    }
    PG8_WAIT_V(0);
    if constexpr (!ALIGN_EPI) { if (wr == 0) PG8_BAR; }
    PG8_BAR;
#undef PG8_SA
#undef PG8_SB
#undef PG8_STAGE
#undef PG8_LDA
#undef PG8_LDB
#undef PG8_MMA
#undef PG8_WAIT_V
#undef PG8_WAIT_L
#undef PG8_BAR
#undef PG8_SCHED
}
}
namespace attn_body {
using bf16=__hip_bfloat16;
using bf16x8=__attribute__((ext_vector_type(8)))short;
using s16x4=__attribute__((ext_vector_type(4)))short;
using f32x16=__attribute__((ext_vector_type(16)))float;
using u32x4=__attribute__((ext_vector_type(4)))unsigned;
using f32x4v=__attribute__((ext_vector_type(4)))float;
constexpr int BATCH=4,NHEAD=12,SEQ=4096,D=64;
constexpr int QP=768,KP=768,VP=768,OP=1024;
constexpr int NW=8,QBLK=32,QB=QBLK*NW,KVBLK=64,NQB=SEQ/QB;
constexpr int ATTN_UNIT_ROWS=QB;
__device__ __forceinline__ int crow(int r,int hi){return (r&3)+8*(r>>2)+4*hi;}
#define SBAR() __builtin_amdgcn_sched_barrier(0)
__device__ __forceinline__ void cmask(f32x16&p0,f32x16&p1,int jb,int qrel,int hi){
  const float NEG=-INFINITY; int kb=64*jb+4*hi;
  #pragma unroll
  for(int r=0;r<16;++r){int kv=kb+(r&3)+8*(r>>2); if(kv>qrel)p0[r]=NEG; if(kv+32>qrel)p1[r]=NEG;}
}

constexpr int NSLOT=3, SLOTB=8192;
constexpr int LDS_K=0, LDS_V=NSLOT*SLOTB, LDS_WS=2*NSLOT*SLOTB, LDS_OST=LDS_WS+NW*64*4, LDS_BYTES=LDS_OST+NW*4096, LDS_F=86016, LDS_F_BYTES=16384;
constexpr float C2=0.125f*1.4426950408889634f;
__device__ __forceinline__ void glds16(const void*gsrc,unsigned lds_dst){unsigned keep;
  asm volatile("s_mov_b32 %0, m0\n\ts_mov_b32 m0, %2\n\ts_nop 0\n\tglobal_load_lds_dwordx4 %1, off\n\ts_mov_b32 m0, %0":"=&s"(keep):"v"(gsrc),"s"(lds_dst):"memory");}
__device__ __forceinline__ float max3f(float a,float b,float c){float r;asm("v_max3_f32 %0, %1, %2, %3":"=v"(r):"v"(a),"v"(b),"v"(c));return r;}
__device__ __forceinline__ float max2f(float a,float b){float r;asm("v_max_f32_e32 %0, %1, %2":"=v"(r):"v"(a),"v"(b));return r;}
__device__ __forceinline__ float fadd_s(float a,float b){float r;asm("v_add_f32_e32 %0, %1, %2":"=v"(r):"v"(a),"v"(b));return r;}
__device__ __forceinline__ float fsub_s(float a,float b){float r;asm("v_sub_f32_e32 %0, %1, %2":"=v"(r):"v"(a),"v"(b));return r;}
typedef float f32x2_t __attribute__((ext_vector_type(2))); typedef __bf16 bf16x2_t __attribute__((ext_vector_type(2)));
__device__ __forceinline__ unsigned cvtpk_s(float lo,float hi){f32x2_t v={lo,hi};bf16x2_t b=__builtin_convertvector(v,bf16x2_t);return __builtin_bit_cast(unsigned,b);}
#define WAIT_BAR(N) asm volatile("s_waitcnt vmcnt(" #N ") lgkmcnt(0)\n\ts_barrier":::"memory")

__device__ __forceinline__ void qkt(f32x16&p0,f32x16&p1,const char*Kslot,const bf16x8*qr,int r32,int hi){
  const char*kb=Kslot+hi*1024+r32*16;
  #pragma unroll
  for(int d0=0;d0<4;++d0){
    const bf16x8 b0=*reinterpret_cast<const bf16x8*>(kb+d0*2048);
    const bf16x8 b1=*reinterpret_cast<const bf16x8*>(kb+d0*2048+512);
    p0=__builtin_amdgcn_mfma_f32_32x32x16_bf16(b0,qr[d0],p0,0,0,0);p1=__builtin_amdgcn_mfma_f32_32x32x16_bf16(b1,qr[d0],p1,0,0,0);}
}
typedef __attribute__((address_space(3))) const char* lds_cptr;
typedef short v4i16_t __attribute__((ext_vector_type(4)));
__device__ __forceinline__ void kload8(bf16x8*kf,lds_cptr kp){
  kf[0]=*(const __attribute__((address_space(3))) bf16x8*)(kp);      kf[1]=*(const __attribute__((address_space(3))) bf16x8*)(kp+512);
  kf[2]=*(const __attribute__((address_space(3))) bf16x8*)(kp+2048); kf[3]=*(const __attribute__((address_space(3))) bf16x8*)(kp+2560);
  kf[4]=*(const __attribute__((address_space(3))) bf16x8*)(kp+4096); kf[5]=*(const __attribute__((address_space(3))) bf16x8*)(kp+4608);
  kf[6]=*(const __attribute__((address_space(3))) bf16x8*)(kp+6144); kf[7]=*(const __attribute__((address_space(3))) bf16x8*)(kp+6656);
}
__device__ __forceinline__ void kload2(bf16x8*kf,lds_cptr kp,int j){ kf[2*j]=*(const __attribute__((address_space(3))) bf16x8*)(kp+j*2048); kf[2*j+1]=*(const __attribute__((address_space(3))) bf16x8*)(kp+j*2048+512); }
__device__ __forceinline__ s16x4 vtr(lds_cptr p){ return __builtin_bit_cast(s16x4,__builtin_amdgcn_ds_read_tr16_b64_v4i16((__attribute__((address_space(3))) v4i16_t*)p)); }
__device__ __forceinline__ float rowmax(const f32x16&p0,const f32x16&p1){
  float a=max3f(p0[0],p0[1],p1[0]),b=max3f(p0[2],p0[3],p1[1]);a=max3f(a,p1[2],p1[3]);
  #pragma unroll
  for(int r=4;r<16;r+=4){a=max3f(a,p0[r],p0[r+1]);b=max3f(b,p0[r+2],p0[r+3]);a=max3f(a,p1[r],p1[r+1]);b=max3f(b,p1[r+2],p1[r+3]);}
  const float m=max2f(a,b);
  auto rr=__builtin_amdgcn_permlane32_swap(__float_as_uint(m),__float_as_uint(m),false,false);
  return max2f(__uint_as_float(rr[0]),__uint_as_float(rr[1]));
}
__device__ __forceinline__ void pv(f32x16*o,int vb,bf16x8 pa0,bf16x8 pa1,bf16x8 pa2,bf16x8 pa3){
  #pragma unroll
  for(int d0=0;d0<2;++d0){s16x4 lo[4],hi[4];
    #pragma unroll
    for(int ks=0;ks<4;++ks){
      asm volatile("ds_read_b64_tr_b16 %0,%1 offset:%c2":"=&v"(lo[ks]):"v"(vb),"i"(d0*4096+ks*1024):"memory");
      asm volatile("ds_read_b64_tr_b16 %0,%1 offset:%c2":"=&v"(hi[ks]):"v"(vb),"i"(d0*4096+ks*1024+512):"memory");}
    asm volatile("s_waitcnt lgkmcnt(0)":::"memory");SBAR();
    #define PK(k) (bf16x8){lo[k][0],lo[k][1],lo[k][2],lo[k][3],hi[k][0],hi[k][1],hi[k][2],hi[k][3]}
    o[d0]=__builtin_amdgcn_mfma_f32_32x32x16_bf16(pa0,PK(0),o[d0],0,0,0);
    o[d0]=__builtin_amdgcn_mfma_f32_32x32x16_bf16(pa1,PK(1),o[d0],0,0,0);
    o[d0]=__builtin_amdgcn_mfma_f32_32x32x16_bf16(pa2,PK(2),o[d0],0,0,0);
    o[d0]=__builtin_amdgcn_mfma_f32_32x32x16_bf16(pa3,PK(3),o[d0],0,0,0);
    #undef PK
  }
}

#ifndef ATTN_STORE16
#define ATTN_STORE16(p,v) (*(u32x4*)(p)=(v))
#endif
template<int THRL> __device__ __forceinline__ void attn_unit(int b,int h,int qb,const bf16*Q,const bf16*__restrict__ K,const bf16*__restrict__ V,bf16*O,const float*F2seq,float skipthr,float bmax,char*shm){
  int tid_ = threadIdx.x; asm volatile("" : "+v"(tid_)); const int tid = tid_,lane=tid&63,r32=lane&31,hi=lane>>5; const int wid=__builtin_amdgcn_readfirstlane(tid>>6);
  const long rowbase=(long)b*SEQ; const int q0=qb*QB;
  int ts=0; { const int nb=q0>>6; bool c_=false; if(lane<nb) c_=(F2seq[q0]-F2seq[64*(lane+1)-1])<-skipthr; ts=__builtin_amdgcn_readfirstlane((int)__popcll(__ballot(c_))&~1); }
  typedef __attribute__((address_space(3))) float* lds_fptr; typedef __attribute__((address_space(3))) f32x4v* lds_f4ptr;
  const lds_fptr Fl=(lds_fptr)(shm+LDS_F);
  { const f32x4v*Fg=(const f32x4v*)(F2seq+64*ts); const int nF=(q0+QB-64*ts)>>2; for(int i=tid;i<nF;i+=NW*64)((lds_f4ptr)Fl)[i]=Fg[i]; }
  const float fq2=F2seq[q0+wid*QBLK+r32];
  const bf16*Qw=Q+(rowbase+q0+wid*QBLK)*QP+h*D;
  const bf16*Kh=K+(rowbase+64*ts)*KP+h*D,*Vh=V+(rowbase+64*ts)*VP+h*D;
  const unsigned lds0=(unsigned)(uintptr_t)shm;
  float*wsf=(float*)(shm+LDS_WS)+wid*64;
  const bf16*ksrc=Kh+(long)lane*KP+wid*8;
  const bf16*vsrc=Vh+(long)(16*(wid&3)+(lane>>2))*VP+(wid>>2)*32+(lane&3)*8;
  const unsigned kdst=lds0+LDS_K+wid*1024, vdst=lds0+LDS_V+wid*1024;
  #define DMA_K(t,slot) glds16(ksrc+(long)(t)*KVBLK*KP,(unsigned)__builtin_amdgcn_readfirstlane(kdst+(slot)))
  #define DMA_V(t,slot) glds16(vsrc+(long)(t)*KVBLK*VP,(unsigned)__builtin_amdgcn_readfirstlane(vdst+(slot)))
  const int vb0=(int)(lds0+LDS_V)+((lane>>4)&1)*32+(lane&3)*8+(4*hi+((lane&15)>>2))*64;
  const char*Kbase=shm+LDS_K; bf16x8 kf[8];
  const lds_cptr shm3=(lds_cptr)shm; const lds_cptr kp0=shm3+LDS_K+hi*1024+r32*16; const lds_cptr vp0=shm3+LDS_V+((lane>>4)&1)*32+(lane&3)*8+(4*hi+((lane&15)>>2))*64;
  const int NT=(q0+QB)/KVBLK-ts;
  DMA_K(0,0);DMA_V(0,0);DMA_K(1,SLOTB);
  bf16x8 qr[4];
  #pragma unroll
  for(int d0=0;d0<4;++d0)qr[d0]=*reinterpret_cast<const bf16x8*>(&Qw[(long)r32*QP+d0*16+hi*8]);
  float mhat=bmax,l_reg=0.f;
  f32x16 o[2];o[0]=f32x16{};o[1]=f32x16{};
  #define BIAS(C0,C1,t) do{ const float nb_=fq2-mhat; const lds_fptr fk_=Fl+64*(t)+4*hi; \
    _Pragma("unroll") for(int j_=0;j_<4;++j_){ const f32x4v a_=*(const lds_f4ptr)(fk_+8*j_); const f32x4v c_=*(const lds_f4ptr)(fk_+32+8*j_); \
      C0[4*j_]=nb_-a_.x; C0[4*j_+1]=nb_-a_.y; C0[4*j_+2]=nb_-a_.z; C0[4*j_+3]=nb_-a_.w; C1[4*j_]=nb_-c_.x; C1[4*j_+1]=nb_-c_.y; C1[4*j_+2]=nb_-c_.z; C1[4*j_+3]=nb_-c_.w; } }while(0)
  const int qrel=wid*QBLK+r32;
  #define CMASK(P0,P1,t) do{int jb_=(t)-(NT-4); if(jb_>=0)cmask(P0,P1,jb_,qrel,hi);}while(0)
  bool resc=false;
  #define START(P0,P1) do{ const float rm=rowmax(P0,P1); resc=false; \
    { const float dl=max2f(rm,0.f); mhat=fadd_s(mhat,dl); \
      _Pragma("unroll") for(int r=0;r<16;++r){P0[r]=fsub_s(P0[r],dl);P1[r]=fsub_s(P1[r],dl);} } \
    _Pragma("unroll") for(int r=0;r<16;++r)P0[r]=__builtin_amdgcn_exp2f(P0[r]); }while(0)
  #define RESC() do{ if(resc){ asm volatile("s_waitcnt lgkmcnt(0)":::"memory"); \
      _Pragma("unroll") for(int d_=0;d_<2;++d_) _Pragma("unroll") for(int r=0;r<16;++r)o[d_][r]*=wsf[crow(r,hi)]; } }while(0)
  f32x16 pA0,pA1,pB0,pB1;
  int sl_prev=0,sl_cur=0,sl_next=SLOTB;
  #define ROT() do{sl_prev=sl_cur;sl_cur=sl_next;sl_next=(sl_next==(NSLOT-1)*SLOTB)?0:sl_next+SLOTB;}while(0)
  DMA_K(2,2*SLOTB);
  WAIT_BAR(3);
  BIAS(pA0,pA1,0); qkt(pA0,pA1,Kbase,qr,r32,hi);asm volatile("s_nop 15\n\ts_nop 7":"+v"(pA0),"+v"(pA1));CMASK(pA0,pA1,0);
  START(pA0,pA1);
  _Pragma("unroll") for(int r=0;r<16;++r)pA1[r]=__builtin_amdgcn_exp2f(pA1[r]);
  WAIT_BAR(0);
  DMA_K(3,0);DMA_V(1,SLOTB);
  ROT();
  kload8(kf,kp0+sl_cur);
  WAIT_BAR(2);
  s16x4 vlo[8],vhi[8]; u32x4 pw0,pw1,pw2,pw3;
  #define PKW(P,B) cvtpk_s(P[B],P[B+1])
  #define PAF(k) __builtin_bit_cast(bf16x8,pw##k)
  #define VFR(i) (bf16x8){vlo[i][0],vlo[i][1],vlo[i][2],vlo[i][3],vhi[i][0],vhi[i][1],vhi[i][2],vhi[i][3]}
  #define PIN(x) asm volatile("":"+v"(x))
  #define MX3(a,b,c) __builtin_fmaxf(__builtin_fmaxf((a),(b)),(c))
  #define GAPA(MF,A0,A1,A2,A3,W0,W1,PW) do{ MF; sacc+=A0; sacc+=A1; sacc+=A2; sacc+=A3; PIN(sacc); W0; W1; PIN(PW); SBAR(); }while(0)
  #define EX(v) __builtin_amdgcn_exp2f(v)
  #define GAPB(MF,X,B) do{ MF; X[B]=EX(X[B]); X[B+1]=EX(X[B+1]); X[B+2]=EX(X[B+2]); X[B+3]=EX(X[B+3]); PIN(X); SBAR(); }while(0)
  #define VRD(i) do{ vlo[i]=vtr(vp_+(((i)>>2)*4096+((i)&3)*1024)); vhi[i]=vtr(vp_+(((i)>>2)*4096+((i)&3)*1024+512)); }while(0)
  #define KRD(G,j) do{ if(G){ kload2(kf,kp0+sl_next,j); SBAR(); } }while(0)
  #define STEP(C0,C1,P0,P1,t,GK,GV,GL) do{ SBAR(); \
    const lds_cptr vp_=vp0+sl_prev; \
    VRD(0); SBAR(); float sacc=(P0[0]+P0[1]); \
    GAPA(C0=__builtin_amdgcn_mfma_f32_32x32x16_bf16(kf[0],qr[0],C0,0,0,0), P0[2],P0[3],P0[4],P0[5],     pw0[0]=PKW(P0,0), pw0[1]=PKW(P0,2), pw0); \
    VRD(4); SBAR(); GAPA(C1=__builtin_amdgcn_mfma_f32_32x32x16_bf16(kf[1],qr[0],C1,0,0,0), P0[6],P0[7],P0[8],P0[9],     pw0[2]=PKW(P0,4), pw0[3]=PKW(P0,6), pw0); \
    VRD(1); SBAR(); GAPA(C0=__builtin_amdgcn_mfma_f32_32x32x16_bf16(kf[2],qr[1],C0,0,0,0),   P0[10],P0[11],P0[12],P0[13], pw1[0]=PKW(P0,8), pw1[1]=PKW(P0,10), pw1); \
    VRD(5); SBAR(); GAPA(C1=__builtin_amdgcn_mfma_f32_32x32x16_bf16(kf[3],qr[1],C1,0,0,0),   P0[14],P0[15],P1[0],P1[1],   pw1[2]=PKW(P0,12),pw1[3]=PKW(P0,14), pw1); \
    VRD(2); SBAR(); GAPA(C0=__builtin_amdgcn_mfma_f32_32x32x16_bf16(kf[4],qr[2],C0,0,0,0),   P1[2],P1[3],P1[4],P1[5],     pw2[0]=PKW(P1,0), pw2[1]=PKW(P1,2), pw2); \
    VRD(6); SBAR(); GAPA(C1=__builtin_amdgcn_mfma_f32_32x32x16_bf16(kf[5],qr[2],C1,0,0,0),   P1[6],P1[7],P1[8],P1[9],     pw2[2]=PKW(P1,4), pw2[3]=PKW(P1,6), pw2); \
    VRD(3); SBAR(); GAPA(C0=__builtin_amdgcn_mfma_f32_32x32x16_bf16(kf[6],qr[3],C0,0,0,0),   P1[10],P1[11],P1[12],P1[13], pw3[0]=PKW(P1,8), pw3[1]=PKW(P1,10), pw3); \
    VRD(7); SBAR(); GAPA(C1=__builtin_amdgcn_mfma_f32_32x32x16_bf16(kf[7],qr[3],C1,0,0,0),   P1[14],P1[15],0.f,0.f,       pw3[2]=PKW(P1,12),pw3[3]=PKW(P1,14), pw3); \
    l_reg+=sacc; \
    if(GK){DMA_K((t)+3,sl_cur);} if(GV){DMA_V((t)+1,sl_next);} \
    CMASK(C0,C1,t); \
    { float a=MX3(C0[0],C0[1],C1[0]),b=MX3(C0[2],C0[3],C1[1]); a=MX3(a,C1[2],C1[3]); \
      _Pragma("unroll") for(int r=4;r<16;r+=4){a=MX3(a,C0[r],C0[r+1]);b=MX3(b,C0[r+2],C0[r+3]);a=MX3(a,C1[r],C1[r+1]);b=MX3(b,C1[r+2],C1[r+3]);} \
      float rm=__builtin_fmaxf(a,b); { auto rr=__builtin_amdgcn_permlane32_swap(__float_as_uint(rm),__float_as_uint(rm),false,false); rm=__builtin_fmaxf(__uint_as_float(rr[0]),__uint_as_float(rr[1])); } \
      resc=false; \
      if(__builtin_expect(__any(rm>(float)THRL),0)){ const float dl=__builtin_fmaxf(rm,0.f); mhat+=dl; \
        _Pragma("unroll") for(int r=0;r<16;++r){C0[r]-=dl;C1[r]-=dl;} \
        const float f=__builtin_amdgcn_exp2f(-dl); l_reg*=f; if(hi==0)wsf[r32]=f; resc=true; } } \
    BIAS(P0,P1,(t)+1); \
    SBAR(); \
    GAPB(o[0]=__builtin_amdgcn_mfma_f32_32x32x16_bf16(PAF(0),VFR(0),o[0],0,0,0), C0,0); \
    GAPB(o[1]=__builtin_amdgcn_mfma_f32_32x32x16_bf16(PAF(0),VFR(4),o[1],0,0,0), C0,4); \
    KRD(GL,0); GAPB(o[0]=__builtin_amdgcn_mfma_f32_32x32x16_bf16(PAF(1),VFR(1),o[0],0,0,0), C0,8); \
    KRD(GL,1); GAPB(o[1]=__builtin_amdgcn_mfma_f32_32x32x16_bf16(PAF(1),VFR(5),o[1],0,0,0), C0,12); \
    KRD(GL,2); GAPB(o[0]=__builtin_amdgcn_mfma_f32_32x32x16_bf16(PAF(2),VFR(2),o[0],0,0,0), C1,0); \
    KRD(GL,3); GAPB(o[1]=__builtin_amdgcn_mfma_f32_32x32x16_bf16(PAF(2),VFR(6),o[1],0,0,0), C1,4); \
    GAPB(o[0]=__builtin_amdgcn_mfma_f32_32x32x16_bf16(PAF(3),VFR(3),o[0],0,0,0), C1,8); \
    GAPB(o[1]=__builtin_amdgcn_mfma_f32_32x32x16_bf16(PAF(3),VFR(7),o[1],0,0,0), C1,12); \
    }while(0)
  BIAS(pB0,pB1,1);
  int t=1;
  #undef CMASK
  #define CMASK(P0,P1,t) do{}while(0)
  for(;t+5<NT;t+=2){
    STEP(pB0,pB1,pA0,pA1,t,true,true,true);     WAIT_BAR(2); RESC(); ROT();
    STEP(pA0,pA1,pB0,pB1,t+1,true,true,true);   WAIT_BAR(2); RESC(); ROT();
  }
  #undef CMASK
  #define CMASK(P0,P1,t) do{int jb_=(t)-(NT-4); if(jb_>=0)cmask(P0,P1,jb_,qrel,hi);}while(0)
  #define ENDW(tt) do{ if((tt)+3<NT){WAIT_BAR(2);} else if((tt)+2<NT){WAIT_BAR(1);} else {WAIT_BAR(0);} }while(0)
  for(;t+1<NT;t+=2){
    STEP(pB0,pB1,pA0,pA1,t,(t+3<NT),(t+1<NT),(t+1<NT));       ENDW(t);   RESC(); ROT();
    STEP(pA0,pA1,pB0,pB1,t+1,(t+4<NT),(t+2<NT),(t+2<NT));     ENDW(t+1); RESC(); ROT();
  }
  STEP(pB0,pB1,pA0,pA1,NT-1,false,false,false); RESC();
  { float sacc=pB0[0]+pB0[1]; _Pragma("unroll") for(int r=2;r<16;++r)sacc+=pB0[r]; _Pragma("unroll") for(int r=0;r<16;++r)sacc+=pB1[r]; l_reg+=sacc;
    pw0=(u32x4){PKW(pB0,0),PKW(pB0,2),PKW(pB0,4),PKW(pB0,6)};pw1=(u32x4){PKW(pB0,8),PKW(pB0,10),PKW(pB0,12),PKW(pB0,14)};pw2=(u32x4){PKW(pB1,0),PKW(pB1,2),PKW(pB1,4),PKW(pB1,6)};pw3=(u32x4){PKW(pB1,8),PKW(pB1,10),PKW(pB1,12),PKW(pB1,14)};
    SBAR(); pv(o,vb0+sl_cur,PAF(0),PAF(1),PAF(2),PAF(3)); }
  #undef PKW
  #undef PAF
  #undef VFR
  #undef PIN
  #undef MX3
  #undef GAPA
  #undef GAPB
  #undef EX
  #undef VRD
  #undef KRD
  #undef STEP
  #undef ENDW
  {auto rr=__builtin_amdgcn_permlane32_swap(__float_as_uint(l_reg),__float_as_uint(l_reg),false,false);l_reg=__uint_as_float(rr[0])+__uint_as_float(rr[1]);}
  if(hi==0)wsf[32+r32]=l_reg;asm volatile("s_waitcnt lgkmcnt(0)":::"memory");
  float rli[16];
  #pragma unroll
  for(int r=0;r<16;++r)rli[r]=__builtin_amdgcn_rcpf(wsf[32+crow(r,hi)]);
  bf16*Ow=O+(rowbase+q0+wid*QBLK)*OP+h*D;
  { bf16*stg=(bf16*)(shm+LDS_OST)+wid*2048;
    #pragma unroll
    for(int r=0;r<16;++r){const int orow=crow(r,hi);
      #pragma unroll
      for(int d0=0;d0<2;++d0)stg[orow*64+d0*32+r32]=__float2bfloat16(o[d0][r]*rli[r]);}
    asm volatile("s_waitcnt lgkmcnt(0)":::"memory");
    #pragma unroll
    for(int i=0;i<4;++i){const int row=i*8+(lane>>3),ch=lane&7; const u32x4 v=*(const u32x4*)(stg+row*64+ch*8); ATTN_STORE16(Ow+(long)row*OP+ch*8,v);} }
  asm volatile("s_waitcnt lgkmcnt(0)\n\ts_barrier":::"memory");
  #undef DMA_K
  #undef DMA_V
  #undef CMASK
  #undef START
  #undef RESC
  #undef BIAS
  #undef ROT
}
constexpr int ATTN_LDS_BYTES=LDS_F+LDS_F_BYTES;
#undef SBAR
#undef WAIT_BAR
}
#define GAS __attribute__((address_space(1)))
#define LAS __attribute__((address_space(3)))
typedef unsigned short bf16;
typedef unsigned v4u __attribute__((ext_vector_type(4)));
typedef float f32x4 __attribute__((ext_vector_type(4)));
typedef short bf16x8 __attribute__((ext_vector_type(8)));
typedef GAS unsigned gu32;
typedef GAS unsigned long long gu64;
#define RLX_AGENT __ATOMIC_RELAXED, __HIP_MEMORY_SCOPE_AGENT
#define LDS_WAIT() asm volatile("s_waitcnt lgkmcnt(0)" ::: "memory")
#define VM_WAIT() asm volatile("s_waitcnt vmcnt(0)" ::: "memory")
__device__ __forceinline__ unsigned long long rt() { return __builtin_amdgcn_s_memrealtime(); }
__device__ __forceinline__ unsigned f2bf(float f) { unsigned u = __builtin_bit_cast(unsigned, f); return (u + 0x7fffu + ((u >> 16) & 1u)) >> 16; }
__device__ __forceinline__ unsigned pk2(float lo, float hi) { return f2bf(lo) | (f2bf(hi) << 16); }

#define XB_TMO      128
#define XB_XCNT(j)  (256  + 64 * (j))
#define XB_XSUB(j)  (1280 + 64 * (j))
#define XB_XGEN(j)  (2304 + 64 * (j))
#define XB_TOP      3328
#define XB_TOPGEN   3392
#define XCD_BAR_WORDS 3456
#define XB_SPIN_CAP (1u << 18)

__device__ __forceinline__ unsigned xb_ld(unsigned* p)              { return __hip_atomic_load(p, __ATOMIC_RELAXED, __HIP_MEMORY_SCOPE_AGENT); }
__device__ __forceinline__ unsigned xb_add(unsigned* p, unsigned v) { return __hip_atomic_fetch_add(p, v, __ATOMIC_RELAXED, __HIP_MEMORY_SCOPE_AGENT); }
__device__ __forceinline__ unsigned xb_xcc_id() { return (unsigned)__builtin_amdgcn_s_getreg((3 << 11) | 20) & 0xFu; }
#define XB_SPIN(cond, bar) do { unsigned _sp = 0; while (cond) { __builtin_amdgcn_s_sleep(1); \
    if ((++_sp & 255u) == 0u) { if (xb_ld(&(bar)[XB_TMO])) break; if (_sp > XB_SPIN_CAP) { atomicAdd(&(bar)[XB_TMO], 1u); break; } } } } while (0)

struct XcdBarrier {
    unsigned* bar; unsigned x;
    volatile LAS unsigned* st;
};

__device__ __forceinline__ XcdBarrier xcd_barrier_post(unsigned* bar, volatile LAS unsigned* st) {
    XcdBarrier b; b.bar = bar; b.x = xb_xcc_id(); b.st = st;
    if (threadIdx.x == 0) (void)xb_add(&bar[XB_XCNT(b.x)], 1u);
    return b;
}
__device__ __forceinline__ void xcd_barrier_complete(unsigned* bar, unsigned x, unsigned& nloc, unsigned& nx) {
    const unsigned G = gridDim.x * gridDim.y * gridDim.z;
    unsigned sum, cnt, mine, sp = 0u;
    for (;;) {
        sum = 0u; cnt = 0u; mine = 0u;
#pragma unroll
        for (unsigned j = 0; j < 16; ++j) { const unsigned c = xb_ld(&bar[XB_XCNT(j)]); sum += c; cnt += (c > 0u) ? 1u : 0u; mine = (j == x) ? c : mine; }
        if (sum == G) break;
        __builtin_amdgcn_s_sleep(1);
        if ((++sp & 255u) == 0u) { if (xb_ld(&bar[XB_TMO])) break; if (sp > XB_SPIN_CAP) { atomicAdd(&bar[XB_TMO], 1u); break; } }
    }
    nloc = mine > 0u ? mine : 1u; nx = cnt > 0u ? cnt : 1u;
}

__device__ __forceinline__ void xcd_barrier(const XcdBarrier& b) {
    asm volatile("s_waitcnt vmcnt(0)" ::: "memory");
    __syncthreads();
    if (threadIdx.x == 0) {
        unsigned* bar = b.bar;
        __builtin_amdgcn_s_waitcnt(0);
        unsigned nloc = b.st[0], nx = b.st[1];
        if (nloc == 0u) { xcd_barrier_complete(bar, b.x, nloc, nx); b.st[0] = nloc; b.st[1] = nx; }
        const unsigned old = xb_add(&bar[XB_XSUB(b.x)], 1u);
        const unsigned gen = old / nloc;
        if (old + 1u == (gen + 1u) * nloc) {
            __builtin_amdgcn_fence(__ATOMIC_RELEASE, "agent");
            asm volatile("s_waitcnt vmcnt(0)" ::: "memory");
            const unsigned og = xb_add(&bar[XB_TOP], 1u);
            const unsigned tg = og / nx;
            if (og + 1u == (tg + 1u) * nx) xb_add(&bar[XB_TOPGEN], 1u);
            else XB_SPIN(xb_ld(&bar[XB_TOPGEN]) == tg, bar);
            __builtin_amdgcn_fence(__ATOMIC_ACQUIRE, "agent");
            xb_add(&bar[XB_XGEN(b.x)], 1u);
            asm volatile("s_waitcnt vmcnt(0)" ::: "memory");
        } else {
            XB_SPIN(xb_ld(&bar[XB_XGEN(b.x)]) == gen, bar);
            __builtin_amdgcn_fence(__ATOMIC_ACQUIRE, "agent");
            asm volatile("s_waitcnt vmcnt(0)" ::: "memory");
        }
    }
    __syncthreads();
}
constexpr int NWAVES = 8, NTHR = NWAVES * 64;
constexpr int T_ = 16384, DM_ = 1024, SEQ_ = 4096, NBH = 48, NHEADS = 12;
constexpr int EV_LD = 2828, EV_N = 2816;
constexpr int NEXP = 16, EHID = 256, SLOTS = 36864;
constexpr float EPS_ = 1e-6f, LOG2E = 1.4426950408889634f;
constexpr int NPH = 17;
constexpr size_t MiB = 1u << 20;
constexpr size_t WS_CTL = 0, CTL_ZERO_BYTES = 1 * MiB;
constexpr size_t WS_WIN0 = 1 * MiB, WS_WOUT0 = 7 * MiB, WS_WIN1 = 9 * MiB, WS_WOUT1 = 13 * MiB, WS_WST = 15 * MiB, WS_WGU = 16 * MiB, WS_WD = 48 * MiB;
constexpr size_t WS_XN = 64 * MiB;
constexpr size_t WS_A = 96 * MiB;
constexpr size_t WS_U = WS_A, WS_V = WS_A + 8 * MiB, WS_Q = WS_A + 16 * MiB, WS_K = WS_A + 40 * MiB, WS_VAL = WS_A + 64 * MiB;
constexpr size_t WS_Y = WS_A, WS_H1 = WS_A;
constexpr size_t WS_MIX = 184 * MiB;
constexpr size_t WS_HID = 216 * MiB;
constexpr size_t WS_F2 = 234 * MiB, WS_LIST = 235 * MiB, WS_LISTW = 236 * MiB, WS_TOKE = 237 * MiB, WS_TOKP = 237 * MiB + 512 * 1024, WS_LISTR = 238 * MiB, WS_RS = 239 * MiB, WS_RS0 = 239 * MiB + 512 * 1024, WS_END = 240 * MiB;
static_assert(WS_Y + (size_t)SLOTS * 1024 * 2 <= WS_MIX && WS_HID + (size_t)SLOTS * 256 * 2 <= WS_F2 && WS_VAL + (size_t)T_ * 768 * 2 <= WS_MIX, "ws map");
constexpr int CW_TMO = 0, CW_BAR = 4096, CW_Q = 8192, CW_CNT0 = 16384, CW_CNT1 = 16384 + 1024, CW_CNTD = 16384 + 2048, CNT_STRIDE = 64;
constexpr int RING_BYTES = 131072, LDSCTL_OFF = RING_BYTES, MISC_OFF = LDSCTL_OFF + 320, LDS_BYTES = 147456;

__device__ __forceinline__ float wave_sum(float v) {
#pragma unroll
    for (int o = 1; o < 64; o <<= 1) v += __shfl_xor(v, o);
    return v;
}
__device__ __forceinline__ float fast_sigmoid(float z) { return __builtin_amdgcn_rcpf(1.f + __builtin_amdgcn_exp2f(-z * LOG2E)); }
__device__ __forceinline__ float gelu_tanh(float x) { const float z = 1.5957691216057308f * x * (1.f + 0.044715f * x * x); return x * fast_sigmoid(z); }
__device__ __forceinline__ float bf2f(unsigned short h) { return __builtin_bit_cast(float, (unsigned)h << 16); }


constexpr int TP = 1028;
template <int NC, bool XBF>
__device__ __forceinline__ void skinny_core(const void* X, int row0, const LAS float* wt, LAS float* part, LAS float* ssq, int wave, int lane) {
    const int rg = wave & 3, kh = wave >> 2, r = lane & 15, kq = lane >> 4, col = lane & 15;
    const GAS float* xp = (const GAS float*)X + (size_t)(row0 + 16 * rg + r) * DM_ + 512 * kh + 4 * kq; const GAS bf16* xb = (const GAS bf16*)X + (size_t)(row0 + 16 * rg + r) * DM_ + 512 * kh + 4 * kq;
    const LAS float* b0p = wt + (col < NC ? col : NC - 1) * TP + 512 * kh + 4 * kq;
    const LAS float* b1p = wt + ((NC > 16) ? (16 + (col & 3)) : 0) * TP + 512 * kh + 4 * kq;
    f32x4 acc0 = (f32x4){0.f, 0.f, 0.f, 0.f}, acc1 = (f32x4){0.f, 0.f, 0.f, 0.f}; float ss = 0.f;
#pragma unroll 1
    for (int jb = 0; jb < 2; ++jb) {
        f32x4 xv[16];
#pragma unroll
        for (int jj = 0; jj < 16; ++jj) { if (XBF) { const unsigned long long q = *(const GAS unsigned long long*)(xb + 16 * (16 * jb + jj)); xv[jj] = (f32x4){bf2f((unsigned short)(q & 0xffff)), bf2f((unsigned short)((q >> 16) & 0xffff)), bf2f((unsigned short)((q >> 32) & 0xffff)), bf2f((unsigned short)(q >> 48))}; }
            else xv[jj] = *(const GAS f32x4*)(xp + 16 * (16 * jb + jj)); }
#pragma unroll
        for (int jj = 0; jj < 16; ++jj) { const f32x4 b0 = *(const LAS f32x4*)(b0p + 16 * (16 * jb + jj)); const f32x4 x4 = xv[jj];
            ss += (x4.x * x4.x + x4.y * x4.y) + (x4.z * x4.z + x4.w * x4.w);
            acc0 = __builtin_amdgcn_mfma_f32_16x16x4f32(x4.x, b0.x, acc0, 0, 0, 0); acc0 = __builtin_amdgcn_mfma_f32_16x16x4f32(x4.y, b0.y, acc0, 0, 0, 0);
            acc0 = __builtin_amdgcn_mfma_f32_16x16x4f32(x4.z, b0.z, acc0, 0, 0, 0); acc0 = __builtin_amdgcn_mfma_f32_16x16x4f32(x4.w, b0.w, acc0, 0, 0, 0);
            if (NC > 16) { const f32x4 b1 = *(const LAS f32x4*)(b1p + 16 * (16 * jb + jj));
                acc1 = __builtin_amdgcn_mfma_f32_16x16x4f32(x4.x, b1.x, acc1, 0, 0, 0); acc1 = __builtin_amdgcn_mfma_f32_16x16x4f32(x4.y, b1.y, acc1, 0, 0, 0);
                acc1 = __builtin_amdgcn_mfma_f32_16x16x4f32(x4.z, b1.z, acc1, 0, 0, 0); acc1 = __builtin_amdgcn_mfma_f32_16x16x4f32(x4.w, b1.w, acc1, 0, 0, 0); } }
    }
    ss += __shfl_xor(ss, 16); ss += __shfl_xor(ss, 32);
    if (lane < 16) ssq[kh * 64 + 16 * rg + r] = ss;
#pragma unroll
    for (int i = 0; i < 4; ++i) { LAS float* pr = part + (kh * 64 + 16 * rg + 4 * kq + i) * 32; pr[col] = acc0[i]; if (NC > 16 && col < 4) pr[16 + col] = acc1[i]; }
    __syncthreads();
}
__device__ __forceinline__ void xn_tile(const float* X, unsigned char* ws, int row0, int wave, int lane) {
#pragma unroll 4
    for (int i = 0; i < 8; ++i) { const int m = row0 + 8 * wave + i;
        const GAS f32x4* xr = (const GAS f32x4*)(X + (size_t)m * DM_) + lane; GAS unsigned long long* o8 = (GAS unsigned long long*)(ws + WS_XN + (size_t)m * DM_ * 2) + lane;
        f32x4 v[4];
#pragma unroll
        for (int j = 0; j < 4; ++j) v[j] = xr[64 * j];
#pragma unroll
        for (int j = 0; j < 4; ++j) o8[64 * j] = (unsigned long long)pk2(v[j].x, v[j].y) | ((unsigned long long)pk2(v[j].z, v[j].w) << 32); }
}
struct TrItem { const float* src; bf16* dst; int ldw2, kp8; const float* gk; };
struct TrSrc { const float *w_in0, *w_out0, *w_in1, *w_out1, *w_gate, *w_up, *w_down, *g_od, *g_moe, *g_ev; };
constexpr int TR_P1_END = 16 * 88 + 3584;
constexpr int TR_I0 = 16 * 88, TR_I1 = 16 * 32, TR_IE = 16 * 128, TR_I2 = 16 * 64, TR_I3 = 8 * 32, TR_A_END = TR_I0 + TR_I1 + 3 * TR_IE, TR_NITEMS = TR_A_END + TR_I2 + TR_I3 + 3 * TR_IE;
__device__ __forceinline__ TrItem tr_decode(int it, const TrSrc& S, unsigned char* ws, int lane) {
    const float* W; int ldw, Kp, k0, n0, drow0; bf16* WT; int r = it; int layer = 0;
    int seg;
    if (r < TR_I0) seg = 0; else if ((r -= TR_I0) < TR_I1) seg = 1; else if ((r -= TR_I1) < TR_IE) seg = 2; else if ((r -= TR_IE) < TR_IE) seg = 3; else if ((r -= TR_IE) < TR_IE) seg = 4;
    else if ((r -= TR_IE) < TR_I2) seg = 5; else if ((r -= TR_I2) < TR_I3) seg = 6; else { layer = 1; if ((r -= TR_I3) < TR_IE) seg = 2; else if ((r -= TR_IE) < TR_IE) seg = 3; else { r -= TR_IE; seg = 4; } }
    if (seg == 0) { const int kb = r / 88, nb = r % 88, c = (32 * nb) & 255; W = S.w_in0; ldw = EV_LD; WT = (bf16*)(ws + WS_WIN0); Kp = 1024; k0 = 64 * kb; n0 = 32 * nb; drow0 = (n0 & ~255) + 128 * ((c >> 5) & 1) + 32 * (c >> 6); }
    else if (seg == 1) { const int kb = r / 32, nb = r % 32; W = S.w_out0; ldw = 1024; WT = (bf16*)(ws + WS_WOUT0); Kp = 1024; k0 = 64 * kb; n0 = 32 * nb; drow0 = n0; }
    else if (seg == 5) { const int kb = r / 64, nb = r % 64; W = S.w_in1; ldw = 2048; WT = (bf16*)(ws + WS_WIN1); Kp = 1024; k0 = 64 * kb; n0 = 32 * nb; drow0 = n0; }
    else if (seg == 6) { const int kb = r / 32, nb = r % 32; W = S.w_out1; ldw = 1024; WT = (bf16*)(ws + WS_WOUT1); Kp = 1024; k0 = 64 * kb; n0 = 32 * nb; drow0 = n0; }
    else { const int le = layer * NEXP + r / 128, rr = r % 128;
        if (seg == 2) { W = S.w_gate + (size_t)le * 1024 * 256; ldw = 256; WT = (bf16*)(ws + WS_WGU) + (size_t)le * 512 * 1024; Kp = 1024; k0 = 64 * (rr / 8); n0 = 32 * (rr % 8); drow0 = (n0 >> 7) * 256 + (n0 & 127); }
        else if (seg == 3) { W = S.w_up + (size_t)le * 1024 * 256; ldw = 256; WT = (bf16*)(ws + WS_WGU) + (size_t)le * 512 * 1024; Kp = 1024; k0 = 64 * (rr / 8); n0 = 32 * (rr % 8); drow0 = (n0 >> 7) * 256 + 128 + (n0 & 127); }
        else { W = S.w_down + (size_t)le * 256 * 1024; ldw = 1024; WT = (bf16*)(ws + WS_WD) + (size_t)le * 1024 * 256; Kp = 256; k0 = 64 * (rr / 32); n0 = 32 * (rr % 32); drow0 = n0; } }
    TrItem t; t.src = W + (size_t)(k0 + (lane >> 5)) * ldw + n0 + (lane & 31); t.ldw2 = 2 * ldw; t.dst = WT + (size_t)(drow0 + (lane >> 3)) * Kp + k0 + 8 * (lane & 7); t.kp8 = 8 * Kp;
    t.gk = (seg == 2 || seg == 3) ? S.g_moe + layer * 1024 + k0 + 8 * (lane & 7) : (seg == 5 ? S.g_od + k0 + 8 * (lane & 7) : (seg == 0 ? S.g_ev + k0 + 8 * (lane & 7) : nullptr)); return t;
}
template <class IN_T> __device__ __forceinline__ void convert_items(const IN_T in, unsigned char* ws, LAS float* scr, int lo, int hi, int widx, int nw, int lane) {
    TrSrc S{in[2], in[9], in[11], in[15], in[21], in[22], in[23], in[10], in[16], in[1]};
    float tv[32], tn[32]; TrItem cur{nullptr, nullptr, 0, 0, nullptr};
    if (lo + widx < hi) { cur = tr_decode(lo + widx, S, ws, lane);
#pragma unroll
        for (int i = 0; i < 32; ++i) tv[i] = cur.src[(size_t)i * cur.ldw2]; }
    for (int it = lo + widx; it < hi; it += nw) {
        TrItem nx = cur; const bool more = it + nw < hi;
        if (more) { nx = tr_decode(it + nw, S, ws, lane);
#pragma unroll
            for (int i = 0; i < 32; ++i) tn[i] = nx.src[(size_t)i * nx.ldw2]; }
#pragma unroll
        for (int i = 0; i < 32; ++i) scr[(2 * i + (lane >> 5)) * 33 + (lane & 31)] = tv[i];
        LDS_WAIT(); asm volatile("" ::: "memory");
        const int c = lane & 7; f32x4 ga = (f32x4){1.f, 1.f, 1.f, 1.f}, gb = ga; if (cur.gk) { ga = *(const GAS f32x4*)cur.gk; gb = *(const GAS f32x4*)(cur.gk + 4); }
#pragma unroll
        for (int j = 0; j < 4; ++j) { const LAS float* s = scr + (8 * c) * 33 + (lane >> 3) + 8 * j;
            v4u o; o.x = pk2(s[0 * 33] * ga.x, s[1 * 33] * ga.y); o.y = pk2(s[2 * 33] * ga.z, s[3 * 33] * ga.w); o.z = pk2(s[4 * 33] * gb.x, s[5 * 33] * gb.y); o.w = pk2(s[6 * 33] * gb.z, s[7 * 33] * gb.w);
            *(GAS v4u*)(cur.dst + (size_t)j * cur.kp8) = o; }
        LDS_WAIT(); asm volatile("" ::: "memory");
        cur = nx;
#pragma unroll
        for (int i = 0; i < 32; ++i) tv[i] = tn[i];
    }
}
template <class IN_T> __device__ __forceinline__ void fold_items(const IN_T in, unsigned char* ws, int widx, int nw, int lane) {
    const float* const w_pool = in[13]; const float* const p_scale = in[14]; const float* const w_out1 = in[15];
    for (int it = widx; it < 4 * 32 * 16; it += nw) {
        const int itu = __builtin_amdgcn_readfirstlane(it), g = itu >> 9, c0 = ((itu >> 4) & 31) * 4, n = (itu & 15) * 64 + lane;
        const float* wp = w_pool + (size_t)(g * 128 + c0) * 128; const float* sc = p_scale + g * 128; const float* wo = w_out1 + (size_t)(512 + g * 128) * 1024 + n;
        float a[4];
#pragma unroll
        for (int c = 0; c < 4; ++c) a[c] = 0.f;
#pragma unroll 32
        for (int d = 0; d < 128; ++d) { const float t = sc[d] * wo[(size_t)d * 1024];
#pragma unroll
            for (int c = 0; c < 4; ++c) a[c] += wp[c * 128 + d] * t; }
        *(GAS unsigned long long*)((bf16*)(ws + WS_WOUT1) + (size_t)n * 1024 + 512 + g * 128 + c0) = (unsigned long long)pk2(a[0], a[1]) | ((unsigned long long)pk2(a[2], a[3]) << 32); }
}
template <class IN_T> __device__ __forceinline__ void p0_prologue(const IN_T in, unsigned char* ws, LAS unsigned char* lds, int G, int vcu) {
    int tid_ = threadIdx.x; asm volatile("" : "+v"(tid_)); const int tid = tid_, lane = tid & 63, wave = __builtin_amdgcn_readfirstlane(tid >> 6);
    const int gw = vcu * NWAVES + wave, NGW = G * NWAVES;
    convert_items(in, ws, (LAS float*)(lds + wave * 16384), 0, TR_I0, gw, NGW, lane); convert_items(in, ws, (LAS float*)(lds + wave * 16384), TR_P1_END, TR_A_END, gw, NGW, lane);
    fold_items(in, ws, gw, NGW, lane);
    const int gt = vcu * NTHR + tid, NGT = G * NTHR;
    { const float* const w_s = in[4]; for (int i = gt; i < 4 * 128 * 128; i += NGT) { const int s = i & 127, t = (i >> 7) & 127; ((GAS bf16*)(ws + WS_WST))[i] = (s <= t) ? (bf16)f2bf(w_s[i]) : (bf16)0; } }
    __syncthreads();
    LAS float* wf = (LAS float*)lds; LAS float* part = (LAS float*)(lds + 98304); LAS float* ssq = part + 2 * 64 * 32; LAS float* rstd_l = ssq + 128;
    const float* const x = in[0]; const float* const gn = in[1]; const float* const b_forget = in[3];
    { const float* const w_in0 = in[2];
#pragma unroll
      for (int kk = 0; kk < 2; ++kk) { const int k = tid + NTHR * kk; const GAS f32x4* src = (const GAS f32x4*)(w_in0 + (size_t)k * EV_LD + EV_N); const f32x4 q0 = src[0], q1 = src[1], q2 = src[2]; const float g = gn[k];
          wf[0 * TP + k] = q0.x * g; wf[1 * TP + k] = q0.y * g; wf[2 * TP + k] = q0.z * g; wf[3 * TP + k] = q0.w * g; wf[4 * TP + k] = q1.x * g; wf[5 * TP + k] = q1.y * g; wf[6 * TP + k] = q1.z * g; wf[7 * TP + k] = q1.w * g;
          wf[8 * TP + k] = q2.x * g; wf[9 * TP + k] = q2.y * g; wf[10 * TP + k] = q2.z * g; wf[11 * TP + k] = q2.w * g; } }
    __syncthreads();
    for (int tile = vcu; tile < T_ / 64; tile += G) { const int row0 = tile * 64;
        skinny_core<12, false>(x, row0, wf, part, ssq, wave, lane);
        if (tid < 64) { const int m = row0 + tid; const float rstd = __builtin_amdgcn_rsqf((ssq[tid] + ssq[64 + tid]) * (1.f / DM_) + EPS_); ((GAS float*)(ws + WS_RS0))[m] = rstd;
            GAS float* f2 = (GAS float*)(ws + WS_F2) + (size_t)((m >> 12) * NHEADS) * SEQ_ + (m & (SEQ_ - 1));
#pragma unroll
            for (int h = 0; h < 12; ++h) { const float z = (part[tid * 32 + h] + part[(64 + tid) * 32 + h]) * rstd + b_forget[h];
                const float ls = (z >= 0.f) ? -log1pf(__expf(-z)) : (z - log1pf(__expf(z)));
                f2[(size_t)h * SEQ_] = ls * LOG2E; } }
        xn_tile(x, ws, row0, wave, lane);
        __syncthreads();
    }
}

__device__ __forceinline__ void scan_seq(float* f, LAS float* tot) {
    int tid_ = threadIdx.x; asm volatile("" : "+v"(tid_)); const int tid = tid_, lane = tid & 63, wave = tid >> 6;
    GAS f32x4* p = (GAS f32x4*)f + 2 * tid; f32x4 a = p[0], b = p[1];
    a.y += a.x; a.z += a.y; a.w += a.z; b.x += a.w; b.y += b.x; b.z += b.y; b.w += b.z;
    float run = b.w;
#pragma unroll
    for (int o = 1; o < 64; o <<= 1) { const float t = __shfl_up(run, o); if (lane >= o) run += t; }
    if (lane == 63) tot[wave] = run;
    __syncthreads();
    float base = run - b.w;
    for (int w = 0; w < wave; ++w) base += tot[w];
    a = a + base; b = b + base; p[0] = a; p[1] = b;
    __syncthreads();
}

struct EpiInproj0 {
    static constexpr bool PERM = true;
    bf16 *U, *V, *Q, *Kb, *VAL; const float *g_v, *g_q, *g_k, *rs;
    __device__ __forceinline__ void operator()(const pg8::f32x4 (&acc)[2][2][4][2], const pg8::Unit& u, int wr, int wc, int fr, int fq) const {
        const int pn = u.pn; const bool act = pn <= 1, nrm = (pn >= 1 && pn <= 7);
        bf16* dst; int pitch, cb; const float* gp = nullptr; float gs = 1.f;
        if (pn == 0) { dst = U; pitch = 256; cb = 0; }
        else if (pn == 1) { dst = V; pitch = 256; cb = 0; gp = g_v + wc * 64; }
        else if (pn <= 4) { dst = Q; pitch = 768; cb = (pn - 2) * 256; gp = g_q; gs = 0.125f * LOG2E; }
        else if (pn <= 7) { dst = Kb; pitch = 768; cb = (pn - 5) * 256; gp = g_k; }
        else { dst = VAL; pitch = 768; cb = (pn - 8) * 256; }
        f32x4 gn[2][2];
#pragma unroll
        for (int bj = 0; bj < 2; ++bj)
#pragma unroll
            for (int n = 0; n < 2; ++n) { gn[bj][n] = (f32x4){1.f, 1.f, 1.f, 1.f}; if (nrm) gn[bj][n] = *(const f32x4*)(gp + 32 * bj + 8 * fq + 4 * n) * gs; }
        const int row0 = u.pm * 256 + wr * 64 + fr, col0 = cb + 64 * wc + 8 * fq;
#pragma unroll
        for (int ai = 0; ai < 2; ++ai)
#pragma unroll
            for (int m = 0; m < 4; ++m) { const float rin = rs[row0 + ai * 128 + m * 16];
                f32x4 x[2][2]; float ss = 0.f;
#pragma unroll
                for (int bj = 0; bj < 2; ++bj)
#pragma unroll
                    for (int n = 0; n < 2; ++n) { f32x4 t = acc[ai][bj][m][n] * rin;
                        if (act) { t.x = gelu_tanh(t.x); t.y = gelu_tanh(t.y); t.z = gelu_tanh(t.z); t.w = gelu_tanh(t.w); }
                        ss += (t.x * t.x + t.y * t.y) + (t.z * t.z + t.w * t.w); x[bj][n] = t; }
                float r = 1.f;
                if (nrm) { ss += __shfl_xor(ss, 16); ss += __shfl_xor(ss, 32); r = __builtin_amdgcn_rsqf(ss * (1.f / 64.f) + EPS_); }
                bf16* rowp = dst + (size_t)(row0 + ai * 128 + m * 16) * pitch + col0;
#pragma unroll
                for (int bj = 0; bj < 2; ++bj) { const f32x4 v0 = x[bj][0] * gn[bj][0] * r, v1 = x[bj][1] * gn[bj][1] * r;
                    v4u w; w.x = pg8::cvt_pk_bf16(v0.x, v0.y); w.y = pg8::cvt_pk_bf16(v0.z, v0.w); w.z = pg8::cvt_pk_bf16(v1.x, v1.y); w.w = pg8::cvt_pk_bf16(v1.z, v1.w);
                    *(v4u*)(rowp + 32 * bj) = w; }
            }
    }
};
template <bool BASE_F32>
struct EpiRes {
    static constexpr bool PERM = true;
    const float* basef; bf16* xres;
    __device__ __forceinline__ void operator()(const pg8::f32x4 (&acc)[2][2][4][2], const pg8::Unit& u, int wr, int wc, int fr, int fq) const {
        const int row0 = u.pm * 256 + wr * 64 + fr, col0 = u.pn * 256 + wc * 32 + 8 * fq;
#pragma unroll
        for (int ai = 0; ai < 2; ++ai) {
            f32x4 b[4][2][2];
#pragma unroll
            for (int m = 0; m < 4; ++m)
#pragma unroll
                for (int bj = 0; bj < 2; ++bj) { const size_t off = (size_t)(row0 + ai * 128 + m * 16) * DM_ + col0 + bj * 128;
                    if (BASE_F32) { b[m][bj][0] = *(const f32x4*)(basef + off); b[m][bj][1] = *(const f32x4*)(basef + off + 4); }
                    else { const v4u q = *(const v4u*)(xres + off);
                        b[m][bj][0] = (f32x4){__builtin_bit_cast(float, q.x << 16), __builtin_bit_cast(float, q.x & 0xffff0000u), __builtin_bit_cast(float, q.y << 16), __builtin_bit_cast(float, q.y & 0xffff0000u)};
                        b[m][bj][1] = (f32x4){__builtin_bit_cast(float, q.z << 16), __builtin_bit_cast(float, q.z & 0xffff0000u), __builtin_bit_cast(float, q.w << 16), __builtin_bit_cast(float, q.w & 0xffff0000u)}; } }
#pragma unroll
            for (int m = 0; m < 4; ++m)
#pragma unroll
                for (int bj = 0; bj < 2; ++bj) { const f32x4 x0 = b[m][bj][0] + acc[ai][bj][m][0], x1 = b[m][bj][1] + acc[ai][bj][m][1];
                    v4u w; w.x = pg8::cvt_pk_bf16(x0.x, x0.y); w.y = pg8::cvt_pk_bf16(x0.z, x0.w); w.z = pg8::cvt_pk_bf16(x1.x, x1.y); w.w = pg8::cvt_pk_bf16(x1.z, x1.w);
                    *(v4u*)(xres + (size_t)(row0 + ai * 128 + m * 16) * DM_ + col0 + bj * 128) = w; }
            asm volatile("" ::: "memory"); }
    }
};
struct EpiBf16 {
    static constexpr bool PERM = true;
    bf16* O; int ldc; const float* rs;
    __device__ __forceinline__ void operator()(const pg8::f32x4 (&acc)[2][2][4][2], const pg8::Unit& u, int wr, int wc, int fr, int fq) const {
        const int row0 = u.pm * 256 + wr * 64 + fr, col0 = u.pn * 256 + wc * 32 + 8 * fq;
#pragma unroll
        for (int ai = 0; ai < 2; ++ai)
#pragma unroll
            for (int m = 0; m < 4; ++m) { bf16* rowp = O + (size_t)(row0 + ai * 128 + m * 16) * ldc + col0; const float r = rs ? rs[row0 + ai * 128 + m * 16] : 1.f;
#pragma unroll
                for (int bj = 0; bj < 2; ++bj) { const f32x4 v0 = acc[ai][bj][m][0] * r, v1 = acc[ai][bj][m][1] * r;
                    v4u w; w.x = pg8::cvt_pk_bf16(v0.x, v0.y); w.y = pg8::cvt_pk_bf16(v0.z, v0.w); w.z = pg8::cvt_pk_bf16(v1.x, v1.y); w.w = pg8::cvt_pk_bf16(v1.z, v1.w);
                    *(v4u*)(rowp + bj * 128) = w; } }
    }
};
struct EpiGateUp {
    static constexpr bool PERM = true;
    bf16* HID; const float* listw; const float* listr;
    __device__ __forceinline__ void operator()(const pg8::f32x4 (&acc)[2][2][4][2], const pg8::Unit& u, int wr, int wc, int fr, int fq) const {
        const int col0 = u.pn * 128 + wc * 32 + 8 * fq;
#pragma unroll
        for (int ai = 0; ai < 2; ++ai)
#pragma unroll
            for (int m = 0; m < 4; ++m) { const int rt = ai * 128 + wr * 64 + m * 16 + fr, pos = u.j * 256 + rt;
                const bool ok = pos < u.cnt; const float w = ok ? listw[(size_t)u.e * T_ + pos] : 0.f, rs = ok ? listr[(size_t)u.e * T_ + pos] : 0.f;
                f32x4 h[2];
#pragma unroll
                for (int n = 0; n < 2; ++n) { const f32x4 g = acc[ai][0][m][n] * rs, up = acc[ai][1][m][n] * rs;
                    h[n].x = g.x * fast_sigmoid(g.x) * up.x * w; h[n].y = g.y * fast_sigmoid(g.y) * up.y * w; h[n].z = g.z * fast_sigmoid(g.z) * up.z * w; h[n].w = g.w * fast_sigmoid(g.w) * up.w * w; }
                v4u o; o.x = pg8::cvt_pk_bf16(h[0].x, h[0].y); o.y = pg8::cvt_pk_bf16(h[0].z, h[0].w); o.z = pg8::cvt_pk_bf16(h[1].x, h[1].y); o.w = pg8::cvt_pk_bf16(h[1].z, h[1].w);
                *(v4u*)(HID + (size_t)(u.pm * 256 + rt) * EHID + col0) = o; }
    }
};
__device__ __forceinline__ int moe_mtiles(unsigned* cnt) { int pre = 0;
#pragma unroll
    for (int e = 0; e < NEXP; ++e) pre += ((int)__builtin_amdgcn_readfirstlane(__hip_atomic_load(cnt + CNT_STRIDE * e, __ATOMIC_RELAXED, __HIP_MEMORY_SCOPE_AGENT)) + 255) >> 8;
    return pre; }
struct ProbMoe {
    const char* A; const char* Bt; int K, nN; unsigned* cnt; const int* list; bool gather; size_t bstride;
    int ubase, ulim, Geff, ceff; bool xcd_map;
    __device__ __forceinline__ bool next(int i, pg8::Unit& u) const {
        if (ceff < 0) return false;
        const int L = ubase + i * Geff + ceff; if (L >= ulim) return false;
        int mt = L / nN, pn_ = L % nN;
        if (xcd_map) { const int x = L & 7, r = L >> 3; mt = 8 * (r / nN) + x; pn_ = r % nN; }
        int pre = 0; bool found = false;
#pragma unroll
        for (int e = 0; e < NEXP; ++e) { const int ce = (int)__builtin_amdgcn_readfirstlane(__hip_atomic_load(cnt + CNT_STRIDE * e, __ATOMIC_RELAXED, __HIP_MEMORY_SCOPE_AGENT)); const int tl = (ce + 255) >> 8;
            if (mt >= pre && mt < pre + tl) { u.e = e; u.j = mt - pre; u.cnt = ce; found = true; } pre += tl; }
        u.pm = mt; u.pn = pn_; return found;
    }
    __device__ __forceinline__ unsigned a_off(const pg8::Unit& u, int row) const {
        if (gather) { int pos = u.j * 256 + row; pos = pos < u.cnt ? pos : u.cnt - 1; const int tok = list[(size_t)u.e * T_ + pos]; return (unsigned)tok * (unsigned)(K * 2); }
        return (unsigned)(u.pm * 256 + row) * (unsigned)(K * 2);
    }
    __device__ __forceinline__ const char* b_base(const pg8::Unit& u) const { return Bt + (size_t)u.e * bstride + (size_t)u.pn * 256 * K * 2; }
};

__device__ __forceinline__ void gmlp_unit(int idx, const bf16* U, const bf16* V, const bf16* WST, const float* b_s, bf16* MIX, LAS unsigned char* lds) {
    int tid_ = threadIdx.x; asm volatile("" : "+v"(tid_)); const int tid = tid_, lane = tid & 63, wave = __builtin_amdgcn_readfirstlane(tid >> 6), fr = lane & 15, fq = lane >> 4;
    const int c = idx >> 2, g = idx & 3, tok0 = c * 128;
    LAS bf16* Vt = (LAS bf16*)lds;
#pragma unroll
    for (int i = 0; i < 2; ++i) { const int p = tid + NTHR * i, s = p >> 3, dc = p & 7;
        const v4u q = *(const GAS v4u*)(V + (size_t)(tok0 + s) * 256 + g * 64 + dc * 8);
        const unsigned w[4] = {q.x, q.y, q.z, q.w};
#pragma unroll
        for (int e = 0; e < 4; ++e) { Vt[(dc * 8 + 2 * e) * 136 + s] = (bf16)(w[e] & 0xffffu); Vt[(dc * 8 + 2 * e + 1) * 136 + s] = (bf16)(w[e] >> 16); } }
    __syncthreads();
    const int t0 = 16 * wave;
    pg8::f32x4 acc[4];
#pragma unroll
    for (int n = 0; n < 4; ++n) acc[n] = (pg8::f32x4){0.f, 0.f, 0.f, 0.f};
#pragma unroll
    for (int ks = 0; ks < 4; ++ks) {
        const bf16x8 wfrag = *(const GAS bf16x8*)(WST + (size_t)(g * 128 + t0 + fr) * 128 + 32 * ks + 8 * fq);
#pragma unroll
        for (int n = 0; n < 4; ++n) { const bf16x8 vfrag = *(const LAS bf16x8*)(Vt + (16 * n + fr) * 136 + 32 * ks + 8 * fq);
            acc[n] = __builtin_amdgcn_mfma_f32_16x16x32_bf16(vfrag, wfrag, acc[n], 0, 0, 0); }
    }
    const int t = t0 + fr; const float bs = b_s[g * 128 + t];
#pragma unroll
    for (int n = 0; n < 4; ++n) { const size_t ucol = (size_t)(tok0 + t) * 256 + g * 64 + 16 * n + 4 * fq;
        const unsigned long long uu = *(const GAS unsigned long long*)(U + ucol);
        const float u0 = bf2f((unsigned short)(uu & 0xffff)), u1 = bf2f((unsigned short)((uu >> 16) & 0xffff)), u2 = bf2f((unsigned short)((uu >> 32) & 0xffff)), u3 = bf2f((unsigned short)(uu >> 48));
        const unsigned lo = pk2(u0 * (acc[n].x + bs), u1 * (acc[n].y + bs)), hi = pk2(u2 * (acc[n].z + bs), u3 * (acc[n].w + bs));
        *(GAS unsigned long long*)(MIX + (size_t)(tok0 + t) * 1024 + g * 64 + 16 * n + 4 * fq) = (unsigned long long)lo | ((unsigned long long)hi << 32); }
    __syncthreads();
}

#if MK_NAIVE_ATTN
__device__ __forceinline__ void naive_attn(const bf16* Q, const bf16* K, const bf16* V, const float* F2, bf16* MIXo, int gt, int NGT) {
    for (int r = gt; r < NBH * SEQ_; r += NGT) { const int bh = r / SEQ_, t = r % SEQ_, b = bh / NHEADS, h = bh % NHEADS; const size_t row = (size_t)b * SEQ_ + t;
        float q[64], o[64];
#pragma unroll
        for (int d = 0; d < 64; ++d) { q[d] = bf2f(Q[row * 768 + h * 64 + d]); o[d] = 0.f; }
        float m = -INFINITY, l = 0.f; const float ft = F2[(size_t)bh * SEQ_ + t];
        for (int s = 0; s <= t; ++s) { const size_t rs = (size_t)b * SEQ_ + s; float sc = 0.f;
#pragma unroll
            for (int d = 0; d < 64; ++d) sc += q[d] * bf2f(K[rs * 768 + h * 64 + d]);
            sc += ft - F2[(size_t)bh * SEQ_ + s];
            const float mn = fmaxf(m, sc), al = exp2f(m - mn), p = exp2f(sc - mn); l = l * al + p; m = mn;
#pragma unroll
            for (int d = 0; d < 64; ++d) o[d] = o[d] * al + p * bf2f(V[rs * 768 + h * 64 + d]); }
        const float il = 1.f / l;
#pragma unroll
        for (int d = 0; d < 64; ++d) MIXo[row * 1024 + 256 + h * 64 + d] = (bf16)f2bf(o[d] * il); }
}
#endif

template <class IN_T> __device__ __forceinline__ void phase_route(const IN_T in, int layer, const bf16* X, unsigned char* ws, unsigned* cnt, LAS unsigned char* lds, int G, int vcu, int rep) {
    int tid_ = threadIdx.x; asm volatile("" : "+v"(tid_)); const int tid = tid_, lane = tid & 63, wave = __builtin_amdgcn_readfirstlane(tid >> 6);
    LAS float* wt = (LAS float*)lds;
    LAS float* part = (LAS float*)(lds + 98304); LAS float* ssq = part + 2 * 64 * 32; LAS float* rstd_l = ssq + 128; LAS unsigned* lcnt = (LAS unsigned*)(rstd_l + 64); LAS unsigned* lbase = lcnt + 16;
    const float* wg = in[17] + (size_t)layer * 1024 * 4; const float* wrt = in[19] + (size_t)layer * 1024 * 16; const float* gn = in[16] + (size_t)layer * 1024;
#pragma unroll
    for (int kk = 0; kk < 2; ++kk) { const int k = tid + NTHR * kk; const f32x4 q0 = *(const GAS f32x4*)(wg + k * 4); const GAS f32x4* rs = (const GAS f32x4*)(wrt + k * 16); const f32x4 q1 = rs[0], q2 = rs[1], q3 = rs[2], q4 = rs[3]; const float g = gn[k];
        wt[0 * TP + k] = q0.x * g; wt[1 * TP + k] = q0.y * g; wt[2 * TP + k] = q0.z * g; wt[3 * TP + k] = q0.w * g;
        wt[4 * TP + k] = q1.x * g; wt[5 * TP + k] = q1.y * g; wt[6 * TP + k] = q1.z * g; wt[7 * TP + k] = q1.w * g; wt[8 * TP + k] = q2.x * g; wt[9 * TP + k] = q2.y * g; wt[10 * TP + k] = q2.z * g; wt[11 * TP + k] = q2.w * g;
        wt[12 * TP + k] = q3.x * g; wt[13 * TP + k] = q3.y * g; wt[14 * TP + k] = q3.z * g; wt[15 * TP + k] = q3.w * g; wt[16 * TP + k] = q4.x * g; wt[17 * TP + k] = q4.y * g; wt[18 * TP + k] = q4.z * g; wt[19 * TP + k] = q4.w * g; }
    const float* bg = in[18] + layer * 4; const float* br = in[20] + layer * 16;
    int* list = (int*)(ws + WS_LIST); float* listw = (float*)(ws + WS_LISTW); float* listr = (float*)(ws + WS_LISTR); int* toke = (int*)(ws + WS_TOKE); int* tokp = (int*)(ws + WS_TOKP);
    for (int tile = vcu; tile < T_ / 64; tile += G) { const int row0 = tile * 64;
        if (tid < 16) lcnt[tid] = 0u;
        __syncthreads();
        skinny_core<20, true>(X, row0, wt, part, ssq, wave, lane);
        int e1 = 0, e2 = 0; float w1 = 0.f, w2 = 0.f; unsigned r1 = 0, r2 = 0;
        if (tid < 64) {
            const float rstd = __builtin_amdgcn_rsqf((ssq[tid] + ssq[64 + tid]) * (1.f / DM_) + EPS_); rstd_l[tid] = rstd;
            float a[20];
#pragma unroll
            for (int c = 0; c < 20; ++c) a[c] = (part[tid * 32 + c] + part[(64 + tid) * 32 + c]) * rstd;
            float lg[4]; int gi = 0; float gmax;
#pragma unroll
            for (int j = 0; j < 4; ++j) lg[j] = a[j] + bg[j];
            gmax = lg[0];
#pragma unroll
            for (int j = 1; j < 4; ++j) if (lg[j] > gmax) { gmax = lg[j]; gi = j; }
            float gsum = 0.f;
#pragma unroll
            for (int j = 0; j < 4; ++j) gsum += __expf(lg[j] - gmax);
            const float gtop = 1.f / gsum;
            float le[4];
#pragma unroll
            for (int e = 0; e < 4; ++e) { float s = 0.f;
#pragma unroll
                for (int j = 0; j < 4; ++j) s = (gi == j) ? (a[4 + 4 * j + e] + br[4 * j + e]) : s;
                le[e] = s; }
            int i1 = 0; float m1 = le[0];
#pragma unroll
            for (int e = 1; e < 4; ++e) if (le[e] > m1) { m1 = le[e]; i1 = e; }
            int i2 = -1; float m2 = -INFINITY;
#pragma unroll
            for (int e = 0; e < 4; ++e) if (e != i1 && le[e] > m2) { m2 = le[e]; i2 = e; }
            const float p2 = __expf(m2 - m1); w1 = gtop / (1.f + p2); w2 = gtop * p2 / (1.f + p2);
            e1 = gi * 4 + i1; e2 = gi * 4 + i2;
            r1 = __hip_atomic_fetch_add(lcnt + e1, 1u, __ATOMIC_RELAXED, __HIP_MEMORY_SCOPE_WORKGROUP); r2 = __hip_atomic_fetch_add(lcnt + e2, 1u, __ATOMIC_RELAXED, __HIP_MEMORY_SCOPE_WORKGROUP);
        }
        __syncthreads();
        if (tid < 16) lbase[tid] = __hip_atomic_fetch_add(cnt + CNT_STRIDE * tid, lcnt[tid], __ATOMIC_RELAXED, __HIP_MEMORY_SCOPE_AGENT);
        __syncthreads();
        if (tid < 64 && rep == 0) { const int m = row0 + tid; const int p1 = (int)(lbase[e1] + r1), q2 = (int)(lbase[e2] + r2); const float rs = rstd_l[tid];
            list[(size_t)e1 * T_ + p1] = m; listw[(size_t)e1 * T_ + p1] = w1; listr[(size_t)e1 * T_ + p1] = rs; list[(size_t)e2 * T_ + q2] = m; listw[(size_t)e2 * T_ + q2] = w2; listr[(size_t)e2 * T_ + q2] = rs;
            toke[2 * m] = e1; toke[2 * m + 1] = e2; tokp[2 * m] = p1; tokp[2 * m + 1] = q2; }
        __syncthreads();
    }
}

template <bool MID>
__device__ __forceinline__ void phase_combine(bf16* XR, float* outf, float* rs, unsigned char* ws, unsigned* cnt, int G, int vcu, int rep) {
    int tid_ = threadIdx.x; asm volatile("" : "+v"(tid_)); const int tid = tid_, lane = tid & 63, wave = __builtin_amdgcn_readfirstlane(tid >> 6);
    const int gw = vcu * NWAVES + wave, NGW = G * NWAVES;
    int sb[NEXP]; { int pre = 0;
#pragma unroll
        for (int e = 0; e < NEXP; ++e) { sb[e] = pre * 256; pre += ((int)__builtin_amdgcn_readfirstlane(__hip_atomic_load(cnt + CNT_STRIDE * e, __ATOMIC_RELAXED, __HIP_MEMORY_SCOPE_AGENT)) + 255) >> 8; } }
    const int* toke = (const int*)(ws + WS_TOKE); const int* tokp = (const int*)(ws + WS_TOKP); const bf16* Y = (const bf16*)(ws + WS_Y);
    const GAS unsigned long long* te8 = (const GAS unsigned long long*)toke; const GAS unsigned long long* tp8 = (const GAS unsigned long long*)tokp;
    for (int m0 = gw; m0 < T_; m0 += 2 * NGW) {
        unsigned long long ee[2], pp[2]; int mm[2]; bool ok[2];
#pragma unroll
        for (int r = 0; r < 2; ++r) { mm[r] = m0 + r * NGW; ok[r] = mm[r] < T_; if (!ok[r]) mm[r] = m0; ee[r] = te8[mm[r]]; pp[r] = tp8[mm[r]]; }
        unsigned long long xv[2][4], ya[2][4], yb[2][4];
#pragma unroll
        for (int r = 0; r < 2; ++r) { const int e1 = (int)(ee[r] & 0xffffffffu), e2 = (int)(ee[r] >> 32), p1 = (int)(pp[r] & 0xffffffffu), p2 = (int)(pp[r] >> 32); int s1 = 0, s2 = 0;
#pragma unroll
            for (int e = 0; e < NEXP; ++e) { s1 = (e == e1) ? sb[e] + p1 : s1; s2 = (e == e2) ? sb[e] + p2 : s2; }
            const GAS unsigned long long* xr = (const GAS unsigned long long*)(XR + (size_t)mm[r] * DM_) + lane;
            const GAS unsigned long long* y1 = (const GAS unsigned long long*)(Y + (size_t)s1 * 1024) + lane; const GAS unsigned long long* y2 = (const GAS unsigned long long*)(Y + (size_t)s2 * 1024) + lane;
#pragma unroll
            for (int j = 0; j < 4; ++j) { xv[r][j] = xr[64 * j]; ya[r][j] = y1[64 * j]; yb[r][j] = y2[64 * j]; } }
#pragma unroll
        for (int r = 0; r < 2; ++r) { if (!ok[r]) continue;
            float ss = 0.f;
#pragma unroll
            for (int j = 0; j < 4; ++j) { const unsigned long long x = xv[r][j], a = ya[r][j], b = yb[r][j]; f32x4 t;
                t.x = bf2f((unsigned short)(x & 0xffff)) + (bf2f((unsigned short)(a & 0xffff)) + bf2f((unsigned short)(b & 0xffff))); t.y = bf2f((unsigned short)((x >> 16) & 0xffff)) + (bf2f((unsigned short)((a >> 16) & 0xffff)) + bf2f((unsigned short)((b >> 16) & 0xffff)));
                t.z = bf2f((unsigned short)((x >> 32) & 0xffff)) + (bf2f((unsigned short)((a >> 32) & 0xffff)) + bf2f((unsigned short)((b >> 32) & 0xffff))); t.w = bf2f((unsigned short)(x >> 48)) + (bf2f((unsigned short)(a >> 48)) + bf2f((unsigned short)(b >> 48)));
                ss += (t.x * t.x + t.y * t.y) + (t.z * t.z + t.w * t.w);
                if (rep == 0) { if (MID) ((GAS unsigned long long*)(XR + (size_t)mm[r] * DM_) + lane)[64 * j] = (unsigned long long)pk2(t.x, t.y) | ((unsigned long long)pk2(t.z, t.w) << 32);
                    else ((GAS f32x4*)(outf + (size_t)mm[r] * DM_) + lane)[64 * j] = t; } }
            if (MID) { const float rstd = __builtin_amdgcn_rsqf(wave_sum(ss) * (1.f / DM_) + EPS_); if (lane == 0 && rep == 0) rs[mm[r]] = rstd; }
        }
    }
}

__device__ __forceinline__ void unpack8(const v4u q, float (&f)[8]) { f[0] = bf2f((unsigned short)(q.x & 0xffff)); f[1] = bf2f((unsigned short)(q.x >> 16)); f[2] = bf2f((unsigned short)(q.y & 0xffff)); f[3] = bf2f((unsigned short)(q.y >> 16));
    f[4] = bf2f((unsigned short)(q.z & 0xffff)); f[5] = bf2f((unsigned short)(q.z >> 16)); f[6] = bf2f((unsigned short)(q.w & 0xffff)); f[7] = bf2f((unsigned short)(q.w >> 16)); }
__device__ __forceinline__ void phase_mix1(const bf16* H1, const float* conv_w, bf16* MIX, int G, int vcu) {
    int tid_ = threadIdx.x; asm volatile("" : "+v"(tid_)); const int gt = vcu * NTHR + tid_, NGT = G * NTHR;
    for (int idx = gt; idx < (T_ / 16) * 128; idx += NGT) {
        const int cgp = idx & 127, m0 = (idx >> 7) * 16, t0 = m0 & (SEQ_ - 1); const bf16* hr = H1 + (size_t)m0 * 2048;
        if (cgp < 64) { const int ch = cgp * 8; float z1[8], z2[8], w[3][8];
#pragma unroll
            for (int tap = 0; tap < 3; ++tap) { const f32x4 w0 = *(const GAS f32x4*)(conv_w + tap * 512 + ch), w1 = *(const GAS f32x4*)(conv_w + tap * 512 + ch + 4);
                w[tap][0] = w0.x; w[tap][1] = w0.y; w[tap][2] = w0.z; w[tap][3] = w0.w; w[tap][4] = w1.x; w[tap][5] = w1.y; w[tap][6] = w1.z; w[tap][7] = w1.w; }
#pragma unroll
            for (int e = 0; e < 8; ++e) { z1[e] = 0.f; z2[e] = 0.f; }
            if (t0 >= 2) { float a[8], b[8]; unpack8(*(const GAS v4u*)(hr - 2048 + 512 + ch), a); unpack8(*(const GAS v4u*)(hr - 2048 + 1024 + ch), b);
#pragma unroll
                for (int e = 0; e < 8; ++e) z1[e] = a[e] * b[e];
                unpack8(*(const GAS v4u*)(hr - 4096 + 512 + ch), a); unpack8(*(const GAS v4u*)(hr - 4096 + 1024 + ch), b);
#pragma unroll
                for (int e = 0; e < 8; ++e) z2[e] = a[e] * b[e]; }
#pragma unroll 4
            for (int i = 0; i < 16; ++i) { const bf16* r = hr + (size_t)i * 2048; float bgv[8], cgv[8], hcv[8], o[8];
                unpack8(*(const GAS v4u*)(r + ch), bgv); unpack8(*(const GAS v4u*)(r + 512 + ch), cgv); unpack8(*(const GAS v4u*)(r + 1024 + ch), hcv);
#pragma unroll
                for (int e = 0; e < 8; ++e) { const float z0 = cgv[e] * hcv[e]; o[e] = bgv[e] * (w[0][e] * z2[e] + w[1][e] * z1[e] + w[2][e] * z0); z2[e] = z1[e]; z1[e] = z0; }
                v4u q; q.x = pk2(o[0], o[1]); q.y = pk2(o[2], o[3]); q.z = pk2(o[4], o[5]); q.w = pk2(o[6], o[7]);
                *(GAS v4u*)(MIX + (size_t)(m0 + i) * 1024 + ch) = q; }
        } else { const int pc = (cgp - 64) * 8, gi = pc >> 7, win = 2 << gi; float s[8];
#pragma unroll
            for (int e = 0; e < 8; ++e) s[e] = 0.f;
            const int nb = (t0 < win - 1) ? t0 : win - 1;
            for (int d = 1; d <= nb; ++d) { float pv[8]; unpack8(*(const GAS v4u*)(hr - (size_t)d * 2048 + 1536 + pc), pv);
#pragma unroll
                for (int e = 0; e < 8; ++e) s[e] += pv[e]; }
#pragma unroll 4
            for (int i = 0; i < 16; ++i) { const int t = t0 + i; const bf16* r = hr + (size_t)i * 2048; float cur[8], o[8];
                unpack8(*(const GAS v4u*)(r + 1536 + pc), cur);
                const int n = (t + 1 < win) ? t + 1 : win; const float inv = 1.f / (float)n;
#pragma unroll
                for (int e = 0; e < 8; ++e) { s[e] += cur[e]; o[e] = s[e] * inv - cur[e]; }
                if (t + 1 >= win) { float old[8]; unpack8(*(const GAS v4u*)(r - (size_t)(win - 1) * 2048 + 1536 + pc), old);
#pragma unroll
                    for (int e = 0; e < 8; ++e) s[e] -= old[e]; }
                v4u q; q.x = pk2(o[0], o[1]); q.y = pk2(o[2], o[3]); q.z = pk2(o[4], o[5]); q.w = pk2(o[6], o[7]);
                *(GAS v4u*)(MIX + (size_t)(m0 + i) * 1024 + 512 + pc) = q; }
        }
    }
}
struct Args { const float* in[24]; float* out; unsigned char* ws; int ph_lo, ph_hi, rep, pad; };
__global__ void __launch_bounds__(NTHR, 2) hybrid_fwd(Args args) {
    extern __shared__ __attribute__((aligned(16))) unsigned char lds_raw[];
    LAS unsigned char* lds = (LAS unsigned char*)lds_raw;
    volatile LAS unsigned* MISC = (volatile LAS unsigned*)(lds + MISC_OFF);
    const int tid = threadIdx.x;
    const int G = gridDim.x; const int bx = blockIdx.x; const int vcu = (G % 8 == 0) ? (bx % 8) * (G / 8) + bx / 8 : bx;
    struct KIn { __device__ __forceinline__ const float* operator[](int k) const { const volatile __attribute__((address_space(4))) unsigned long long* ka = (const volatile __attribute__((address_space(4))) unsigned long long*)__builtin_amdgcn_kernarg_segment_ptr(); return (const float*)(const GAS float*)ka[k]; } };
    const KIn in;
#define out ((float*)in[24])
#define ws ((unsigned char*)in[25])
#define XN ((bf16*)(ws + WS_XN))
#define MIX ((bf16*)(ws + WS_MIX))
#define HID ((bf16*)(ws + WS_HID))
#define Y ((bf16*)(ws + WS_Y))
#define F2 ((float*)(ws + WS_F2))
#define ctl ((gu32*)(ws + WS_CTL))
    for (int u = tid; u < (LDS_BYTES - LDSCTL_OFF) / 4; u += NTHR) ((LAS unsigned*)(lds + LDSCTL_OFF))[u] = 0u;
    __syncthreads();
#if MK_USE_CG
    cooperative_groups::grid_group grid = cooperative_groups::this_grid();
#define GRID_BAR() grid.sync()
#else
    XcdBarrier bar; bar.bar = (unsigned*)(ctl + CW_BAR); bar.x = 0; bar.st = nullptr;
    if (MK_N_LAUNCHES == 1) bar = xcd_barrier_post((unsigned*)(ctl + CW_BAR), MISC + 8);
#define GRID_BAR() xcd_barrier(bar)
#endif
    const int lo = args.ph_lo, hi = args.ph_hi;
#ifndef PH_MASK
#define PH_MASK 0x1ffff
#endif
#define IN(k) (((PH_MASK >> (k)) & 1) && lo <= (k) && (k) < hi)
#define SEAM(k) do { if (IN(k) && IN((k) + 1)) GRID_BAR(); } while (0)

    if (IN(0)) { p0_prologue(in, ws, lds, G, vcu); }
    SEAM(0);
    if (IN(1)) {
        if (bx >= G - NBH && G > NBH && args.rep == 0) { scan_seq(F2 + (size_t)(bx - (G - NBH)) * SEQ_, (LAS float*)(lds + MISC_OFF + 64)); }
        pg8::ProbPlain S; S.init(XN, ws + WS_WIN0, T_, EV_N, 1024, G, bx);
        EpiInproj0 E{(bf16*)(ws + WS_U), (bf16*)(ws + WS_V), (bf16*)(ws + WS_Q), (bf16*)(ws + WS_K), (bf16*)(ws + WS_VAL), in[6], in[7], in[8], (const float*)(ws + WS_RS0)};
        pg8::gemm_phase<EpiInproj0, pg8::ProbPlain, true>(lds, S, E);
        { const int nfull = S.nwg % G, nidle = G - nfull;
          if (nfull > 0 && bx >= nfull) { const int wv_ = __builtin_amdgcn_readfirstlane(tid >> 6);
              convert_items(in, ws, (LAS float*)(lds + wv_ * 16384), TR_I0, TR_P1_END, (bx - nfull) * NWAVES + wv_, nidle * NWAVES, tid & 63); }
          else if (nfull == 0) { const int wv_ = __builtin_amdgcn_readfirstlane(tid >> 6); convert_items(in, ws, (LAS float*)(lds + wv_ * 16384), TR_I0, TR_P1_END, bx * NWAVES + wv_, G * NWAVES, tid & 63); } }
    }
    SEAM(1);
    if (IN(2)) {
#if MK_NAIVE_ATTN
        naive_attn((const bf16*)(ws + WS_Q), (const bf16*)(ws + WS_K), (const bf16*)(ws + WS_VAL), F2, MIX, vcu * NTHR + tid, G * NTHR);
        for (int u = bx; u < 512; u += G) gmlp_unit(u, (const bf16*)(ws + WS_U), (const bf16*)(ws + WS_V), (const bf16*)(ws + WS_WST), in[5], MIX, lds);
#else
        float skipthr, bmax; { const float gq = fabsf(in[7][tid & 63]), gk = fabsf(in[8][tid & 63]); float mq = gq, mk = gk;
#pragma unroll
            for (int o = 1; o < 64; o <<= 1) { mq = fmaxf(mq, __shfl_xor(mq, o)); mk = fmaxf(mk, __shfl_xor(mk, o)); }
            bmax = 1.02f * (0.125f * LOG2E * 64.f) * mq * mk; skipthr = 40.f + 2.f * bmax; }
        for (;;) {
            if (tid == 0) MISC[0] = __hip_atomic_fetch_add((unsigned*)(ctl + CW_Q + 16 * args.rep), 1u, __ATOMIC_RELAXED, __HIP_MEMORY_SCOPE_AGENT);
            __syncthreads();
            const int u = (int)MISC[0];
            __syncthreads();
            if (u >= 768 + 512) break;
            if (u < 768) { const int qb = 15 - u / NBH, bh = u % NBH;
                attn_body::attn_unit<8>(bh / NHEADS, bh % NHEADS, qb, (const attn_body::bf16*)(ws + WS_Q), (const attn_body::bf16*)(ws + WS_K), (const attn_body::bf16*)(ws + WS_VAL),
                                        (attn_body::bf16*)(ws + WS_MIX) + 256, F2 + (size_t)bh * SEQ_, skipthr, bmax, (char*)lds_raw); }
            else gmlp_unit(u - 768, (const bf16*)(ws + WS_U), (const bf16*)(ws + WS_V), (const bf16*)(ws + WS_WST), in[5], MIX, lds);
        }
#endif
    }
    SEAM(2);
    if (IN(3)) {
        pg8::ProbPlain S; S.init(MIX, ws + WS_WOUT0, T_, 1024, 1024, G, bx);
        EpiRes<false> E{nullptr, XN};
        pg8::gemm_phase<EpiRes<false>, pg8::ProbPlain, false>(lds, S, E);
    }
    SEAM(3);
#define MOE_LAYER(layer, pb, cntw) do { \
        unsigned* cnt = (unsigned*)(ctl + (cntw)); \
          \
        if (IN(pb)) phase_route(in, layer, XN, ws, args.rep ? (unsigned*)(ctl + CW_CNTD) : cnt, lds, G, vcu, args.rep); \
        SEAM(pb); \
        const char* wgu_ = (const char*)(ws + WS_WGU) + (size_t)(layer) * NEXP * 512 * 1024 * 2; const char* wd_ = (const char*)(ws + WS_WD) + (size_t)(layer) * NEXP * 1024 * 256 * 2; \
          \
        if (IN((pb) + 1)) { const int MT = moe_mtiles(cnt), NG = 2 * MT; \
            ProbMoe S{(const char*)XN, wgu_, 1024, 2, cnt, (const int*)(ws + WS_LIST), true, (size_t)512 * 1024 * 2, 0, NG < G ? NG : G, G, bx, G == 256 && NG >= G}; \
            EpiGateUp E{HID, (const float*)(ws + WS_LISTW), (const float*)(ws + WS_LISTR)}; \
            pg8::gemm_phase<EpiGateUp, ProbMoe, true>(lds, S, E); } \
        SEAM((pb) + 1); \
          \
        if (IN((pb) + 2)) { const int MT = moe_mtiles(cnt), NG = 2 * MT, n2 = NG > G ? NG - G : 0, MT1 = (NG < G ? NG : G) / 2, Ge = G - n2, dl = 4 * MT1 < 2 * Ge ? 4 * MT1 : 2 * Ge; \
            if (bx < n2) { ProbMoe S{(const char*)XN, wgu_, 1024, 2, cnt, (const int*)(ws + WS_LIST), true, (size_t)512 * 1024 * 2, G, NG, G, bx, false}; \
                EpiGateUp E{HID, (const float*)(ws + WS_LISTW), (const float*)(ws + WS_LISTR)}; \
                pg8::gemm_phase<EpiGateUp, ProbMoe, true>(lds, S, E); } \
            else { ProbMoe S{(const char*)HID, wd_, 256, 4, cnt, nullptr, false, (size_t)1024 * 256 * 2, 0, dl, Ge, bx - n2, G == 256 && (Ge & 7) == 0 && (n2 & 7) == 0 && (dl & 31) == 0 && dl / 4 <= MT1}; \
                EpiBf16 E{Y, 1024, nullptr}; \
                pg8::gemm_phase<EpiBf16, ProbMoe, true>(lds, S, E); } } \
        SEAM((pb) + 2); \
          \
        if (IN((pb) + 3)) { const int MT = moe_mtiles(cnt), NG = 2 * MT, n2 = NG > G ? NG - G : 0, MT1 = (NG < G ? NG : G) / 2, Ge = G - n2, dl = 4 * MT1 < 2 * Ge ? 4 * MT1 : 2 * Ge, nd2 = 4 * MT - dl; \
            ProbMoe S{(const char*)HID, wd_, 256, 4, cnt, nullptr, false, (size_t)1024 * 256 * 2, dl, 4 * MT, G, bx, false}; \
            EpiBf16 E{Y, 1024, nullptr}; \
            pg8::gemm_phase<EpiBf16, ProbMoe, true>(lds, S, E); \
            if ((layer) == 0) { const int wv_ = __builtin_amdgcn_readfirstlane((int)threadIdx.x >> 6); const int nid_ = nd2 < G ? G - nd2 : 0; \
                if (nid_ > 0) { if (bx >= nd2) { convert_items(in, ws, (LAS float*)(lds + wv_ * 16384), TR_A_END, TR_NITEMS, (bx - nd2) * NWAVES + wv_, nid_ * NWAVES, (int)threadIdx.x & 63); } } \
                else { convert_items(in, ws, (LAS float*)(lds + wv_ * 16384), TR_A_END, TR_NITEMS, bx * NWAVES + wv_, G * NWAVES, (int)threadIdx.x & 63); } } } \
        SEAM((pb) + 3); \
          \
        if (IN((pb) + 4)) { if ((layer) == 0) phase_combine<true>(XN, nullptr, (float*)(ws + WS_RS), ws, cnt, G, vcu, args.rep); else phase_combine<false>(XN, out, nullptr, ws, cnt, G, vcu, args.rep); } \
    } while (0)
    MOE_LAYER(0, 4, CW_CNT0);
    SEAM(8);
    if (IN(9)) {
        pg8::ProbPlain S; S.init(XN, ws + WS_WIN1, T_, 2048, 1024, G, bx);
        EpiBf16 E{(bf16*)(ws + WS_H1), 2048, (const float*)(ws + WS_RS)};
        pg8::gemm_phase<EpiBf16, pg8::ProbPlain, true>(lds, S, E);
    }
    SEAM(9);
    if (IN(10)) phase_mix1((const bf16*)(ws + WS_H1), in[12], MIX, G, vcu);
    SEAM(10);
    if (IN(11)) {
        pg8::ProbPlain S; S.init(MIX, ws + WS_WOUT1, T_, 1024, 1024, G, bx);
        EpiRes<false> E{nullptr, XN};
        pg8::gemm_phase<EpiRes<false>, pg8::ProbPlain, false>(lds, S, E);
    }
    SEAM(11);
    MOE_LAYER(1, 12, CW_CNT1);
#undef MOE_LAYER
#undef XN
#undef MIX
#undef HID
#undef Y
#undef F2
#undef ctl
#undef out
#undef ws
#undef IN
#undef SEAM
#undef GRID_BAR
}

extern "C" void kernel_launch(void* const* d_in, const int* in_sizes, int n_in, void* d_out, int out_size, void* d_ws, size_t ws_size, hipStream_t stream) {
    static int grid = 0;
    if (grid == 0) {
        if (n_in != 24 || in_sizes[0] != T_ * DM_ || out_size != T_ * DM_ || ws_size < WS_END) { fprintf(stderr, "kernel_launch: unexpected shapes (n_in %d, in0 %d, out %d, ws %zu); nothing launched\n", n_in, n_in > 0 ? in_sizes[0] : -1, out_size, ws_size); grid = -1; return; }
        int dev = 0, cus = 0, per_cu = 0;
        if (hipGetDevice(&dev) != hipSuccess || hipDeviceGetAttribute(&cus, hipDeviceAttributeMultiprocessorCount, dev) != hipSuccess) { fprintf(stderr, "kernel_launch: device query failed\n"); grid = -1; return; }
        if (hipFuncSetAttribute((const void*)hybrid_fwd, hipFuncAttributeMaxDynamicSharedMemorySize, LDS_BYTES) != hipSuccess) { fprintf(stderr, "kernel_launch: hipFuncSetAttribute failed\n"); grid = -1; return; }
        if (hipOccupancyMaxActiveBlocksPerMultiprocessor(&per_cu, (const void*)hybrid_fwd, NTHR, LDS_BYTES) != hipSuccess || per_cu < 1) { fprintf(stderr, "kernel_launch: occupancy query reports %d workgroups per CU\n", per_cu); per_cu = 1; }
        (void)hipGetLastError();
        grid = cus;
    }
    if (grid < 0) return;
    if (hipMemsetAsync((char*)d_ws + WS_CTL, 0, CTL_ZERO_BYTES, stream) != hipSuccess) { fprintf(stderr, "kernel_launch: memset failed\n"); return; }
    Args a{};
    for (int i = 0; i < 24; ++i) a.in[i] = (const float*)d_in[i];
    a.out = (float*)d_out; a.ws = (unsigned char*)d_ws;
#if MK_N_LAUNCHES == 1
    a.ph_lo = 0; a.ph_hi = NPH;
#if MK_USE_CG
    void* kargs[] = {&a};
    hipError_t e = hipLaunchCooperativeKernel((const void*)hybrid_fwd, dim3(grid), dim3(NTHR), kargs, LDS_BYTES, stream);
    if (e != hipSuccess) fprintf(stderr, "kernel_launch: cooperative launch failed: %s (grid %d)\n", hipGetErrorString(e), grid);
#else
    hipLaunchKernelGGL(hybrid_fwd, dim3(grid), dim3(NTHR), LDS_BYTES, stream, a);
#endif
#else
    for (int p = 0; p < NPH; ++p) { a.ph_lo = p; a.ph_hi = p + 1; a.rep = 0; hipLaunchKernelGGL(hybrid_fwd, dim3(grid), dim3(NTHR), LDS_BYTES, stream, a);
        if ((MK_REPEAT_MASK >> p) & 1) { a.rep = MK_REP_MODE; hipLaunchKernelGGL(hybrid_fwd, dim3(grid), dim3(NTHR), LDS_BYTES, stream, a); } }
#endif
}
```
